# Optimizing an MI355X kernel written in HIP

```python
import jax, jax.numpy as jnp
from jax import lax
import numpy as np

D_MODEL = 2048
BATCH = 16
SEQ = 2048
DEPTH = 4
DEC_BATCH = 4
DEC_SEQ = 8192
PAST_LEN = 128

GRID_W = 64
ROPE_THETA = 10000.0
NORM_EPS = 1e-6
Q_BLOCK = 128

N_MIXERS = 3
N_GQA_LAYERS = (DEPTH + 2) // 3
N_GLA_LAYERS = (DEPTH + 1) // 3
N_MLA_LAYERS = DEPTH // 3

GQA_HEAD_DIM = 128
GQA_Q_HEADS = D_MODEL // GQA_HEAD_DIM
GQA_KV_HEADS = 4
GQA_GROUP = GQA_Q_HEADS // GQA_KV_HEADS

GLA_HEADS = 4
GLA_DK = D_MODEL // 2
GLA_DV = D_MODEL
GLA_DK_HEAD = GLA_DK // GLA_HEADS
GLA_DV_HEAD = GLA_DV // GLA_HEADS
GLA_GATE_RANK = 16
GLA_GATE_TAU = 16.0
GLA_CHUNK = 64

MLA_HEADS = 16
MLA_Q_RANK = 512
MLA_KV_RANK = 256
MLA_NOPE_DIM = 128
MLA_ROPE_DIM = 64
MLA_QK_DIM = MLA_NOPE_DIM + MLA_ROPE_DIM
MLA_V_DIM = 128

D_FF = 4 * D_MODEL

kernel_name = 'hybrid_gqa_gla_mla_adaln_encoder'


def rms_norm(x, g):
    xf = x.astype(jnp.float32)
    y = xf * lax.rsqrt(jnp.mean(xf * xf, axis=-1, keepdims=True) + NORM_EPS)
    return (y * g.astype(jnp.float32)).astype(x.dtype)


def axial_rope(n_tok, rot_dim):
    rows = n_tok // GRID_W
    row = jnp.repeat(jnp.arange(rows, dtype=jnp.float32), GRID_W)
    col = jnp.tile(jnp.arange(GRID_W, dtype=jnp.float32), rows)
    n_freq = rot_dim // 4
    inv = ROPE_THETA ** (-jnp.arange(n_freq, dtype=jnp.float32) / n_freq)
    ang = jnp.concatenate([row[:, None] * inv, col[:, None] * inv], axis=-1)
    return jnp.cos(ang), jnp.sin(ang)


def apply_rope(x, cos, sin):
    xf = x.astype(jnp.float32)
    x1 = xf[..., 0::2]
    x2 = xf[..., 1::2]
    c = cos[None, :, None, :]
    s = sin[None, :, None, :]
    out = jnp.stack([x1 * c - x2 * s, x1 * s + x2 * c], axis=-1).reshape(x.shape)
    return out.astype(x.dtype)


def block_attention(q, k, v, scale):
    B, T, Hkv, G, dh = q.shape
    dv = v.shape[-1]
    nb = T // Q_BLOCK
    qb = q.reshape(B, nb, Q_BLOCK, Hkv, G, dh).transpose(1, 0, 2, 3, 4, 5)

    def one_block(qblk):
        s = jnp.einsum('bqhgd,bkhd->bhgqk', qblk, k).astype(jnp.float32) * scale
        p = jax.nn.softmax(s, axis=-1).astype(v.dtype)
        return jnp.einsum('bhgqk,bkhe->bqhge', p, v)

    o = lax.map(one_block, qb)
    return o.transpose(1, 0, 2, 3, 4, 5).reshape(B, T, Hkv * G * dv)


def gqa_mixer(h, w_qkv, q_norm, k_norm, w_o, cos, sin):
    B, T, _ = h.shape
    qkv = h @ w_qkv
    nq = GQA_Q_HEADS * GQA_HEAD_DIM
    nk = GQA_KV_HEADS * GQA_HEAD_DIM
    q = qkv[..., :nq].reshape(B, T, GQA_Q_HEADS, GQA_HEAD_DIM)
    k = qkv[..., nq:nq + nk].reshape(B, T, GQA_KV_HEADS, GQA_HEAD_DIM)
    v = qkv[..., nq + nk:].reshape(B, T, GQA_KV_HEADS, GQA_HEAD_DIM)
    q = apply_rope(rms_norm(q, q_norm), cos, sin)
    k = apply_rope(rms_norm(k, k_norm), cos, sin)
    q = q.reshape(B, T, GQA_KV_HEADS, GQA_GROUP, GQA_HEAD_DIM)
    o = block_attention(q, k, v, GQA_HEAD_DIM ** -0.5)
    return o @ w_o


def gla_scan(q, k, v, log_a):
    B, T, H, dk = q.shape
    dv = v.shape[-1]
    n = T // GLA_CHUNK

    def chunks(x):
        return x.reshape(B, n, GLA_CHUNK, H, x.shape[-1]).transpose(1, 0, 3, 2, 4)

    qc, kc, vc, ac = chunks(q), chunks(k), chunks(v), chunks(log_a)
    b = jnp.cumsum(ac, axis=3)
    b_last = b[:, :, :, -1:, :]
    qd = qc * jnp.exp(b)
    kd = kc * jnp.exp(-b)
    ke = kc * jnp.exp(b_last - b)
    de = jnp.exp(b_last[:, :, :, 0, :])
    mask = jnp.tril(jnp.ones((GLA_CHUNK, GLA_CHUNK), dtype=bool))

    def step(S, inp):
        qd_i, kd_i, ke_i, v_i, de_i = inp
        a = jnp.where(mask, jnp.einsum('bhld,bhmd->bhlm', qd_i, kd_i), 0.0)
        o = jnp.einsum('bhlm,bhme->bhle', a, v_i) + jnp.einsum('bhld,bhde->bhle', qd_i, S)
        S = de_i[..., None] * S + jnp.einsum('bhld,bhle->bhde', ke_i, v_i)
        return S, o

    S0 = jnp.zeros((B, H, dk, dv), jnp.float32)
    _, o = lax.scan(step, S0, (qd, kd, ke, vc, de))
    return o.transpose(1, 0, 3, 2, 4).reshape(B, T, H, dv)


def gla_mixer(h, w_in, w_g1, w_g2, b_g, o_norm, w_o):
    B, T, _ = h.shape
    proj = h @ w_in
    q = proj[..., :GLA_DK]
    k = proj[..., GLA_DK:2 * GLA_DK]
    v = proj[..., 2 * GLA_DK:2 * GLA_DK + GLA_DV]
    r = proj[..., 2 * GLA_DK + GLA_DV:]
    q = q.reshape(B, T, GLA_HEADS, GLA_DK_HEAD).astype(jnp.float32) * (GLA_DK_HEAD ** -0.5)
    k = k.reshape(B, T, GLA_HEADS, GLA_DK_HEAD).astype(jnp.float32)
    v = v.reshape(B, T, GLA_HEADS, GLA_DV_HEAD).astype(jnp.float32)
    low = jnp.einsum('btd,ndr->nbtr', h, w_g1)
    z = jnp.einsum('nbtr,nrk->nbtk', low, w_g2) + b_g[:, None, None, :]
    log_a = jax.nn.log_sigmoid(z.astype(jnp.float32)) / GLA_GATE_TAU
    log_a = log_a.reshape(2, B, T, GLA_HEADS, GLA_DK_HEAD)
    o_fwd = gla_scan(q, k, v, log_a[0])
    flip = lambda t: jnp.flip(t, axis=1)
    o_bwd = flip(gla_scan(flip(q), flip(k), flip(v), flip(log_a[1])))
    o = rms_norm(o_fwd + o_bwd, o_norm)
    o = o.reshape(B, T, GLA_DV) * jax.nn.silu(r.astype(jnp.float32))
    return o.astype(h.dtype) @ w_o


def mla_mixer(h, w_down, q_a_norm, kv_a_norm, w_uq, w_ukv, q_norm, k_nope_norm,
              k_rope_norm, w_o, cos, sin):
    B, T, _ = h.shape
    down = h @ w_down
    cq = down[..., :MLA_Q_RANK]
    ckv = down[..., MLA_Q_RANK:MLA_Q_RANK + MLA_KV_RANK]
    kr = down[..., MLA_Q_RANK + MLA_KV_RANK:]
    q = (rms_norm(cq, q_a_norm) @ w_uq).reshape(B, T, MLA_HEADS, MLA_QK_DIM)
    kv = (rms_norm(ckv, kv_a_norm) @ w_ukv).reshape(B, T, MLA_HEADS, MLA_NOPE_DIM + MLA_V_DIM)
    k_nope = rms_norm(kv[..., :MLA_NOPE_DIM], k_nope_norm)
    v = kv[..., MLA_NOPE_DIM:]
    q = rms_norm(q, q_norm)
    q = jnp.concatenate([q[..., :MLA_NOPE_DIM], apply_rope(q[..., MLA_NOPE_DIM:], cos, sin)], axis=-1)
    kr = apply_rope(rms_norm(kr, k_rope_norm)[:, :, None, :], cos, sin)
    k = jnp.concatenate([k_nope, jnp.broadcast_to(kr, (B, T, MLA_HEADS, MLA_ROPE_DIM))], axis=-1)
    o = block_attention(q[:, :, :, None, :], k, v, MLA_QK_DIM ** -0.5)
    return o @ w_o


def sq_relu_mlp(h, w1, w2):
    a = jax.nn.relu(h @ w1)
    return (a * a) @ w2


def trunk(x, c, p):
    T = x.shape[1]
    cos_a, sin_a = axial_rope(T, GQA_HEAD_DIM)
    cos_c, sin_c = axial_rope(T, MLA_ROPE_DIM)
    cond = jax.nn.silu(c.astype(jnp.float32)).astype(x.dtype)
    for i in range(DEPTH):
        mod = cond @ p['ada_w'][i] + p['ada_b'][i]
        sh1, sc1, g1, sh2, sc2, g2 = jnp.split(mod[:, None, :], 6, axis=-1)
        h = rms_norm(x, p['norm1_g'][i]) * (1.0 + sc1) + sh1
        kind = i % N_MIXERS
        j = i // N_MIXERS
        if kind == 0:
            y = gqa_mixer(h, p['gqa_w_qkv'][j], p['gqa_q_norm'][j], p['gqa_k_norm'][j],
                          p['gqa_w_o'][j], cos_a, sin_a)
        elif kind == 1:
            y = gla_mixer(h, p['gla_w_in'][j], p['gla_w_g1'][j], p['gla_w_g2'][j],
                          p['gla_b_g'][j], p['gla_o_norm'][j], p['gla_w_o'][j])
        else:
            y = mla_mixer(h, p['mla_w_down'][j], p['mla_q_a_norm'][j], p['mla_kv_a_norm'][j],
                          p['mla_w_uq'][j], p['mla_w_ukv'][j], p['mla_q_norm'][j],
                          p['mla_k_nope_norm'][j], p['mla_k_rope_norm'][j], p['mla_w_o'][j],
                          cos_c, sin_c)
        x = x + g1 * y
        h = rms_norm(x, p['norm2_g'][i]) * (1.0 + sc2) + sh2
        x = x + g2 * sq_relu_mlp(h, p['mlp_w1'][i], p['mlp_w2'][i])
    return x


def setup_inputs(seed: int = 0) -> dict:
    key = jax.random.key(seed)
    ks = iter(jax.random.split(key, 32))
    f32 = jnp.float32

    def nrm(shape, scale):
        return jax.random.normal(next(ks), shape, f32) * scale

    def gain(shape):
        return 1.0 + 0.05 * jax.random.normal(next(ks), shape, f32)

    D = D_MODEL
    nA, nB, nC = N_GQA_LAYERS, N_GLA_LAYERS, N_MLA_LAYERS
    return {
        'x_prompt': nrm((BATCH, SEQ, D), 1.0),
        'x_sample': nrm((DEC_BATCH, DEC_SEQ, D), 1.0),
        'c_prompt': nrm((BATCH, D), 1.0),
        'c_sample': nrm((DEC_BATCH, D), 1.0),
        'norm1_g': gain((DEPTH, D)),
        'norm2_g': gain((DEPTH, D)),
        'ada_w': nrm((DEPTH, D, 6 * D), 0.5 * D ** -0.5),
        'ada_b': nrm((DEPTH, 6 * D), 0.01),
        'gqa_w_qkv': nrm((nA, D, (GQA_Q_HEADS + 2 * GQA_KV_HEADS) * GQA_HEAD_DIM), D ** -0.5),
        'gqa_q_norm': gain((nA, GQA_HEAD_DIM)),
        'gqa_k_norm': gain((nA, GQA_HEAD_DIM)),
        'gqa_w_o': nrm((nA, GQA_Q_HEADS * GQA_HEAD_DIM, D), (GQA_Q_HEADS * GQA_HEAD_DIM) ** -0.5),
        'gla_w_in': nrm((nB, D, 2 * GLA_DK + 2 * GLA_DV), D ** -0.5),
        'gla_w_g1': nrm((nB, 2, D, GLA_GATE_RANK), D ** -0.5),
        'gla_w_g2': nrm((nB, 2, GLA_GATE_RANK, GLA_DK), GLA_GATE_RANK ** -0.5),
        'gla_b_g': nrm((nB, 2, GLA_DK), 0.01),
        'gla_o_norm': gain((nB, GLA_DV_HEAD)),
        'gla_w_o': nrm((nB, GLA_DV, D), GLA_DV ** -0.5),
        'mla_w_down': nrm((nC, D, MLA_Q_RANK + MLA_KV_RANK + MLA_ROPE_DIM), D ** -0.5),
        'mla_q_a_norm': gain((nC, MLA_Q_RANK)),
        'mla_kv_a_norm': gain((nC, MLA_KV_RANK)),
        'mla_w_uq': nrm((nC, MLA_Q_RANK, MLA_HEADS * MLA_QK_DIM), MLA_Q_RANK ** -0.5),
        'mla_w_ukv': nrm((nC, MLA_KV_RANK, MLA_HEADS * (MLA_NOPE_DIM + MLA_V_DIM)), MLA_KV_RANK ** -0.5),
        'mla_q_norm': gain((nC, MLA_QK_DIM)),
        'mla_k_nope_norm': gain((nC, MLA_NOPE_DIM)),
        'mla_k_rope_norm': gain((nC, MLA_ROPE_DIM)),
        'mla_w_o': nrm((nC, MLA_HEADS * MLA_V_DIM, D), (MLA_HEADS * MLA_V_DIM) ** -0.5),
        'mlp_w1': nrm((DEPTH, D, D_FF), D ** -0.5),
        'mlp_w2': nrm((DEPTH, D_FF, D), D_FF ** -0.5),
    }


def reference(x_prompt, x_sample, c_prompt, c_sample, norm1_g, norm2_g, ada_w, ada_b,
              gqa_w_qkv, gqa_q_norm, gqa_k_norm, gqa_w_o,
              gla_w_in, gla_w_g1, gla_w_g2, gla_b_g, gla_o_norm, gla_w_o,
              mla_w_down, mla_q_a_norm, mla_kv_a_norm, mla_w_uq, mla_w_ukv, mla_q_norm,
              mla_k_nope_norm, mla_k_rope_norm, mla_w_o, mlp_w1, mlp_w2):
    params = dict(
        norm1_g=norm1_g, norm2_g=norm2_g, ada_w=ada_w, ada_b=ada_b,
        gqa_w_qkv=gqa_w_qkv, gqa_q_norm=gqa_q_norm, gqa_k_norm=gqa_k_norm, gqa_w_o=gqa_w_o,
        gla_w_in=gla_w_in, gla_w_g1=gla_w_g1, gla_w_g2=gla_w_g2, gla_b_g=gla_b_g,
        gla_o_norm=gla_o_norm, gla_w_o=gla_w_o,
        mla_w_down=mla_w_down, mla_q_a_norm=mla_q_a_norm, mla_kv_a_norm=mla_kv_a_norm,
        mla_w_uq=mla_w_uq, mla_w_ukv=mla_w_ukv, mla_q_norm=mla_q_norm,
        mla_k_nope_norm=mla_k_nope_norm, mla_k_rope_norm=mla_k_rope_norm, mla_w_o=mla_w_o,
        mlp_w1=mlp_w1, mlp_w2=mlp_w2,
    )
    y_prompt = trunk(x_prompt, c_prompt, params)
    y_sample = trunk(x_sample, c_sample, params)
    return (y_prompt, y_sample)
```

```cpp
#include <hip/hip_runtime.h>
#include <cstdio>
#include <cstdint>

#define GAS __attribute__((address_space(1)))
#define LAS __attribute__((address_space(3)))
#define PG8_LAS __attribute__((address_space(3)))

#ifndef MK_ONE_LAUNCH
#define MK_ONE_LAUNCH 1
#endif

constexpr int D = 2048, M = 65536, MP = 32768, NSEQ = 20, FF = 8192, DEPTH = 4;
constexpr float NORM_EPS = 1e-6f;
enum { I_XP = 0, I_XS, I_CP, I_CS, I_N1G, I_N2G, I_ADAW, I_ADAB, I_GQA_WQKV, I_GQA_QN, I_GQA_KN, I_GQA_WO, I_GLA_WIN, I_GLA_WG1, I_GLA_WG2, I_GLA_BG, I_GLA_ON, I_GLA_WO,
       I_MLA_WDOWN, I_MLA_QAN, I_MLA_KVAN, I_MLA_WUQ, I_MLA_WUKV, I_MLA_QN, I_MLA_KNN, I_MLA_KRN, I_MLA_WO, I_W1, I_W2, N_IN };

constexpr size_t MiB = 1u << 20;
constexpr size_t WS_CTL = 0, CTL_ZERO_BYTES = 1 * MiB;
constexpr size_t WS_MODP = 384 * MiB;
constexpr size_t WS_MOD = 16 * MiB;
constexpr size_t WS_ROPE = 20 * MiB;
constexpr size_t WS_BW1 = 20 * MiB + 256 * 1024, WS_BW2 = 21 * MiB;
constexpr size_t WS_BW1B = 26 * MiB, WS_BW2B = 26 * MiB + 768 * 1024;
constexpr size_t WS_SSQA = 22 * MiB, WS_SSQB = 24 * MiB;
constexpr size_t WS_W = 28 * MiB;
constexpr size_t WS_W1T = WS_W, WS_W2T = WS_W + 32 * MiB, WS_WMIX = WS_W + 64 * MiB;
constexpr size_t WS_WO_T = WS_WMIX + 26 * MiB;
constexpr size_t WS_H = 128 * MiB;
constexpr size_t WS_S = 384 * MiB;
constexpr size_t WS_QKV = WS_S;
constexpr size_t WS_PROJ = WS_S, WS_OB = WS_S + 800 * MiB;
constexpr size_t WS_DOWN = WS_S, WS_Q = WS_S + 128 * MiB, WS_KV = WS_S + 512 * MiB;
constexpr size_t WS_HID = WS_S;
constexpr size_t WS_WB = WS_S + 1056 * MiB;
constexpr size_t WS_END = WS_WB + 100 * MiB;
static_assert(WS_WO_T + 8 * MiB <= WS_H && WS_OB + 256 * MiB <= WS_END && WS_KV + 512 * MiB <= WS_END && WS_HID + 1024 * MiB <= WS_END, "ws map");
constexpr int CW_BAR = 4096;
constexpr int CW_PREP = 8192;

constexpr int RING_BYTES = 131072;
constexpr int LDSCTL_OFF = 144 * 1024 - 512;
constexpr int LDS_BYTES = 147456;

typedef unsigned short bf16;
typedef unsigned v4u __attribute__((ext_vector_type(4)));
typedef unsigned v2u __attribute__((ext_vector_type(2)));
typedef unsigned v3u __attribute__((ext_vector_type(3)));
typedef float f32x4 __attribute__((ext_vector_type(4)));
typedef float f32x2 __attribute__((ext_vector_type(2)));
typedef short bf16x8 __attribute__((ext_vector_type(8)));
typedef GAS unsigned gu32;
#define RLX_AGENT __ATOMIC_RELAXED, __HIP_MEMORY_SCOPE_AGENT
#define LDS_WAIT() asm volatile("s_waitcnt lgkmcnt(0)" ::: "memory")
#define VM_WAIT() asm volatile("s_waitcnt vmcnt(0)" ::: "memory")
__device__ __forceinline__ unsigned f2bf(float f) { unsigned u = __builtin_bit_cast(unsigned, f); return (u + 0x7fffu + ((u >> 16) & 1u)) >> 16; }
typedef __bf16 bf16x2_t __attribute__((ext_vector_type(2)));
__device__ __forceinline__ unsigned pk2c(float lo, float hi) { const f32x2 v = {lo, hi}; const bf16x2_t b = __builtin_convertvector(v, bf16x2_t); return __builtin_bit_cast(unsigned, b); }
__device__ __forceinline__ unsigned pk2(float lo, float hi) { unsigned r; asm volatile("v_cvt_pk_bf16_f32 %0, %1, %2" : "=v"(r) : "v"(lo), "v"(hi)); return r; }
__device__ __forceinline__ float bflo(unsigned u) { return __uint_as_float(u << 16); }
__device__ __forceinline__ float bfhi(unsigned u) { return __uint_as_float(u & 0xffff0000u); }
__device__ __forceinline__ int seq_of_row(int row) { return row < MP ? (row >> 11) : 16 + ((row - MP) >> 13); }
__device__ __forceinline__ int pos_of_row(int row) { return row < MP ? (row & 2047) : (row & 8191); }
__device__ __forceinline__ float wave_sum(float v) {
#pragma unroll
    for (int o = 1; o < 64; o <<= 1) v += __shfl_xor(v, o);
    return v;
}
namespace pg8 {
typedef unsigned short bf16_t;
typedef short bf16x8 __attribute__((ext_vector_type(8)));
typedef float f32x4 __attribute__((ext_vector_type(4)));
typedef unsigned u32x4 __attribute__((ext_vector_type(4)));
constexpr int BM = 256, BK = 64, HALF = 128, HTB = HALF * BK * 2  , STAGE_BYTES = 8 * HTB, NXCD = 8, WGM = 8;

__host__ __device__ __forceinline__ int lds_byte(int r, int c) { const int st = (r >> 4) * 2 + (c >> 5), rr = r & 15, cc = c & 31, ob = rr * 64 + cc * 2; return st * 1024 + (ob ^ (((ob >> 9) & 1) << 5)); }
__host__ __device__ __forceinline__ void stage_rc(int b, int& R, int& C) { const int st = b / 1024, sb = b % 1024, swz = sb ^ (((sb >> 9) & 1) << 5); R = (st >> 1) * 16 + swz / 64; C = (st & 1) * 32 + (swz % 64) / 2; }
__host__ __device__ __forceinline__ int perm32(int rho) { const int n = rho >> 4, i = rho & 15; return 8 * (i >> 2) + 4 * n + (i & 3); }

struct Unit { int pm, pn; };
struct Gemm { const bf16_t* A; const bf16_t* Bt; int M, N, K, lda, pairA; };

struct StaticOrder {
    int nM, nN, nwg, G, c, reps, wgm;
    __host__ __device__ void init(int M, int N, int G_, int c_, int reps_ = 1, int wgm_ = 4) { nM = M / BM; nN = N / BM; nwg = nM * nN; G = G_; c = c_; reps = reps_; wgm = wgm_; }
    __host__ __device__ bool next(int i, Unit& u) const {
        long L = (long)i * G + c; if (L >= (long)nwg * reps) return false;
        L %= nwg;
        int wgid = (int)L; { const int q = nwg / NXCD, r = nwg % NXCD, xcd = wgid % NXCD, off = wgid / NXCD; wgid = (xcd < r ? xcd * (q + 1) : r * (q + 1) + (xcd - r) * q) + off; }
        const int nig = wgm * nN, gid = wgid / nig, fm = gid * wgm, gsz = (nM - fm) < wgm ? (nM - fm) : wgm;
        u.pm = fm + ((wgid % nig) % gsz); u.pn = (wgid % nig) / gsz; return true;
    }
    __device__ __forceinline__ void a_ready(const Unit&) const {}
    __device__ __forceinline__ void done(const Unit&) const {}
};


__device__ __forceinline__ unsigned cvt_pk_bf16(float lo, float hi) { return ::pk2(lo, hi); }
template <int ACT> struct EpiBf16N {
    static constexpr bool PERM = true, AFTER_DRAIN = false, OWN_ALIGN = true;
    bf16_t* O; int ldc; const float* ssq; const float* bw; int ldbw;
    __device__ __forceinline__ void operator()(const f32x4 (&acc)[2][2][4][2], const Unit& u, int wr, int wc, int fr, int fq) const {
        const int rowt = u.pm * BM, row0 = rowt + wr * 64 + fr, col0 = u.pn * BM + wc * 32 + 8 * fq;
        const int seq = rowt < 32768 ? (rowt >> 11) : 16 + ((rowt - 32768) >> 13);
        typedef float f32x2v __attribute__((ext_vector_type(2)));
        f32x2v pv[8]; f32x4 bv[2][2];
#pragma unroll
        for (int i = 0; i < 8; ++i) pv[i] = *(const f32x2v*)(ssq + (size_t)(row0 + (i >> 2) * HALF + (i & 3) * 16) * 8 + 2 * fq);
#pragma unroll
        for (int bj = 0; bj < 2; ++bj)
#pragma unroll
            for (int n = 0; n < 2; ++n) bv[bj][n] = *(const f32x4*)(bw + (size_t)seq * ldbw + col0 + bj * HALF + 4 * n);
        asm volatile("" ::: "memory"); if (wr == 0) __builtin_amdgcn_s_barrier(); asm volatile("" ::: "memory");
        float rs[8];
#pragma unroll
        for (int i = 0; i < 8; ++i) { float s = pv[i].x + pv[i].y; s += __shfl_xor(s, 16); s += __shfl_xor(s, 32); rs[i] = __builtin_amdgcn_rsqf(s * (1.f / 2048.f) + 1e-6f); }
#pragma unroll
        for (int ai = 0; ai < 2; ++ai)
#pragma unroll
            for (int m = 0; m < 4; ++m) { const int r = row0 + ai * HALF + m * 16; const float rsr = rs[ai * 4 + m];
                bf16_t* rowp = O + (size_t)r * ldc + col0;
#pragma unroll
                for (int bj = 0; bj < 2; ++bj) { f32x4 v0 = acc[ai][bj][m][0] * rsr + bv[bj][0], v1 = acc[ai][bj][m][1] * rsr + bv[bj][1];
                    if (ACT == 1) {
#pragma unroll
                        for (int j = 0; j < 4; ++j) { const float a = fmaxf(v0[j], 0.f), b = fmaxf(v1[j], 0.f); v0[j] = a * a; v1[j] = b * b; } }
                    u32x4 w; w.x = cvt_pk_bf16(v0[0], v0[1]); w.y = cvt_pk_bf16(v0[2], v0[3]); w.z = cvt_pk_bf16(v1[0], v1[1]); w.w = cvt_pk_bf16(v1[2], v1[3]);
                    *(u32x4*)(rowp + bj * HALF) = w; } }
    }
};
struct EpiResGateNorm {
    static constexpr bool PERM = false, AFTER_DRAIN = false, OWN_ALIGN = false;
    const float* in0; const float* in1; float* out; const float* gate;
    bf16_t* xa; const float* gn; const float* sc; float* ssq; PG8_LAS float* xl;
    __device__ __forceinline__ void operator()(const f32x4 (&acc)[2][2][4][2], const Unit& u, int wr, int wc, int fr, int fq) const {
        const int rowt = u.pm * BM, row0 = rowt + wr * 64 + fr, col0 = u.pn * BM + wc * 32 + 4 * fq;
        const int seq = rowt < 32768 ? (rowt >> 11) : 16 + ((rowt - 32768) >> 13);
        const float* gp = gate + (size_t)seq * 12288 + col0;
        typedef unsigned u32x2 __attribute__((ext_vector_type(2)));
        u32x2 dp[2][2][4][2];
        {
            f32x4 gv[2][2];
#pragma unroll
            for (int bj = 0; bj < 2; ++bj)
#pragma unroll
                for (int n = 0; n < 2; ++n) gv[bj][n] = *(const f32x4*)(gp + bj * HALF + n * 16);
#pragma unroll
            for (int ai = 0; ai < 2; ++ai)
#pragma unroll
                for (int bj = 0; bj < 2; ++bj)
#pragma unroll
                    for (int m = 0; m < 4; ++m)
#pragma unroll
                        for (int n = 0; n < 2; ++n) { const f32x4 d = gv[bj][n] * acc[ai][bj][m][n]; dp[ai][bj][m][n] = (u32x2){cvt_pk_bf16(d[0], d[1]), cvt_pk_bf16(d[2], d[3])}; }
        }
        asm volatile("" ::: "memory");
        const float* base = in0 ? (rowt < 32768 ? in0 : in1 - (size_t)32768 * 2048) : out;
        f32x4 av[2][2];
#pragma unroll
        for (int bj = 0; bj < 2; ++bj)
#pragma unroll
            for (int n = 0; n < 2; ++n) { if (xa) av[bj][n] = *(const f32x4*)(gn + col0 + bj * HALF + n * 16) * (*(const f32x4*)(sc + (size_t)seq * 12288 + col0 + bj * HALF + n * 16) + 1.0f); else av[bj][n] = (f32x4){0.f, 0.f, 0.f, 0.f}; }
#pragma unroll
        for (int ai = 0; ai < 2; ++ai) {
            f32x4 bsv[4][2][2];
#pragma unroll
            for (int m = 0; m < 4; ++m)
#pragma unroll
                for (int bj = 0; bj < 2; ++bj)
#pragma unroll
                    for (int n = 0; n < 2; ++n) bsv[m][bj][n] = *(const f32x4*)(base + (size_t)(row0 + ai * HALF + m * 16) * 2048 + col0 + bj * HALF + n * 16);
            asm volatile("" ::: "memory");
#pragma unroll
            for (int m = 0; m < 4; ++m) { const size_t off = (size_t)(row0 + ai * HALF + m * 16) * 2048 + col0; float ss = 0.f;
#pragma unroll
                for (int bj = 0; bj < 2; ++bj)
#pragma unroll
                    for (int n = 0; n < 2; ++n) { const u32x2 dq = dp[ai][bj][m][n];
                        const f32x4 d = {__uint_as_float(dq.x << 16), __uint_as_float(dq.x & 0xffff0000u), __uint_as_float(dq.y << 16), __uint_as_float(dq.y & 0xffff0000u)};
                        const f32x4 o = bsv[m][bj][n] + d;
                        *(f32x4*)(out + off + bj * HALF + n * 16) = o;
                        if (xa) { const f32x4 y = o * av[bj][n]; ss += (o[0] * o[0] + o[1] * o[1]) + (o[2] * o[2] + o[3] * o[3]);
                            *(u32x2*)(xa + off + bj * HALF + n * 16) = (u32x2){cvt_pk_bf16(y[0], y[1]), cvt_pk_bf16(y[2], y[3])}; } }
                if (xa) { ss += __shfl_xor(ss, 16); ss += __shfl_xor(ss, 32);
                    if (fq == 0) xl[(ai * HALF + wr * 64 + m * 16 + fr) * 4 + wc] = ss; } }
            asm volatile("" ::: "memory");
        }
        if (xa) {
            asm volatile("s_waitcnt lgkmcnt(0)" ::: "memory"); __builtin_amdgcn_s_barrier(); asm volatile("" ::: "memory");
            const int t = threadIdx.x;
            if (t < 256) { const f32x4 p = *(const PG8_LAS f32x4*)(xl + t * 4); ssq[(size_t)(rowt + t) * 8 + u.pn] = (p[0] + p[1]) + (p[2] + p[3]); }
        }
    }
};
template <int MODE>
struct EpiResGateNormB {
    static constexpr bool PERM = true, AFTER_DRAIN = false, OWN_ALIGN = true;
    const float* in0; const float* in1; float* out; const float* gate;
    bf16_t* xa; const float* gn; const float* sc; float* ssq; PG8_LAS float* xl;
    static __device__ __forceinline__ void unpack(u32x4 w, f32x4& lo, f32x4& hi) {
        lo = (f32x4){__uint_as_float(w.x << 16), __uint_as_float(w.x & 0xffff0000u), __uint_as_float(w.y << 16), __uint_as_float(w.y & 0xffff0000u)};
        hi = (f32x4){__uint_as_float(w.z << 16), __uint_as_float(w.z & 0xffff0000u), __uint_as_float(w.w << 16), __uint_as_float(w.w & 0xffff0000u)};
    }
    static __device__ __forceinline__ u32x4 pack(f32x4 lo, f32x4 hi) { u32x4 w; w.x = cvt_pk_bf16(lo[0], lo[1]); w.y = cvt_pk_bf16(lo[2], lo[3]); w.z = cvt_pk_bf16(hi[0], hi[1]); w.w = cvt_pk_bf16(hi[2], hi[3]); return w; }
    __device__ __forceinline__ void operator()(const f32x4 (&acc)[2][2][4][2], const Unit& u, int wr, int wc, int fr, int fq) const {
        const int rowt = u.pm * BM, row0 = rowt + wr * 64 + fr, col0 = u.pn * BM + wc * 32 + 8 * fq;
        const int seq = rowt < 32768 ? (rowt >> 11) : 16 + ((rowt - 32768) >> 13);
        const float* gp = gate + (size_t)seq * 12288 + col0;
        bf16_t* const xb = (bf16_t*)out + (size_t)row0 * 4096 + u.pn * 512 + wc * 32 + 8 * fq;
        f32x4 gv[2][2], av[2][2];
        if constexpr (MODE == 0) {
            typedef unsigned u32x2 __attribute__((ext_vector_type(2)));
            u32x2 dp[2][2][4][2];
#pragma unroll
            for (int bj = 0; bj < 2; ++bj)
#pragma unroll
                for (int n = 0; n < 2; ++n) gv[bj][n] = *(const f32x4*)(gp + bj * HALF + 4 * n);
            asm volatile("" ::: "memory"); if (wr == 0) __builtin_amdgcn_s_barrier(); asm volatile("" ::: "memory");
#pragma unroll
            for (int ai = 0; ai < 2; ++ai)
#pragma unroll
                for (int bj = 0; bj < 2; ++bj)
#pragma unroll
                    for (int m = 0; m < 4; ++m)
#pragma unroll
                        for (int n = 0; n < 2; ++n) { const f32x4 d = gv[bj][n] * acc[ai][bj][m][n]; dp[ai][bj][m][n] = (u32x2){cvt_pk_bf16(d[0], d[1]), cvt_pk_bf16(d[2], d[3])}; }
            asm volatile("" ::: "memory");
#pragma unroll
            for (int bj = 0; bj < 2; ++bj)
#pragma unroll
                for (int n = 0; n < 2; ++n) av[bj][n] = *(const f32x4*)(sc + (size_t)seq * 12288 + col0 + bj * HALF + 4 * n);
            const float* base = rowt < 32768 ? in0 : in1 - (size_t)32768 * 2048;
#pragma unroll
            for (int ai = 0; ai < 2; ++ai) {
                f32x4 bsv[4][2][2];
#pragma unroll
                for (int m = 0; m < 4; ++m)
#pragma unroll
                    for (int bj = 0; bj < 2; ++bj)
#pragma unroll
                        for (int n = 0; n < 2; ++n) bsv[m][bj][n] = *(const f32x4*)(base + (size_t)(row0 + ai * HALF + m * 16) * 2048 + col0 + bj * HALF + 4 * n);
                asm volatile("" ::: "memory");
#pragma unroll
                for (int m = 0; m < 4; ++m) { const size_t off = (size_t)(row0 + ai * HALF + m * 16) * 2048 + col0; float ss = 0.f;
#pragma unroll
                    for (int bj = 0; bj < 2; ++bj) { f32x4 o[2];
#pragma unroll
                        for (int n = 0; n < 2; ++n) { const u32x2 dq = dp[ai][bj][m][n];
                            const f32x4 d = {__uint_as_float(dq.x << 16), __uint_as_float(dq.x & 0xffff0000u), __uint_as_float(dq.y << 16), __uint_as_float(dq.y & 0xffff0000u)};
                            o[n] = bsv[m][bj][n] + d; ss += (o[n][0] * o[n][0] + o[n][1] * o[n][1]) + (o[n][2] * o[n][2] + o[n][3] * o[n][3]); }
                        *(u32x4*)(xb + (size_t)(ai * HALF + m * 16) * 4096 + bj * HALF) = pack(o[0], o[1]);
                        *(u32x4*)(xa + off + bj * HALF) = pack(o[0] * av[bj][0], o[1] * av[bj][1]); }
                    ss += __shfl_xor(ss, 16); ss += __shfl_xor(ss, 32);
                    if (fq == 0) xl[(ai * HALF + wr * 64 + m * 16 + fr) * 4 + wc] = ss; }
                asm volatile("" ::: "memory");
            }
        } else {
            u32x4 xv[2][4][2], dpk[2][4][2];
#pragma unroll
            for (int bj = 0; bj < 2; ++bj)
#pragma unroll
                for (int n = 0; n < 2; ++n) gv[bj][n] = *(const f32x4*)(gp + bj * HALF + 4 * n);
#pragma unroll
            for (int m = 0; m < 4; ++m)
#pragma unroll
                for (int bj = 0; bj < 2; ++bj) xv[0][m][bj] = *(const u32x4*)(xb + (size_t)(m * 16) * 4096 + bj * HALF);
            asm volatile("" ::: "memory"); if (wr == 0) __builtin_amdgcn_s_barrier(); asm volatile("" ::: "memory");
#pragma unroll
            for (int ai = 0; ai < 2; ++ai)
#pragma unroll
                for (int m = 0; m < 4; ++m)
#pragma unroll
                    for (int bj = 0; bj < 2; ++bj) dpk[ai][m][bj] = pack(gv[bj][0] * acc[ai][bj][m][0], gv[bj][1] * acc[ai][bj][m][1]);
            asm volatile("" ::: "memory");
#pragma unroll
            for (int bj = 0; bj < 2; ++bj)
#pragma unroll
                for (int n = 0; n < 2; ++n) { if constexpr (MODE == 1) av[bj][n] = *(const f32x4*)(sc + (size_t)seq * 12288 + col0 + bj * HALF + 4 * n); else av[bj][n] = (f32x4){0.f, 0.f, 0.f, 0.f}; }
#pragma unroll
            for (int m = 0; m < 4; ++m)
#pragma unroll
                for (int bj = 0; bj < 2; ++bj) xv[1][m][bj] = *(const u32x4*)(xb + (size_t)(HALF + m * 16) * 4096 + bj * HALF);
            if constexpr (MODE == 2) { asm volatile("s_waitcnt vmcnt(0)" ::: "memory"); __builtin_amdgcn_s_barrier(); }
            asm volatile("" ::: "memory");
#pragma unroll
            for (int ai = 0; ai < 2; ++ai) {
#pragma unroll
                for (int m = 0; m < 4; ++m) { const size_t off = (size_t)(row0 + ai * HALF + m * 16) * 2048 + col0; float ss = 0.f;
#pragma unroll
                    for (int bj = 0; bj < 2; ++bj) { f32x4 o[2], d[2]; unpack(xv[ai][m][bj], o[0], o[1]); unpack(dpk[ai][m][bj], d[0], d[1]); o[0] += d[0]; o[1] += d[1];
                        if constexpr (MODE == 2) { *(f32x4*)(out + off + bj * HALF) = o[0]; *(f32x4*)(out + off + bj * HALF + 4) = o[1]; }
                        else {
#pragma unroll
                            for (int n = 0; n < 2; ++n) ss += (o[n][0] * o[n][0] + o[n][1] * o[n][1]) + (o[n][2] * o[n][2] + o[n][3] * o[n][3]);
                            *(u32x4*)(xb + (size_t)(ai * HALF + m * 16) * 4096 + bj * HALF) = pack(o[0], o[1]);
                            *(u32x4*)(xa + off + bj * HALF) = pack(o[0] * av[bj][0], o[1] * av[bj][1]); } }
                    if constexpr (MODE != 2) { ss += __shfl_xor(ss, 16); ss += __shfl_xor(ss, 32);
                        if (fq == 0) xl[(ai * HALF + wr * 64 + m * 16 + fr) * 4 + wc] = ss; } }
                asm volatile("" ::: "memory");
            }
        }
        if constexpr (MODE != 2) {
            asm volatile("s_waitcnt lgkmcnt(0)" ::: "memory"); __builtin_amdgcn_s_barrier(); asm volatile("" ::: "memory");
            const int t = threadIdx.x;
            if (t < 256) { const f32x4 p = *(const PG8_LAS f32x4*)(xl + t * 4); ssq[(size_t)(rowt + t) * 8 + u.pn] = (p[0] + p[1]) + (p[2] + p[3]); }
        }
    }
};
struct EpiBf16NRope {
    static constexpr bool PERM = true, AFTER_DRAIN = false, OWN_ALIGN = true;
    bf16_t* O; int ldc; const float* ssq; const float* bw; int ldbw;
    const float* qg; const float* kg; const float* rope; PG8_LAS float* hs;
    __device__ __forceinline__ void operator()(f32x4 (&acc)[2][2][4][2], const Unit& u, int wr, int wc, int fr, int fq) const {
        const int rowt = u.pm * BM, row0 = rowt + wr * 64 + fr, col0 = u.pn * BM + wc * 32 + 8 * fq;
        const int seq = rowt < 32768 ? (rowt >> 11) : 16 + ((rowt - 32768) >> 13);
        const bool roped = u.pn < 10;
        typedef float f32x2v __attribute__((ext_vector_type(2)));
        f32x2v pv[8]; f32x4 bv[2][2], gv[2];
#pragma unroll
        for (int i = 0; i < 8; ++i) pv[i] = *(const f32x2v*)(ssq + (size_t)(row0 + (i >> 2) * HALF + (i & 3) * 16) * 8 + 2 * fq);
#pragma unroll
        for (int bj = 0; bj < 2; ++bj)
#pragma unroll
            for (int n = 0; n < 2; ++n) bv[bj][n] = *(const f32x4*)(bw + (size_t)seq * ldbw + col0 + bj * HALF + 4 * n);
        { const float* g = (u.pn < 8 ? qg : kg) + wc * 32 + 8 * fq; gv[0] = *(const f32x4*)g; gv[1] = *(const f32x4*)(g + 4); }
        asm volatile("" ::: "memory"); if (wr == 0) __builtin_amdgcn_s_barrier(); asm volatile("" ::: "memory");
        float rs[8];
#pragma unroll
        for (int i = 0; i < 8; ++i) { float s = pv[i].x + pv[i].y; s += __shfl_xor(s, 16); s += __shfl_xor(s, 32); rs[i] = __builtin_amdgcn_rsqf(s * (1.f / 2048.f) + 1e-6f); }
#pragma unroll
        for (int ai = 0; ai < 2; ++ai)
#pragma unroll
            for (int m = 0; m < 4; ++m)
#pragma unroll
                for (int bj = 0; bj < 2; ++bj) { const float rsr = rs[ai * 4 + m];
                    acc[ai][bj][m][0] = acc[ai][bj][m][0] * rsr + bv[bj][0]; acc[ai][bj][m][1] = acc[ai][bj][m][1] * rsr + bv[bj][1];
                    if (roped) { const f32x4 a = acc[ai][bj][m][0], b = acc[ai][bj][m][1];
                        float s = ((a[0] * a[0] + a[1] * a[1]) + (a[2] * a[2] + a[3] * a[3])) + ((b[0] * b[0] + b[1] * b[1]) + (b[2] * b[2] + b[3] * b[3]));
                        s += __shfl_xor(s, 16); s += __shfl_xor(s, 32);
                        if (fq == 0) hs[((ai * HALF + wr * 64 + m * 16 + fr) * 2 + bj) * 4 + wc] = s; } }
        if (roped) { asm volatile("s_waitcnt lgkmcnt(0)" ::: "memory"); __builtin_amdgcn_s_barrier(); asm volatile("" ::: "memory"); }
#pragma unroll
        for (int ai = 0; ai < 2; ++ai) {
            f32x4 cs[4][2];
            if (roped) {
#pragma unroll
                for (int m = 0; m < 4; ++m) { const int r = row0 + ai * HALF + m * 16, t = r < 32768 ? (r & 2047) : (r & 8191);
                    const float* rp = rope + (size_t)((wc < 2 ? (t >> 6) : 128 + (t & 63)) * 32 + (wc & 1) * 16 + 4 * fq) * 2;
                    cs[m][0] = *(const f32x4*)rp; cs[m][1] = *(const f32x4*)(rp + 4); }
            }
#pragma unroll
            for (int m = 0; m < 4; ++m) { const int r = row0 + ai * HALF + m * 16; bf16_t* rowp = O + (size_t)r * ldc + col0;
#pragma unroll
                for (int bj = 0; bj < 2; ++bj) { f32x4 v0 = acc[ai][bj][m][0], v1 = acc[ai][bj][m][1];
                    if (roped) { const f32x4 hp = *(const PG8_LAS f32x4*)(hs + ((ai * HALF + wr * 64 + m * 16 + fr) * 2 + bj) * 4);
                        const float hr = __builtin_amdgcn_rsqf(((hp[0] + hp[1]) + (hp[2] + hp[3])) * (1.f / 128.f) + 1e-6f);
                        v0 = v0 * hr * gv[0]; v1 = v1 * hr * gv[1];
                        const f32x4 c0 = cs[m][0], c1 = cs[m][1];
                        const float a0 = v0[0] * c0[0] - v0[1] * c0[1], a1 = v0[0] * c0[1] + v0[1] * c0[0], a2 = v0[2] * c0[2] - v0[3] * c0[3], a3 = v0[2] * c0[3] + v0[3] * c0[2];
                        const float b0 = v1[0] * c1[0] - v1[1] * c1[1], b1 = v1[0] * c1[1] + v1[1] * c1[0], b2 = v1[2] * c1[2] - v1[3] * c1[3], b3 = v1[2] * c1[3] + v1[3] * c1[2];
                        v0 = (f32x4){a0, a1, a2, a3}; v1 = (f32x4){b0, b1, b2, b3}; }
                    u32x4 w; w.x = cvt_pk_bf16(v0[0], v0[1]); w.y = cvt_pk_bf16(v0[2], v0[3]); w.z = cvt_pk_bf16(v1[0], v1[1]); w.w = cvt_pk_bf16(v1[2], v1[3]);
                    *(u32x4*)(rowp + bj * HALF) = w; } }
        }
    }
};
struct EpiBf16KV {
    static constexpr bool PERM = true, AFTER_DRAIN = false, OWN_ALIGN = false;
    bf16_t* O; int ldc; const float* kg; PG8_LAS float* hs;
    __device__ __forceinline__ void operator()(const f32x4 (&acc)[2][2][4][2], const Unit& u, int wr, int wc, int fr, int fq) const {
        const int row0 = u.pm * BM + wr * 64 + fr, col0 = u.pn * BM + wc * 32 + 8 * fq;
        const f32x4 g0 = *(const f32x4*)(kg + wc * 32 + 8 * fq), g1 = *(const f32x4*)(kg + wc * 32 + 8 * fq + 4);
#pragma unroll
        for (int ai = 0; ai < 2; ++ai)
#pragma unroll
            for (int m = 0; m < 4; ++m) { const f32x4 a = acc[ai][0][m][0], b = acc[ai][0][m][1];
                float s = ((a[0] * a[0] + a[1] * a[1]) + (a[2] * a[2] + a[3] * a[3])) + ((b[0] * b[0] + b[1] * b[1]) + (b[2] * b[2] + b[3] * b[3]));
                s += __shfl_xor(s, 16); s += __shfl_xor(s, 32);
                if (fq == 0) hs[(ai * HALF + wr * 64 + m * 16 + fr) * 4 + wc] = s; }
#pragma unroll
        for (int ai = 0; ai < 2; ++ai)
#pragma unroll
            for (int m = 0; m < 4; ++m) { bf16_t* rowp = O + (size_t)(row0 + ai * HALF + m * 16) * ldc + col0 + HALF;
                const f32x4 v0 = acc[ai][1][m][0], v1 = acc[ai][1][m][1];
                u32x4 w; w.x = cvt_pk_bf16(v0[0], v0[1]); w.y = cvt_pk_bf16(v0[2], v0[3]); w.z = cvt_pk_bf16(v1[0], v1[1]); w.w = cvt_pk_bf16(v1[2], v1[3]); *(u32x4*)rowp = w; }
        asm volatile("s_waitcnt lgkmcnt(0)" ::: "memory"); __builtin_amdgcn_s_barrier(); asm volatile("" ::: "memory");
#pragma unroll
        for (int ai = 0; ai < 2; ++ai)
#pragma unroll
            for (int m = 0; m < 4; ++m) { bf16_t* rowp = O + (size_t)(row0 + ai * HALF + m * 16) * ldc + col0;
                const f32x4 hp = *(const PG8_LAS f32x4*)(hs + (ai * HALF + wr * 64 + m * 16 + fr) * 4);
                const float hr = __builtin_amdgcn_rsqf(((hp[0] + hp[1]) + (hp[2] + hp[3])) * (1.f / 128.f) + 1e-6f);
                const f32x4 v0 = acc[ai][0][m][0] * hr * g0, v1 = acc[ai][0][m][1] * hr * g1;
                u32x4 w; w.x = cvt_pk_bf16(v0[0], v0[1]); w.y = cvt_pk_bf16(v0[2], v0[3]); w.z = cvt_pk_bf16(v1[0], v1[1]); w.w = cvt_pk_bf16(v1[2], v1[3]); *(u32x4*)rowp = w; }
    }
};
struct EpiBf16P {
    static constexpr bool PERM = true, AFTER_DRAIN = false, OWN_ALIGN = false;
    bf16_t* O; int ldc;
    __device__ __forceinline__ void operator()(const f32x4 (&acc)[2][2][4][2], const Unit& u, int wr, int wc, int fr, int fq) const {
        const int row0 = u.pm * BM + wr * 64 + fr, col0 = u.pn * BM + wc * 32 + 8 * fq;
#pragma unroll
        for (int ai = 0; ai < 2; ++ai)
#pragma unroll
            for (int m = 0; m < 4; ++m) { bf16_t* rowp = O + (size_t)(row0 + ai * HALF + m * 16) * ldc + col0;
#pragma unroll
                for (int bj = 0; bj < 2; ++bj) { const f32x4 v0 = acc[ai][bj][m][0], v1 = acc[ai][bj][m][1];
                    u32x4 w; w.x = cvt_pk_bf16(v0[0], v0[1]); w.y = cvt_pk_bf16(v0[2], v0[3]); w.z = cvt_pk_bf16(v1[0], v1[1]); w.w = cvt_pk_bf16(v1[2], v1[3]);
                    *(u32x4*)(rowp + bj * HALF) = w; } }
    }
};
template <class Epi, class Sched, bool ALIGN_EPI = false, bool SP2 = false>
__device__ __forceinline__ void gemm_phase(PG8_LAS unsigned char* lds, const Gemm g, const Sched& S, const Epi& E) {
    const int tid = threadIdx.x, wid = __builtin_amdgcn_readfirstlane(tid >> 6), lane = tid & 63, wr = wid >> 2, wc = wid & 3, fr = lane & 15, fq = lane >> 4;
    const int K = g.K, nt = K / BK;
    unsigned voffA[2], voffB[2];
#pragma unroll
    for (int i = 0; i < 2; ++i) { int R, C; stage_rc(tid * 16 + i * 8192, R, C); const int Rb = Epi::PERM ? ((R & ~31) + perm32(R & 31)) : R;
        voffA[i] = (unsigned)(R * g.lda + C) * 2u; voffB[i] = (unsigned)(Rb * K + C) * 2u; }
    const size_t kstep = (size_t)(BK * 2);
    const size_t hstepB = (size_t)HALF * K * 2, hstepA = (size_t)HALF * g.lda * 2;
    const size_t tstepA = 2 * hstepA, tstepB = 2 * hstepB;
    const unsigned ldsw = (unsigned)wid * 1024u;
    const int aoff = lds_byte(wr * 64 + fr, fq * 8), boff = lds_byte(wc * 32 + fr, fq * 8);
#define PG8_SA(b, h) (((b) * 2 + (h)) * HTB)
#define PG8_SB(b, h) ((4 + (b) * 2 + (h)) * HTB)
#define PG8_STAGE(bufoff, gbase, voff) do { _Pragma("unroll") for (int _i = 0; _i < 2; ++_i) \
        __builtin_amdgcn_global_load_lds((const unsigned*)((const char*)(gbase) + (voff)[_i]), (PG8_LAS unsigned*)(lds + (bufoff) + ldsw + _i * 8192), 16, 0, 0); } while (0)
#define PG8_LDA(dst, b, h) do { _Pragma("unroll") for (int m = 0; m < 4; ++m) _Pragma("unroll") for (int k = 0; k < 2; ++k) dst[m][k] = *(const PG8_LAS bf16x8*)(lds + PG8_SA(b, h) + aoff + m * 2048 + k * 1024); } while (0)
#define PG8_LDB(dst, b, h) do { _Pragma("unroll") for (int n = 0; n < 2; ++n) _Pragma("unroll") for (int k = 0; k < 2; ++k) dst[n][k] = *(const PG8_LAS bf16x8*)(lds + PG8_SB(b, h) + boff + n * 2048 + k * 1024); } while (0)
#define PG8_MMA(ai, bj, At, Bt) do { __builtin_amdgcn_s_setprio(1); _Pragma("unroll") for (int m = 0; m < 4; ++m) _Pragma("unroll") for (int n = 0; n < 2; ++n) _Pragma("unroll") for (int k = 0; k < 2; ++k) \
        acc[ai][bj][m][n] = __builtin_amdgcn_mfma_f32_16x16x32_bf16(Bt[n][k], At[m][k], acc[ai][bj][m][n], 0, 0, 0); __builtin_amdgcn_s_setprio(0); } while (0)
#define PG8_WAIT_V(n) asm volatile("s_waitcnt vmcnt(" #n ")" ::: "memory")
#define PG8_WAIT_L(n) asm volatile("s_waitcnt lgkmcnt(" #n ")" ::: "memory")
#define PG8_BAR __builtin_amdgcn_s_barrier()
#define PG8_SCHED __builtin_amdgcn_sched_barrier(0)
    Unit cur, nxt; int ui = 0;
    if (!S.next(0, cur)) return;
    f32x4 acc[2][2][4][2];
#pragma unroll
    for (int a = 0; a < 2; ++a)
#pragma unroll
        for (int b = 0; b < 2; ++b)
#pragma unroll
            for (int m = 0; m < 4; ++m)
#pragma unroll
                for (int n = 0; n < 2; ++n) acc[a][b][m][n] = (f32x4){0.f, 0.f, 0.f, 0.f};
    bf16x8 At[4][2], B0[2][2], B1[2][2];
    const char* cA = (const char*)g.A + (size_t)cur.pm * tstepA; const char* cB = (const char*)g.Bt + (size_t)cur.pn * tstepB;
    S.a_ready(cur);
    if constexpr (SP2) {
        PG8_STAGE(PG8_SB(0, 0), cB, voffB); PG8_STAGE(PG8_SB(0, 1), cB + hstepB, voffB); PG8_STAGE(PG8_SA(0, 0), cA, voffA); PG8_STAGE(PG8_SA(0, 1), cA + hstepA, voffA);
        if (wr == 1) PG8_BAR;
        PG8_WAIT_V(2); PG8_BAR;
        PG8_STAGE(PG8_SB(1, 0), cB + kstep, voffB); PG8_STAGE(PG8_SA(1, 0), cA + kstep, voffA); PG8_STAGE(PG8_SB(1, 1), cB + hstepB + kstep, voffB);
        PG8_WAIT_V(6); PG8_BAR;
    } else {
        PG8_STAGE(PG8_SB(0, 0), cB, voffB); PG8_STAGE(PG8_SA(0, 0), cA, voffA); PG8_STAGE(PG8_SB(0, 1), cB + hstepB, voffB); PG8_STAGE(PG8_SA(0, 1), cA + hstepA, voffA);
        if (wr == 1) PG8_BAR;
        PG8_WAIT_V(4); PG8_BAR;
        PG8_STAGE(PG8_SB(1, 0), cB + kstep, voffB); PG8_STAGE(PG8_SA(1, 0), cA + kstep, voffA); PG8_STAGE(PG8_SB(1, 1), cB + hstepB + kstep, voffB);
        PG8_WAIT_V(6); PG8_BAR;
    }
    for (;;) {
        const bool has_next = S.next(ui + 1, nxt);
        const char* nA = has_next ? (const char*)g.A + (size_t)nxt.pm * tstepA : cA; const char* nB = has_next ? (const char*)g.Bt + (size_t)nxt.pn * tstepB : cB;
        for (int t = 0; t < nt; t += 2) {
            const bool last = (t == nt - 2);
            const char* a1 = cA + (size_t)(t >> 1) * g.pairA + kstep;
            const char* a2 = last ? nA : cA + (size_t)((t >> 1) + 1) * g.pairA; const char* b2 = last ? nB : cB + (size_t)(t + 2) * kstep;
            const char* a3 = a2 + kstep; const char* b3 = b2 + kstep;
            if (last && has_next) S.a_ready(nxt);
            if constexpr (SP2) {
            PG8_LDB(B0, 0, 0); PG8_LDB(B1, 0, 1); PG8_SCHED; PG8_LDA(At, 0, 0); PG8_STAGE(PG8_SA(1, 1), a1 + hstepA, voffA);
            PG8_WAIT_V(8); PG8_WAIT_L(0); PG8_BAR; PG8_MMA(0, 0, At, B0); PG8_MMA(0, 1, At, B1); PG8_BAR; PG8_SCHED;
            PG8_LDA(At, 0, 1); PG8_STAGE(PG8_SB(0, 0), b2, voffB); PG8_STAGE(PG8_SB(0, 1), b2 + hstepB, voffB); PG8_STAGE(PG8_SA(0, 0), a2, voffA);
            PG8_WAIT_V(8); PG8_WAIT_L(0); PG8_BAR; PG8_MMA(1, 0, At, B0); PG8_MMA(1, 1, At, B1); PG8_BAR; PG8_SCHED;
            PG8_LDB(B0, 1, 0); PG8_LDB(B1, 1, 1); PG8_SCHED; PG8_LDA(At, 1, 0); PG8_STAGE(PG8_SA(0, 1), a2 + hstepA, voffA);
            PG8_WAIT_V(8); PG8_WAIT_L(0); PG8_BAR; PG8_MMA(0, 0, At, B0); PG8_MMA(0, 1, At, B1); PG8_BAR; PG8_SCHED;
            PG8_LDA(At, 1, 1); PG8_STAGE(PG8_SB(1, 0), b3, voffB); PG8_STAGE(PG8_SB(1, 1), b3 + hstepB, voffB); PG8_STAGE(PG8_SA(1, 0), a3, voffA);
            PG8_WAIT_V(8); PG8_WAIT_L(0); PG8_BAR; PG8_MMA(1, 0, At, B0); PG8_MMA(1, 1, At, B1); PG8_BAR; PG8_SCHED;
            } else {
            PG8_LDB(B0, 0, 0); PG8_SCHED; PG8_LDA(At, 0, 0); PG8_STAGE(PG8_SA(1, 1), a1 + hstepA, voffA);
            PG8_WAIT_L(8); PG8_BAR; PG8_WAIT_L(0); PG8_MMA(0, 0, At, B0); PG8_BAR; PG8_SCHED;
            PG8_LDB(B1, 0, 1); PG8_STAGE(PG8_SB(0, 0), b2, voffB);
            PG8_BAR; PG8_WAIT_L(0); PG8_MMA(0, 1, At, B1); PG8_BAR;
            PG8_LDA(At, 0, 1); PG8_STAGE(PG8_SA(0, 0), a2, voffA);
            PG8_BAR; PG8_WAIT_L(0); PG8_MMA(1, 0, At, B0); PG8_BAR; PG8_SCHED;
            PG8_STAGE(PG8_SB(0, 1), b2 + hstepB, voffB);
            PG8_WAIT_V(6); PG8_BAR; PG8_MMA(1, 1, At, B1); PG8_BAR;
            PG8_LDB(B0, 1, 0); PG8_SCHED; PG8_LDA(At, 1, 0); PG8_STAGE(PG8_SA(0, 1), a2 + hstepA, voffA);
            PG8_WAIT_L(8); PG8_BAR; PG8_WAIT_L(0); PG8_MMA(0, 0, At, B0); PG8_BAR; PG8_SCHED;
            PG8_LDB(B1, 1, 1); PG8_STAGE(PG8_SB(1, 0), b3, voffB);
            PG8_BAR; PG8_WAIT_L(0); PG8_MMA(0, 1, At, B1); PG8_BAR;
            PG8_LDA(At, 1, 1); PG8_STAGE(PG8_SA(1, 0), a3, voffA);
            PG8_BAR; PG8_WAIT_L(0); PG8_MMA(1, 0, At, B0); PG8_BAR; PG8_SCHED;
            PG8_STAGE(PG8_SB(1, 1), b3 + hstepB, voffB);
            PG8_WAIT_V(6); PG8_BAR; PG8_MMA(1, 1, At, B1); PG8_BAR;
            }
        }
        if constexpr (ALIGN_EPI && !Epi::OWN_ALIGN) { if (wr == 0) PG8_BAR; }
        if constexpr (!Epi::AFTER_DRAIN) { E(acc, cur, wr, wc, fr, fq); S.done(cur); }
        if (!has_next) break;
#pragma unroll
        for (int a = 0; a < 2; ++a)
#pragma unroll
            for (int b = 0; b < 2; ++b)
#pragma unroll
                for (int m = 0; m < 4; ++m)
#pragma unroll
                    for (int n = 0; n < 2; ++n) acc[a][b][m][n] = (f32x4){0.f, 0.f, 0.f, 0.f};
        cur = nxt; cA = nA; cB = nB; ++ui;
        if constexpr (ALIGN_EPI) { if (wr == 1) PG8_BAR; }
    }
    PG8_WAIT_V(0);
    if constexpr (!ALIGN_EPI) { if (wr == 0) PG8_BAR; }
    PG8_BAR;
    if constexpr (Epi::AFTER_DRAIN) { E.fused(acc, cur, wr, wc, fr, fq, lds, wid, lane); S.done(cur); }
#undef PG8_SA
#undef PG8_SB
#undef PG8_STAGE
#undef PG8_LDA
#undef PG8_LDB
#undef PG8_MMA
#undef PG8_WAIT_V
#undef PG8_WAIT_L
#undef PG8_BAR
#undef PG8_SCHED
}
}

namespace attn {
using bf16x8 = __attribute__((ext_vector_type(8))) short;
using s16x4  = __attribute__((ext_vector_type(4))) short;
using f32x16 = __attribute__((ext_vector_type(16))) float;
using u32x4  = __attribute__((ext_vector_type(4))) unsigned;
using f32x4  = __attribute__((ext_vector_type(4))) float;
constexpr int NW = 8, QBLK = 32, KVBLK = 64;
constexpr float THR = 8.f;
#define SBAR() __builtin_amdgcn_sched_barrier(0)
__device__ __forceinline__ int crow(int r, int hi) { return (r & 3) + 8 * (r >> 2) + 4 * hi; }
__device__ __forceinline__ unsigned cvtpk(float lo, float hi) { unsigned r; asm volatile("v_cvt_pk_bf16_f32 %0, %1, %2\n\ts_nop 1" : "=v"(r) : "v"(lo), "v"(hi)); return r; }
template <bool VIS> __device__ __forceinline__ unsigned cvtpk_t(float lo, float hi) { if constexpr (VIS) return ::pk2c(lo, hi); else return cvtpk(lo, hi); }

template <int DQK> struct Cfg {
    static constexpr int KROW = DQK * 2;
    static constexpr int SHM_K = KVBLK * KROW, SHM_V = KVBLK * 128 * 2;
    static constexpr int NQR = DQK == 128 ? 8 : 6;
    static constexpr int QX_WAVE = (DQK / 16 - NQR) * 1024;
    static constexpr int SHM = 2 * SHM_V + 2 * SHM_K + NW * 64 * 4 + NW * QX_WAVE;
    static constexpr float SCALE = DQK == 128 ? 0.088388347648318440f : 0.072168783648703220f;
    static constexpr float C = SCALE * 1.4426950408889634f;
};
template <int DQK> __device__ __forceinline__ int kswz(int row, int colB) { return row * (DQK * 2) + (colB ^ ((row & 7) << 4)); }

template <int DQK> __device__ __forceinline__ void partialSM(f32x16& p0, f32x16& p1, float& m_reg, float& mn, float& alpha) {
  constexpr float C = Cfg<DQK>::C, SCALE = Cfg<DQK>::SCALE;
  float pmax = p0[0];
#pragma unroll
  for (int r = 1; r < 16; ++r) pmax = fmaxf(pmax, p0[r]);
#pragma unroll
  for (int r = 0; r < 16; ++r) pmax = fmaxf(pmax, p1[r]);
  { auto rr = __builtin_amdgcn_permlane32_swap(__float_as_uint(pmax), __float_as_uint(pmax), false, false);
    pmax = fmaxf(__uint_as_float(rr[0]), __uint_as_float(rr[1])); }
  if (__builtin_expect(__all(pmax - m_reg <= THR / SCALE), 1)) { mn = m_reg; alpha = 1.f; }
  else { mn = fmaxf(m_reg, pmax); alpha = __builtin_amdgcn_exp2f((m_reg - mn) * C); m_reg = mn; }
  float mnC = -mn * C;
#pragma unroll
  for (int r = 0; r < 16; ++r) p0[r] = fmaf(p0[r], C, mnC);
#pragma unroll
  for (int r = 0; r < 16; ++r) p1[r] = fmaf(p1[r], C, mnC);
#pragma unroll
  for (int r = 0; r < 16; ++r) p0[r] = __builtin_amdgcn_exp2f(p0[r]);
}
template <bool VIS> __device__ __forceinline__ void finishSM(f32x16& p0, f32x16& p1, float alpha, float& l_reg, bf16x8& pa0, bf16x8& pa1, bf16x8& pa2, bf16x8& pa3) {
#pragma unroll
  for (int r = 0; r < 16; ++r) p1[r] = __builtin_amdgcn_exp2f(p1[r]);
  float ps = 0;
#pragma unroll
  for (int r = 0; r < 16; ++r) ps += p0[r];
#pragma unroll
  for (int r = 0; r < 16; ++r) ps += p1[r];
  { auto rr = __builtin_amdgcn_permlane32_swap(__float_as_uint(ps), __float_as_uint(ps), false, false);
    ps = __uint_as_float(rr[0]) + __uint_as_float(rr[1]); }
  l_reg = l_reg * alpha + ps;
#define PK4(P, BASE, OUT) do { unsigned a0 = cvtpk_t<VIS>(P[BASE + 0], P[BASE + 1]), a1 = cvtpk_t<VIS>(P[BASE + 2], P[BASE + 3]);   \
    unsigned b0 = cvtpk_t<VIS>(P[BASE + 4], P[BASE + 5]), b1 = cvtpk_t<VIS>(P[BASE + 6], P[BASE + 7]);                              \
    auto r0 = __builtin_amdgcn_permlane32_swap(a0, b0, false, false); auto r1 = __builtin_amdgcn_permlane32_swap(a1, b1, false, false); \
    u32x4 w = {r0[0], r1[0], r0[1], r1[1]}; OUT = *reinterpret_cast<bf16x8*>(&w); } while (0)
  PK4(p0, 0, pa0); PK4(p0, 8, pa1); PK4(p1, 0, pa2); PK4(p1, 8, pa3);
#undef PK4
}
template <int DQK, int NQR> __device__ __forceinline__ void qkt(f32x16& p0, f32x16& p1, const char* Ks, const bf16x8* qr, const char* qx, int r32, int hi) {
  p0 = f32x16{}; p1 = f32x16{};
#pragma unroll
  for (int d0 = 0; d0 < DQK / 16; ++d0) { const int cb = (d0 * 16 + hi * 8) * 2;
    bf16x8 b0 = *reinterpret_cast<const bf16x8*>(Ks + kswz<DQK>(r32, cb));
    bf16x8 b1 = *reinterpret_cast<const bf16x8*>(Ks + kswz<DQK>(32 + r32, cb));
    bf16x8 q; if (d0 < NQR) q = qr[d0]; else q = *reinterpret_cast<const bf16x8*>(qx + (d0 - NQR) * 1024);
    p0 = __builtin_amdgcn_mfma_f32_32x32x16_bf16(b0, q, p0, 0, 0, 0);
    p1 = __builtin_amdgcn_mfma_f32_32x32x16_bf16(b1, q, p1, 0, 0, 0);
    if (DQK > 128 && (d0 & 3) == 3 && d0 + 1 < DQK / 16) SBAR(); }
}
__device__ __forceinline__ int v_st(int k, int c) { const int kk = (k & ~0xC) | ((k & 4) << 1) | ((k & 8) >> 1); return ((kk >> 3) * 4 + (c >> 5)) * 512 + ((kk & 7) * 32 + (c & 31)) * 2; }
__device__ __forceinline__ int v_rd_base(int lane) { return ((lane & 3) << 3) | (((lane >> 2) & 3) << 6) | (((lane >> 4) & 1) << 5) | (((lane >> 5) & 1) << 8); }
constexpr int v_rd_off(int d0, int ks, int half) { return d0 * 512 + ks * 4096 + half * 2048; }
template <int OFF> __device__ __forceinline__ s16x4 tr_read(int vb) {
  s16x4 r; asm volatile("ds_read_b64_tr_b16 %0, %1 offset:%2" : "=&v"(r) : "v"(vb), "i"(OFF) : "memory"); return r;
}
template <int D0> __device__ __forceinline__ void pv_one(f32x16& od, int vb, bf16x8 pa0, bf16x8 pa1, bf16x8 pa2, bf16x8 pa3) {
  const s16x4 l0 = tr_read<v_rd_off(D0, 0, 0)>(vb), h0 = tr_read<v_rd_off(D0, 0, 1)>(vb), l1 = tr_read<v_rd_off(D0, 1, 0)>(vb), h1 = tr_read<v_rd_off(D0, 1, 1)>(vb);
  const s16x4 l2 = tr_read<v_rd_off(D0, 2, 0)>(vb), h2 = tr_read<v_rd_off(D0, 2, 1)>(vb), l3 = tr_read<v_rd_off(D0, 3, 0)>(vb), h3 = tr_read<v_rd_off(D0, 3, 1)>(vb);
  asm volatile("s_waitcnt lgkmcnt(0)" ::: "memory"); SBAR();
#define PK(L, H) (bf16x8){L[0], L[1], L[2], L[3], H[0], H[1], H[2], H[3]}
  od = __builtin_amdgcn_mfma_f32_32x32x16_bf16(pa0, PK(l0, h0), od, 0, 0, 0);
  od = __builtin_amdgcn_mfma_f32_32x32x16_bf16(pa1, PK(l1, h1), od, 0, 0, 0);
  od = __builtin_amdgcn_mfma_f32_32x32x16_bf16(pa2, PK(l2, h2), od, 0, 0, 0);
  od = __builtin_amdgcn_mfma_f32_32x32x16_bf16(pa3, PK(l3, h3), od, 0, 0, 0);
#undef PK
}
__device__ __forceinline__ void pv_d0(f32x16* o, int vb, bf16x8 pa0, bf16x8 pa1, bf16x8 pa2, bf16x8 pa3) {
  pv_one<0>(o[0], vb, pa0, pa1, pa2, pa3); pv_one<1>(o[1], vb, pa0, pa1, pa2, pa3); pv_one<2>(o[2], vb, pa0, pa1, pa2, pa3); pv_one<3>(o[3], vb, pa0, pa1, pa2, pa3);
}

template <int DQK, int LDQ, int LDK, int LDKR, int LDV, int LDO, int SDEPTH, bool QNORM = false>
__device__ __forceinline__ void attn_dense_body(const bf16* __restrict__ Qb, const bf16* __restrict__ Kh, const bf16* __restrict__ KRh, const bf16* __restrict__ Vh,
                                                bf16* __restrict__ Ob, int seq, char* lds, const float* qgain = nullptr, const float* ropetab = nullptr, int tq0 = 0) {
  constexpr int SHM_V = Cfg<DQK>::SHM_V, SHM_K = Cfg<DQK>::SHM_K; constexpr float SCALE = Cfg<DQK>::SCALE;
  constexpr bool ROPE = (DQK == 192);
  const int tid = threadIdx.x, wid = tid >> 6, lane = tid & 63, r32 = lane & 31, hi = lane >> 5;
  char* V_lds = lds; char* K_lds = lds + 2 * SHM_V;
  float* ws = (float*)(lds + 2 * SHM_V + 2 * SHM_K) + wid * 64; float* li_l = ws; float* al_l = ws + 32;
  constexpr int NQR = Cfg<DQK>::NQR;
  float m_reg = -1e30f, l_reg = 0; f32x16 o[4] = {}; bf16x8 qr[NQR];
  const bf16* Qw = Qb + (long)(wid * QBLK + r32) * LDQ + hi * 8;
  char* qx = lds + 2 * SHM_V + 2 * SHM_K + NW * 64 * 4 + wid * Cfg<DQK>::QX_WAVE + lane * 16;
  if constexpr (!QNORM) {
#pragma unroll
    for (int d0 = 0; d0 < NQR; ++d0) qr[d0] = *reinterpret_cast<const bf16x8*>(Qw + d0 * 16);
#pragma unroll
    for (int d0 = NQR; d0 < DQK / 16; ++d0) *reinterpret_cast<bf16x8*>(qx + (d0 - NQR) * 1024) = *reinterpret_cast<const bf16x8*>(Qw + d0 * 16);
  } else {
    float ss = 0.f;
#pragma unroll
    for (int d0 = 0; d0 < DQK / 16; ++d0) { const u32x4 rw = *reinterpret_cast<const u32x4*>(Qw + d0 * 16);
#pragma unroll
      for (int w = 0; w < 4; ++w) { const float a = __uint_as_float(rw[w] << 16), b = __uint_as_float(rw[w] & 0xffff0000u); ss += a * a + b * b; } }
    asm volatile("" ::: "memory");
    { auto rr = __builtin_amdgcn_permlane32_swap(__float_as_uint(ss), __float_as_uint(ss), false, false); ss = __uint_as_float(rr[0]) + __uint_as_float(rr[1]); }
    const float rsn = __builtin_amdgcn_rsqf(ss * (1.f / DQK) + 1e-6f);
    const int tpos = tq0 + wid * QBLK + r32, eri = tpos >> 6, eci = 128 + (tpos & 63);
#pragma unroll
    for (int d0 = 0; d0 < DQK / 16; ++d0) {
      const f32x4 g0 = *reinterpret_cast<const f32x4*>(qgain + d0 * 16 + hi * 8), g1 = *reinterpret_cast<const f32x4*>(qgain + d0 * 16 + hi * 8 + 4);
      const u32x4 rw = *reinterpret_cast<const u32x4*>(Qw + d0 * 16);
      float x[8];
#pragma unroll
      for (int w = 0; w < 4; ++w) { x[2 * w] = __uint_as_float(rw[w] << 16) * rsn; x[2 * w + 1] = __uint_as_float(rw[w] & 0xffff0000u) * rsn; }
      x[0] *= g0[0]; x[1] *= g0[1]; x[2] *= g0[2]; x[3] *= g0[3]; x[4] *= g1[0]; x[5] *= g1[1]; x[6] *= g1[2]; x[7] *= g1[3];
      if (d0 >= 8) {
        const float* rp = ropetab + (size_t)((d0 < 10 ? eri : eci) * 16 + ((d0 - 8) & 1) * 8 + hi * 4) * 2;
        const f32x4 c0 = *reinterpret_cast<const f32x4*>(rp), c1 = *reinterpret_cast<const f32x4*>(rp + 4);
        const float a0 = x[0] * c0[0] - x[1] * c0[1], a1 = x[0] * c0[1] + x[1] * c0[0], a2 = x[2] * c0[2] - x[3] * c0[3], a3 = x[2] * c0[3] + x[3] * c0[2];
        const float a4 = x[4] * c1[0] - x[5] * c1[1], a5 = x[4] * c1[1] + x[5] * c1[0], a6 = x[6] * c1[2] - x[7] * c1[3], a7 = x[6] * c1[3] + x[7] * c1[2];
        x[0] = a0; x[1] = a1; x[2] = a2; x[3] = a3; x[4] = a4; x[5] = a5; x[6] = a6; x[7] = a7;
      }
      u32x4 w4 = {cvtpk(x[0], x[1]), cvtpk(x[2], x[3]), cvtpk(x[4], x[5]), cvtpk(x[6], x[7])};
      if (d0 < NQR) qr[d0 < NQR ? d0 : 0] = *reinterpret_cast<bf16x8*>(&w4); else *reinterpret_cast<bf16x8*>(qx + (d0 - NQR) * 1024) = *reinterpret_cast<bf16x8*>(&w4);
    }
  }
  const int sr = tid >> 4, sc = (tid & 15) * 8, vst0 = v_st(sr, sc), vst1 = v_st(32 + sr, sc);
  const int rr = tid >> 3, rc = (tid & 7) * 8;
  const int vb0 = (int)(uintptr_t)V_lds + v_rd_base(lane);
  struct { bf16x8 vs0, vs1, ks0, ks1, kr; } sr_[SDEPTH];
  const unsigned offV = (unsigned)(sr * LDV + sc) * 2u, offK = (unsigned)(sr * LDK + sc) * 2u, offR = (unsigned)(rr * LDKR + rc) * 2u;
#define SLOAD(i, k0) do { const char* vb_ = (const char*)Vh + (size_t)(k0) * (LDV * 2); const char* kb_ = (const char*)Kh + (size_t)(k0) * (LDK * 2); \
    sr_[i].vs0 = *reinterpret_cast<const bf16x8*>(vb_ + offV); sr_[i].vs1 = *reinterpret_cast<const bf16x8*>(vb_ + (size_t)32 * LDV * 2 + offV); \
    sr_[i].ks0 = *reinterpret_cast<const bf16x8*>(kb_ + offK); sr_[i].ks1 = *reinterpret_cast<const bf16x8*>(kb_ + (size_t)32 * LDK * 2 + offK); \
    if constexpr (ROPE) sr_[i].kr = *reinterpret_cast<const bf16x8*>((const char*)KRh + (size_t)(k0) * (LDKR * 2) + offR); } while (0)
#define SWRITE(b, i) do { *(bf16x8*)(V_lds + (b) * SHM_V + vst0) = sr_[i].vs0;          \
    *(bf16x8*)(V_lds + (b) * SHM_V + vst1) = sr_[i].vs1; const int kc = sc * 2;               \
    *(bf16x8*)(K_lds + (b) * SHM_K + kswz<DQK>(sr, kc)) = sr_[i].ks0;                       \
    *(bf16x8*)(K_lds + (b) * SHM_K + kswz<DQK>(32 + sr, kc)) = sr_[i].ks1;                   \
    if constexpr (ROPE) *(bf16x8*)(K_lds + (b) * SHM_K + kswz<DQK>(rr, 256 + rc * 2)) = sr_[i].kr; } while (0)
#define SWAIT() do { if constexpr (SDEPTH == 2) { if constexpr (ROPE) asm volatile("s_waitcnt vmcnt(5)" ::: "memory"); else asm volatile("s_waitcnt vmcnt(4)" ::: "memory"); } else asm volatile("s_waitcnt vmcnt(0)" ::: "memory"); } while (0)
#define RESC(a) do { if (__any((a) < 1.f)) { if (hi == 0) al_l[r32] = (a); asm volatile("s_waitcnt lgkmcnt(0)" ::: "memory"); \
    _Pragma("unroll") for (int d = 0; d < 4; ++d) _Pragma("unroll") for (int r = 0; r < 16; ++r) o[d][r] *= al_l[crow(r, hi)]; } } while (0)
  f32x16 pA0, pA1, pB0, pB1; float mnA, mnB, alA, alB; bf16x8 pa0, pa1, pa2, pa3; const int NT = seq / KVBLK;
  constexpr int SE = 0, SO = SDEPTH - 1;
  SLOAD(SE, 0); asm volatile("s_waitcnt vmcnt(0)" ::: "memory"); SWRITE(0, SE); __syncthreads();
  qkt<DQK, NQR>(pA0, pA1, K_lds, qr, qx, r32, hi); partialSM<DQK>(pA0, pA1, m_reg, mnA, alA);
  SLOAD(SO, KVBLK); if constexpr (SDEPTH == 2) { if (2 < NT) SLOAD(SE, 2 * KVBLK); }
  SWAIT(); SWRITE(1, SO); __syncthreads();
  for (int j = 1; j + 1 < NT; j += 2) {
    SBAR(); qkt<DQK, NQR>(pB0, pB1, K_lds + SHM_K, qr, qx, r32, hi);
    finishSM<true>(pA0, pA1, alA, l_reg, pa0, pa1, pa2, pa3); SBAR();
    SLOAD(SO, (j + SDEPTH) * KVBLK); SBAR();
    pv_d0(o, vb0, pa0, pa1, pa2, pa3); partialSM<DQK>(pB0, pB1, m_reg, mnB, alB);
    __syncthreads(); SWAIT(); SWRITE(0, SE);
    RESC(alB); __syncthreads();
    SBAR(); qkt<DQK, NQR>(pA0, pA1, K_lds, qr, qx, r32, hi);
    finishSM<true>(pB0, pB1, alB, l_reg, pa0, pa1, pa2, pa3); SBAR();
    if (SDEPTH == 1 || j + 3 < NT) SLOAD(SE, (j + 1 + SDEPTH) * KVBLK); SBAR();
    pv_d0(o, vb0 + SHM_V, pa0, pa1, pa2, pa3); partialSM<DQK>(pA0, pA1, m_reg, mnA, alA);
    __syncthreads(); SWAIT(); SWRITE(1, SO);
    RESC(alA); __syncthreads();
  }
  SBAR(); qkt<DQK, NQR>(pB0, pB1, K_lds + SHM_K, qr, qx, r32, hi);
  finishSM<true>(pA0, pA1, alA, l_reg, pa0, pa1, pa2, pa3); SBAR();
  pv_d0(o, vb0, pa0, pa1, pa2, pa3); partialSM<DQK>(pB0, pB1, m_reg, mnB, alB);
  __syncthreads(); RESC(alB);
  finishSM<true>(pB0, pB1, alB, l_reg, pa0, pa1, pa2, pa3); SBAR();
  pv_d0(o, vb0 + SHM_V, pa0, pa1, pa2, pa3);
  if (hi == 0) li_l[r32] = l_reg; asm volatile("s_waitcnt lgkmcnt(0)" ::: "memory");
  float rli[16];
#pragma unroll
  for (int r = 0; r < 16; ++r) rli[r] = __builtin_amdgcn_rcpf(li_l[crow(r, hi)]);
  bf16* Ow = Ob + (long)(wid * QBLK) * LDO;
#pragma unroll
  for (int r = 0; r < 16; ++r) { const int orow = crow(r, hi);
#pragma unroll
    for (int d0 = 0; d0 < 4; ++d0) Ow[(long)orow * LDO + d0 * 32 + r32] = (bf16)(cvtpk(o[d0][r] * rli[r], 0.f) & 0xffffu); }
  __syncthreads();
#undef SLOAD
#undef SWRITE
#undef SWAIT
#undef RESC
}
}
#define XB_TMO      128
#define XB_XCNT(j)  (256  + 64 * (j))
#define XB_XSUB(j)  (1280 + 64 * (j))
#define XB_XGEN(j)  (2304 + 64 * (j))
#define XB_TOP      3328
#define XB_TOPGEN   3392
#define XCD_BAR_WORDS 3456
#define XB_SPIN_CAP (1u << 18)

__device__ __forceinline__ unsigned xb_ld(unsigned* p)              { return __hip_atomic_load(p, __ATOMIC_RELAXED, __HIP_MEMORY_SCOPE_AGENT); }
__device__ __forceinline__ unsigned xb_add(unsigned* p, unsigned v) { return __hip_atomic_fetch_add(p, v, __ATOMIC_RELAXED, __HIP_MEMORY_SCOPE_AGENT); }
__device__ __forceinline__ unsigned xb_xcc_id() { return (unsigned)__builtin_amdgcn_s_getreg((3 << 11) | 20) & 0xFu; }
#define XB_SPIN(cond, bar) do { unsigned _sp = 0; while (cond) { __builtin_amdgcn_s_sleep(1); \
    if ((++_sp & 255u) == 0u) { if (xb_ld(&(bar)[XB_TMO])) break; if (_sp > XB_SPIN_CAP) { atomicAdd(&(bar)[XB_TMO], 1u); break; } } } } while (0)

struct XcdBarrier {
    unsigned* bar; unsigned x;
    volatile LAS unsigned* st;
};

__device__ __forceinline__ XcdBarrier xcd_barrier_post(unsigned* bar, volatile LAS unsigned* st) {
    XcdBarrier b; b.bar = bar; b.x = xb_xcc_id(); b.st = st;
    if (threadIdx.x == 0) (void)xb_add(&bar[XB_XCNT(b.x)], 1u);
    return b;
}
__device__ __forceinline__ void xcd_barrier_complete(unsigned* bar, unsigned x, unsigned& nloc, unsigned& nx) {
    const unsigned G = gridDim.x * gridDim.y * gridDim.z;
    unsigned sum, cnt, mine, sp = 0u;
    for (;;) {
        sum = 0u; cnt = 0u; mine = 0u;
#pragma unroll
        for (unsigned j = 0; j < 16; ++j) { const unsigned c = xb_ld(&bar[XB_XCNT(j)]); sum += c; cnt += (c > 0u) ? 1u : 0u; mine = (j == x) ? c : mine; }
        if (sum == G) break;
        __builtin_amdgcn_s_sleep(1);
        if ((++sp & 255u) == 0u) { if (xb_ld(&bar[XB_TMO])) break; if (sp > XB_SPIN_CAP) { atomicAdd(&bar[XB_TMO], 1u); break; } }
    }
    nloc = mine > 0u ? mine : 1u; nx = cnt > 0u ? cnt : 1u;
}

__device__ __forceinline__ void xcd_barrier(const XcdBarrier& b) {
    asm volatile("s_waitcnt vmcnt(0)" ::: "memory");
    __syncthreads();
    if (threadIdx.x == 0) {
        unsigned* bar = b.bar;
        __builtin_amdgcn_s_waitcnt(0);
        unsigned nloc = b.st[0], nx = b.st[1];
        if (nloc == 0u) { xcd_barrier_complete(bar, b.x, nloc, nx); b.st[0] = nloc; b.st[1] = nx; }
        const unsigned old = xb_add(&bar[XB_XSUB(b.x)], 1u);
        const unsigned gen = old / nloc;
        if (old + 1u == (gen + 1u) * nloc) {
            __builtin_amdgcn_fence(__ATOMIC_RELEASE, "agent");
            asm volatile("s_waitcnt vmcnt(0)" ::: "memory");
            const unsigned og = xb_add(&bar[XB_TOP], 1u);
            const unsigned tg = og / nx;
            if (og + 1u == (tg + 1u) * nx) xb_add(&bar[XB_TOPGEN], 1u);
            else XB_SPIN(xb_ld(&bar[XB_TOPGEN]) == tg, bar);
            __builtin_amdgcn_fence(__ATOMIC_ACQUIRE, "agent");
            xb_add(&bar[XB_XGEN(b.x)], 1u);
            asm volatile("s_waitcnt vmcnt(0)" ::: "memory");
        } else {
            XB_SPIN(xb_ld(&bar[XB_XGEN(b.x)]) == gen, bar);
            __builtin_amdgcn_fence(__ATOMIC_ACQUIRE, "agent");
            asm volatile("s_waitcnt vmcnt(0)" ::: "memory");
        }
    }
    __syncthreads();
}

struct Args { const float* in[N_IN]; float* out; unsigned char* ws; int ph_lo, ph_hi, one_launch, pad; };
struct Frame {
    LAS unsigned char* lds;
    int tid, lane, wave, vcu, G;
    const float* const* in;
    float* out; unsigned char* ws;
    float* mod; const f32x2* ropeA; const f32x2* ropeC;
    bf16* H;
};
constexpr int NWAVES = 8;

__device__ __forceinline__ void transpose_item(const float* W, int ldw, int K, int N, bf16* WT, int row_off, float scale, LAS float* scr, int item, int lane) {
    const int nblk = N / 32, kb = item / nblk, nb = item % nblk, k0 = 64 * kb, n0 = 32 * nb;
#pragma unroll 8
    for (int i = 0; i < 32; ++i) { const int kk = 2 * i + (lane >> 5); scr[kk * 33 + (lane & 31)] = W[(size_t)(k0 + kk) * ldw + n0 + (lane & 31)] * scale; }
    LDS_WAIT(); asm volatile("" ::: "memory");
    const int c = lane & 7;
#pragma unroll
    for (int j = 0; j < 4; ++j) { const int n = (lane >> 3) + 8 * j; const LAS float* s = scr + (8 * c) * 33 + n;
        v4u o; o.x = pk2(s[0 * 33], s[1 * 33]); o.y = pk2(s[2 * 33], s[3 * 33]); o.z = pk2(s[4 * 33], s[5 * 33]); o.w = pk2(s[6 * 33], s[7 * 33]);
        *(GAS v4u*)(WT + (size_t)(row_off + n0 + n) * K + k0 + 8 * c) = o; }
    LDS_WAIT(); asm volatile("" ::: "memory");
}
struct ItemSrc { unsigned* head; int cur, step; };
__device__ __forceinline__ void item_next(ItemSrc& S) {
    if (S.head) { unsigned v = 0; if ((threadIdx.x & 63) == 0) v = __hip_atomic_fetch_add(S.head, 1u, __ATOMIC_RELAXED, __HIP_MEMORY_SCOPE_AGENT); S.cur = (int)__builtin_amdgcn_readfirstlane(v); }
    else S.cur += S.step;
}
__device__ __forceinline__ int transpose_matrix(Frame& F, ItemSrc& S, int base, const float* W, int ldw, int K, int N, bf16* WT, int row_off, float scale) {
    LAS float* scr = (LAS float*)(F.lds + F.wave * 16384);
    const int nit = (K / 64) * (N / 32), nb = (nit + 7) / 8;
    while (S.cur < base + nb) { const int i0 = (S.cur - base) * 8, i1 = i0 + 8 < nit ? i0 + 8 : nit;
        for (int it = i0; it < i1; ++it) transpose_item(W, ldw, K, N, WT, row_off, scale, scr, it, F.lane);
        item_next(S); }
    return base + nb;
}
__device__ __forceinline__ void zero_rows(Frame& F, bf16* WT, int row0, int nrows, int K) {
    const size_t n16 = (size_t)nrows * K / 8; GAS v4u* p = (GAS v4u*)(WT + (size_t)row0 * K);
    for (size_t i = (size_t)(F.vcu * NWAVES + F.wave) * 64 + F.lane; i < n16; i += (size_t)F.G * NWAVES * 64) p[i] = (v4u){0u, 0u, 0u, 0u};
}
__device__ __forceinline__ void prep_weights(Frame& F, int layer, unsigned* head) {
    const int kind = layer % 3, j = layer / 3;
    unsigned char* wr = F.ws + ((layer & 1) ? WS_WB : WS_W);
    bf16* w1t = (bf16*)wr; bf16* w2t = (bf16*)(wr + 32 * MiB); bf16* wmix = (bf16*)(wr + 64 * MiB); bf16* wot = (bf16*)(wr + 90 * MiB);
    if (kind == 1) {
        const float* g1 = F.in[I_GLA_WG1];
        for (int i = (F.vcu * NWAVES + F.wave) * 64 + F.lane; i < 2 * 16 * D; i += F.G * NWAVES * 64) { const int k = i % D, nr = i / D, n = nr >> 4, r = nr & 15;
            wmix[(size_t)(6144 + nr) * D + k] = (bf16)f2bf(g1[((size_t)n * D + k) * 16 + r]); }
        zero_rows(F, wmix, 6176, 224, D);
    } else if (kind == 2) zero_rows(F, wmix, 832, 192, D);
    ItemSrc S; S.head = head; S.step = F.G * NWAVES; S.cur = F.vcu * NWAVES + F.wave;
    if (head) item_next(S);
    int b = 0;
    b = transpose_matrix(F, S, b, F.in[I_W1] + (size_t)layer * D * FF, FF, D, FF, w1t, 0, 1.f);
    b = transpose_matrix(F, S, b, F.in[I_W2] + (size_t)layer * FF * D, D, FF, D, w2t, 0, 1.f);
    if (kind == 0) {
        b = transpose_matrix(F, S, b, F.in[I_GQA_WQKV] + (size_t)j * D * 3072, 3072, D, 3072, wmix, 0, 1.f);
        b = transpose_matrix(F, S, b, F.in[I_GQA_WO] + (size_t)j * D * D, D, D, D, wot, 0, 1.f);
    } else if (kind == 1) {
        const float* win = F.in[I_GLA_WIN];
        b = transpose_matrix(F, S, b, win, 6144, D, 1024, wmix, 0, 0.0625f);
        b = transpose_matrix(F, S, b, win + 1024, 6144, D, 5120, wmix, 1024, 1.f);
        b = transpose_matrix(F, S, b, F.in[I_GLA_WO], D, D, D, wot, 0, 1.f);
    } else {
        b = transpose_matrix(F, S, b, F.in[I_MLA_WDOWN], 832, D, 832, wmix, 0, 1.f);
        b = transpose_matrix(F, S, b, F.in[I_MLA_WUQ], 3072, 512, 3072, wmix + (size_t)4 * MiB / 2, 0, 1.f);
        b = transpose_matrix(F, S, b, F.in[I_MLA_WUKV], 4096, 256, 4096, wmix + (size_t)8 * MiB / 2, 0, 1.f);
        b = transpose_matrix(F, S, b, F.in[I_MLA_WO], D, D, D, wot, 0, 1.f);
    }
    (void)b;
}
__device__ __forceinline__ void ada_phase(Frame& F) {
    LAS float* cond = (LAS float*)(F.lds);
    float* modp = (float*)(F.ws + WS_MODP);
    const float* cp = F.in[I_CP]; const float* cs = F.in[I_CS]; const float* aw = F.in[I_ADAW];
    for (int item = F.vcu; item < 4 * 24 * 4; item += F.G) {
        const int kq = item & 3, cg = (item >> 2) % 24, l = item / 96;
        __syncthreads();
        for (int i = F.tid; i < 512 * NSEQ; i += 512) { const int k = i / NSEQ, s = i % NSEQ; const float c = s < 16 ? cp[s * D + kq * 512 + k] : cs[(s - 16) * D + kq * 512 + k];
            cond[i] = c / (1.f + __expf(-c)); }
        __syncthreads();
        const int col = cg * 512 + F.wave * 64 + F.lane;
        const float* wp = aw + ((size_t)l * D + kq * 512) * 12288 + col;
        float acc[NSEQ];
#pragma unroll
        for (int s = 0; s < NSEQ; ++s) acc[s] = 0.f;
        for (int k0 = 0; k0 < 512; k0 += 8) {
            float wv[8];
#pragma unroll
            for (int u = 0; u < 8; ++u) wv[u] = wp[(size_t)(k0 + u) * 12288];
#pragma unroll
            for (int u = 0; u < 8; ++u) { const LAS f32x4* cr = (const LAS f32x4*)(cond + (k0 + u) * NSEQ);
#pragma unroll
                for (int q = 0; q < 5; ++q) { const f32x4 cv = cr[q]; acc[4 * q] += cv.x * wv[u]; acc[4 * q + 1] += cv.y * wv[u]; acc[4 * q + 2] += cv.z * wv[u]; acc[4 * q + 3] += cv.w * wv[u]; } }
        }
#pragma unroll
        for (int s = 0; s < NSEQ; ++s) modp[(((size_t)kq * DEPTH + l) * NSEQ + s) * 12288 + col] = acc[s];
    }
    __syncthreads();
}
__device__ __forceinline__ void rope_tables(Frame& F) {
    f32x2* ra = (f32x2*)(F.ws + WS_ROPE); f32x2* rc = ra + 192 * 32;
    for (int i = (F.vcu * NWAVES + F.wave) * 64 + F.lane; i < 192 * 48; i += F.G * NWAVES * 64) {
        const int e = i / 48, f = i % 48; const double idx = (double)(e < 128 ? e : e - 128);
        const double inv = f < 32 ? pow(10000.0, -(double)f / 32.0) : pow(10000.0, -(double)(f - 32) / 16.0);
        const double a = idx * inv; const f32x2 v = {(float)cos(a), (float)sin(a)};
        if (f < 32) ra[e * 32 + f] = v; else rc[e * 16 + (f - 32)] = v;
    }
}
__device__ __forceinline__ void mod_finalize(Frame& F) {
    const float* modp = (const float*)(F.ws + WS_MODP); const float* ab = F.in[I_ADAB];
    constexpr int NTOT = DEPTH * NSEQ * 12288, Q = NTOT;
    for (int i = (F.vcu * NWAVES + F.wave) * 64 + F.lane; i < NTOT; i += F.G * NWAVES * 64) { const int l = i / (NSEQ * 12288), n = i % 12288;
        float v = ab[l * 12288 + n] + ((modp[i] + modp[i + Q]) + (modp[i + 2 * Q] + modp[i + 3 * Q]));
        const int slot = n >> 11; if (slot == 1) v = F.in[I_N1G][l * D + (n & 2047)] * (1.0f + v); else if (slot == 4) v = F.in[I_N2G][l * D + (n & 2047)] * (1.0f + v);
        F.mod[i] = v; }
}
__device__ __forceinline__ void norm0_phase(Frame& F) {
    const int gw = F.vcu * NWAVES + F.wave, NGW = F.G * NWAVES;
    float* ssq = (float*)(F.ws + WS_SSQB);
    for (int item = gw; item < M / 32; item += NGW) {
        const int row0 = item * 32, seq = seq_of_row(row0);
        const float* mp = F.mod + (size_t)seq * 12288;
        f32x4 A[8];
#pragma unroll
        for (int j = 0; j < 8; ++j) { const int c = j * 256 + F.lane * 4; A[j] = *(const f32x4*)(mp + D + c); }
        const float* xb = row0 < MP ? F.in[I_XP] + (size_t)row0 * D : F.in[I_XS] + (size_t)(row0 - MP) * D;
        bf16* hb = F.H + (size_t)row0 * D;
        for (int r = 0; r < 32; r += 2) {
            f32x4 v0[8], v1[8]; float s0 = 0.f, s1 = 0.f;
#pragma unroll
            for (int j = 0; j < 8; ++j) { v0[j] = *(const GAS f32x4*)(xb + (size_t)r * D + j * 256 + F.lane * 4); v1[j] = *(const GAS f32x4*)(xb + (size_t)(r + 1) * D + j * 256 + F.lane * 4); }
#pragma unroll
            for (int j = 0; j < 8; ++j) { s0 += (v0[j].x * v0[j].x + v0[j].y * v0[j].y) + (v0[j].z * v0[j].z + v0[j].w * v0[j].w); s1 += (v1[j].x * v1[j].x + v1[j].y * v1[j].y) + (v1[j].z * v1[j].z + v1[j].w * v1[j].w); }
            s0 = wave_sum(s0); s1 = wave_sum(s1);
            if (F.lane < 16) { const int rr = row0 + r + (F.lane >> 3), sl = F.lane & 7; ssq[(size_t)rr * 8 + sl] = sl == 0 ? ((F.lane >> 3) ? s1 : s0) : 0.f; }
#pragma unroll
            for (int j = 0; j < 8; ++j) { const f32x4 a = v0[j] * A[j], b = v1[j] * A[j];
                *(GAS v2u*)(hb + (size_t)r * D + j * 256 + F.lane * 4) = (v2u){pk2(a.x, a.y), pk2(a.z, a.w)};
                *(GAS v2u*)(hb + (size_t)(r + 1) * D + j * 256 + F.lane * 4) = (v2u){pk2(b.x, b.y), pk2(b.z, b.w)}; }
        }
    }
}
__device__ __forceinline__ void gemv20_item(Frame& F, const float* shift  , const float* W, int ldw, int ncols, float scale, float* out, int ldo, int c0) {
    LAS float* cond = (LAS float*)(F.lds);
    LAS float* red = (LAS float*)(F.lds + 98304);
    const int c = c0 + F.lane; const bool ok = c < ncols;
    for (int pass = 0; pass < 2; ++pass) {
        __syncthreads();
        for (int i = F.tid; i < 2048 * 10; i += 512) { const int k = i / 10, s = i % 10; cond[k * 12 + s] = shift[(size_t)(pass * 10 + s) * 12288 + k]; }
        __syncthreads();
        float acc[10];
#pragma unroll
        for (int s = 0; s < 10; ++s) acc[s] = 0.f;
        const float* wp = W + (size_t)(F.wave * 256) * ldw + (ok ? c : 0);
        const LAS float* cb = cond + F.wave * 256 * 12;
        for (int k0 = 0; k0 < 256; k0 += 16) {
            float wv[16];
#pragma unroll
            for (int u = 0; u < 16; ++u) { wv[u] = *wp; wp += ldw; }
#pragma unroll
            for (int u = 0; u < 16; ++u) { const LAS f32x4* cr = (const LAS f32x4*)(cb + (k0 + u) * 12); const f32x4 c0v = cr[0], c1v = cr[1], c2v = cr[2];
                acc[0] += c0v.x * wv[u]; acc[1] += c0v.y * wv[u]; acc[2] += c0v.z * wv[u]; acc[3] += c0v.w * wv[u]; acc[4] += c1v.x * wv[u]; acc[5] += c1v.y * wv[u];
                acc[6] += c1v.z * wv[u]; acc[7] += c1v.w * wv[u]; acc[8] += c2v.x * wv[u]; acc[9] += c2v.y * wv[u]; }
        }
#pragma unroll
        for (int s = 0; s < 10; ++s) red[(F.wave * 10 + s) * 64 + F.lane] = acc[s];
        __syncthreads();
        for (int i = F.tid; i < 640; i += 512) { const int s = i >> 6, l = i & 63; float t = 0.f;
#pragma unroll
            for (int w = 0; w < 8; ++w) t += red[(w * 10 + s) * 64 + l];
            if (c0 + l < ncols) out[(size_t)(pass * 10 + s) * ldo + c0 + l] = t * scale; }
    }
    __syncthreads();
}
__device__ __forceinline__ void bw_phase(Frame& F, int layer) {
    const int kind = layer % 3, j = layer / 3;
    const float* sh1 = F.mod + (size_t)layer * NSEQ * 12288; const float* sh2 = sh1 + 3 * D;
    float* bw1 = (float*)(F.ws + ((layer & 1) ? WS_BW1B : WS_BW1)); float* bw2 = (float*)(F.ws + ((layer & 1) ? WS_BW2B : WS_BW2));
    const int n1 = kind == 0 ? 48 : (kind == 1 ? 98 : 13);
    for (int it = F.G - 1 - F.vcu; it < n1 + 128; it += F.G) {
        if (it >= n1) { gemv20_item(F, sh2, F.in[I_W1] + (size_t)layer * D * FF, FF, FF, 1.f, bw2, FF, (it - n1) * 64); continue; }
        if (kind == 0) gemv20_item(F, sh1, F.in[I_GQA_WQKV] + (size_t)j * D * 3072, 3072, 3072, 1.f, bw1, 6400, it * 64);
        else if (kind == 1) {
            if (it < 16) gemv20_item(F, sh1, F.in[I_GLA_WIN], 6144, 1024, 0.0625f, bw1, 6400, it * 64);
            else if (it < 96) gemv20_item(F, sh1, F.in[I_GLA_WIN], 6144, 6144, 1.f, bw1, 6400, it * 64);
            else gemv20_item(F, sh1, F.in[I_GLA_WG1] + (size_t)(it - 96) * D * 16, 16, 16, 1.f, bw1 + 6144 + (it - 96) * 16, 6400, 0);
        } else gemv20_item(F, sh1, F.in[I_MLA_WDOWN], 832, 832, 1.f, bw1, 6400, it * 64);
    }
}
__device__ __forceinline__ void rot(float& y0, float& y1, f32x2 cs) { const float a = y0 * cs.x - y1 * cs.y, b = y0 * cs.y + y1 * cs.x; y0 = a; y1 = b; }
__device__ __forceinline__ void unpack8(v4u w, float* x) { x[0] = bflo(w.x); x[1] = bfhi(w.x); x[2] = bflo(w.y); x[3] = bfhi(w.y); x[4] = bflo(w.z); x[5] = bfhi(w.z); x[6] = bflo(w.w); x[7] = bfhi(w.w); }
__device__ __forceinline__ void mla_down_norm_phase(Frame& F) {
    bf16* DN = (bf16*)(F.ws + WS_DOWN); const float* qa = F.in[I_MLA_QAN]; const float* kva = F.in[I_MLA_KVAN]; const float* krn = F.in[I_MLA_KRN];
    const int gw = F.vcu * NWAVES + F.wave, NGW = F.G * NWAVES, lane = F.lane;
    float g0[8], g1[8], g2[8];
#pragma unroll
    for (int e = 0; e < 8; ++e) { g0[e] = qa[lane * 8 + e]; g1[e] = kva[(lane & 31) * 8 + e]; g2[e] = krn[(lane & 7) * 8 + e]; }
    for (int row = gw; row < M; row += NGW) {
        const int t = pos_of_row(row), ri = t >> 6, ci = 128 + (t & 63);
        bf16* rp = DN + (size_t)row * 1024;
        const v4u w0 = *(const GAS v4u*)(rp + lane * 8), w1 = *(const GAS v4u*)(rp + 512 + (lane & 31) * 8), w2 = *(const GAS v4u*)(rp + 768 + (lane & 7) * 8);
        float x[8], ss;
        unpack8(w0, x); ss = 0.f;
#pragma unroll
        for (int e = 0; e < 8; ++e) ss += x[e] * x[e];
        ss = wave_sum(ss); { const float rs = 1.0f / sqrtf(ss * (1.f / 512.f) + NORM_EPS);
#pragma unroll
            for (int e = 0; e < 8; ++e) x[e] = x[e] * rs * g0[e]; }
        *(GAS v4u*)(rp + lane * 8) = (v4u){pk2(x[0], x[1]), pk2(x[2], x[3]), pk2(x[4], x[5]), pk2(x[6], x[7])};
        unpack8(w1, x); ss = 0.f;
#pragma unroll
        for (int e = 0; e < 8; ++e) ss += x[e] * x[e];
        ss += __shfl_xor(ss, 1); ss += __shfl_xor(ss, 2); ss += __shfl_xor(ss, 4); ss += __shfl_xor(ss, 8); ss += __shfl_xor(ss, 16);
        { const float rs = 1.0f / sqrtf(ss * (1.f / 256.f) + NORM_EPS);
#pragma unroll
            for (int e = 0; e < 8; ++e) x[e] = x[e] * rs * g1[e]; }
        if (lane < 32) *(GAS v4u*)(rp + 512 + lane * 8) = (v4u){pk2(x[0], x[1]), pk2(x[2], x[3]), pk2(x[4], x[5]), pk2(x[6], x[7])};
        unpack8(w2, x); ss = 0.f;
#pragma unroll
        for (int e = 0; e < 8; ++e) ss += x[e] * x[e];
        ss += __shfl_xor(ss, 1); ss += __shfl_xor(ss, 2); ss += __shfl_xor(ss, 4);
        { const float rs = 1.0f / sqrtf(ss * (1.f / 64.f) + NORM_EPS);
#pragma unroll
            for (int e = 0; e < 8; ++e) x[e] = x[e] * rs * g2[e]; }
#pragma unroll
        for (int p = 0; p < 4; ++p) { const int i = (lane & 7) * 4 + p; rot(x[2 * p], x[2 * p + 1], F.ropeC[(i < 16 ? ri : ci) * 16 + (i & 15)]); }
        if (lane < 8) *(GAS v4u*)(rp + 768 + lane * 8) = (v4u){pk2(x[0], x[1]), pk2(x[2], x[3]), pk2(x[4], x[5]), pk2(x[6], x[7])};
    }
}
__device__ __forceinline__ void mla_knope_norm_phase(Frame& F) {
    bf16* KV = (bf16*)(F.ws + WS_KV); const float* knn = F.in[I_MLA_KNN];
    const int gw = F.vcu * NWAVES + F.wave, NGW = F.G * NWAVES, lane = F.lane, sub = lane & 15, hh = lane >> 4;
    float gk[8];
#pragma unroll
    for (int e = 0; e < 8; ++e) gk[e] = knn[sub * 8 + e];
    for (int row = gw; row < M; row += NGW) {
        v4u w[4];
#pragma unroll
        for (int ps = 0; ps < 4; ++ps) w[ps] = *(const GAS v4u*)(KV + (size_t)row * 4096 + (ps * 4 + hh) * 256 + sub * 8);
#pragma unroll
        for (int ps = 0; ps < 4; ++ps) {
            float x[8]; unpack8(w[ps], x); float ss = 0.f;
#pragma unroll
            for (int e = 0; e < 8; ++e) ss += x[e] * x[e];
            ss += __shfl_xor(ss, 1); ss += __shfl_xor(ss, 2); ss += __shfl_xor(ss, 4); ss += __shfl_xor(ss, 8);
            const float rs = 1.0f / sqrtf(ss * (1.f / 128.f) + NORM_EPS);
#pragma unroll
            for (int e = 0; e < 8; ++e) x[e] = x[e] * rs * gk[e];
            *(GAS v4u*)(KV + (size_t)row * 4096 + (ps * 4 + hh) * 256 + sub * 8) = (v4u){pk2(x[0], x[1]), pk2(x[2], x[3]), pk2(x[4], x[5]), pk2(x[6], x[7])};
        }
    }
}
__device__ __forceinline__ void gla_post_phase(Frame& F) {
    bf16* OB = (bf16*)(F.ws + WS_OB); const bf16* PROJ = (const bf16*)(F.ws + WS_PROJ); const float* on = F.in[I_GLA_ON];
    const int gw = F.vcu * NWAVES + F.wave, NGW = F.G * NWAVES, lane = F.lane;
    float g[8];
#pragma unroll
    for (int e = 0; e < 8; ++e) g[e] = on[lane * 8 + e];
    for (int row = gw; row < M; row += NGW) {
        v4u wf[4], wb[4], wr[4];
#pragma unroll
        for (int h = 0; h < 4; ++h) { wf[h] = *(const GAS v4u*)(F.H + (size_t)row * D + h * 512 + lane * 8); wb[h] = *(const GAS v4u*)(OB + (size_t)row * D + h * 512 + lane * 8);
            wr[h] = *(const GAS v4u*)(PROJ + (size_t)row * 6400 + 4096 + h * 512 + lane * 8); }
#pragma unroll
        for (int h = 0; h < 4; ++h) {
            float a[8], b[8], r[8]; unpack8(wf[h], a); unpack8(wb[h], b); unpack8(wr[h], r); float ss = 0.f;
#pragma unroll
            for (int e = 0; e < 8; ++e) { a[e] += b[e]; ss += a[e] * a[e]; }
            ss = wave_sum(ss); const float rs = 1.0f / sqrtf(ss * (1.f / 512.f) + NORM_EPS);
#pragma unroll
            for (int e = 0; e < 8; ++e) a[e] = a[e] * rs * g[e] * (r[e] / (1.f + __expf(-r[e])));
            *(GAS v4u*)(OB + (size_t)row * D + h * 512 + lane * 8) = (v4u){pk2(a[0], a[1]), pk2(a[2], a[3]), pk2(a[4], a[5]), pk2(a[6], a[7])};
        }
    }
}

namespace gla {
typedef float f32x4 __attribute__((ext_vector_type(4)));
typedef short bf16x8 __attribute__((ext_vector_type(8)));
constexpr int CL = 32;
constexpr int QD_ROW = 528, KET_ROW = 80, V_ROW = 272, P_ROW = 80;
constexpr int OFF_QD = 0, OFF_KD = OFF_QD + CL * QD_ROW, OFF_KET = OFF_KD + CL * QD_ROW, OFF_V = OFF_KET + 256 * KET_ROW, OFF_DE = OFF_V + CL * V_ROW, BUF_BYTES = OFF_DE + 1024;
constexpr int OFF_LOW = 2 * BUF_BYTES, OFF_PW = OFF_LOW + 2 * CL * 64, OFF_END = OFF_PW + 4 * CL * P_ROW;
static_assert(OFF_END <= LDSCTL_OFF, "gla LDS map");
__device__ __forceinline__ float log_sigmoid(float z) { return fminf(z, 0.f) - __logf(1.f + __expf(-fabsf(z))); }
__device__ __forceinline__ void rd_p(bf16x8 (&fa)[2][2], bf16x8 (&fb)[2][2], int aq, int ak) {
#pragma unroll
    for (int mi = 0; mi < 2; ++mi)
#pragma unroll
        for (int kk = 0; kk < 2; ++kk) { fa[mi][kk] = *(const LAS bf16x8*)(uintptr_t)(unsigned)(aq + mi * 8448 + kk * 64); fb[mi][kk] = *(const LAS bf16x8*)(uintptr_t)(unsigned)(ak + mi * 8448 + kk * 64); }
}
__device__ __forceinline__ void rd_v(unsigned (&vu)[8], int av) {
#pragma unroll
    for (int q = 0; q < 8; ++q) vu[q] = *(const LAS unsigned short*)(uintptr_t)(unsigned)(av + q * 272);
}
__device__ __forceinline__ void rd_pw(bf16x8 (&fp)[2], int ap) { fp[0] = *(const LAS bf16x8*)(uintptr_t)(unsigned)ap; fp[1] = *(const LAS bf16x8*)(uintptr_t)(unsigned)(ap + 1280); }
__device__ __forceinline__ void rd_q(v2u (&q0)[2][2], v2u (&q1)[2][2], int aq) {
#pragma unroll
    for (int mi = 0; mi < 2; ++mi)
#pragma unroll
        for (int kk = 0; kk < 2; ++kk) { q0[mi][kk] = *(const LAS v2u*)(uintptr_t)(unsigned)(aq + mi * 8448 + kk * 64); q1[mi][kk] = *(const LAS v2u*)(uintptr_t)(unsigned)(aq + mi * 8448 + kk * 64 + 32); }
}
__device__ __forceinline__ void rd_s(bf16x8 (&fk)[4], f32x4 (&fd)[4], int ak, int ad) {
#pragma unroll
    for (int t = 0; t < 4; ++t) { fk[t] = *(const LAS bf16x8*)(uintptr_t)(unsigned)(ak + t * 1280); fd[t] = *(const LAS f32x4*)(uintptr_t)(unsigned)(ad + t * 64); }
}
static_assert(16 * QD_ROW == 8448 && V_ROW == 272 && 16 * P_ROW == 1280 && 16 * KET_ROW == 1280, "asm offsets");
#define GLA_BAR() do { asm volatile("s_waitcnt lgkmcnt(0)" ::: "memory"); __builtin_amdgcn_s_barrier(); asm volatile("" ::: "memory"); } while (0)

__device__ __forceinline__ void chain(LAS unsigned char* lds, const bf16* PROJ, bf16* OF, bf16* OB, const float* wg2, const float* bgv, int c) {
    const int tid = threadIdx.x, wave = __builtin_amdgcn_readfirstlane(tid >> 6), lane = tid & 63;
    const int sl = c & 3, dir = (c >> 2) & 1, h = (c >> 3) & 3, s = c >> 5;
    int T, rowbase;
    if (c < 128) { T = 8192; rowbase = MP + s * 8192; } else { T = 2048; rowbase = (s - 4) * 2048; }
    const int nch = T / CL;
    GLA_BAR();
    if (wave < 4) {
        const int ptid = tid, l16 = lane & 15, g = lane >> 4, dbase = 64 * wave + 2 * l16;
        bf16x8 wB[4]; float bias[4];
#pragma unroll
        for (int nj = 0; nj < 4; ++nj) { const int d = dbase + 32 * (nj >> 1) + (nj & 1); float w[8];
#pragma unroll
            for (int jx = 0; jx < 8; ++jx) w[jx] = g < 2 ? wg2[((size_t)dir * 16 + 8 * g + jx) * 1024 + h * 256 + d] : 0.f;
            wB[nj] = __builtin_bit_cast(bf16x8, (v4u){pk2c(w[0], w[1]), pk2c(w[2], w[3]), pk2c(w[4], w[5]), pk2c(w[6], w[7])});
            bias[nj] = bgv[dir * 1024 + h * 256 + d]; }
        unsigned qv[2][2][4], kv[2][2][4]; v4u vv[2]; unsigned lw;
#define GLA_ROW0(J) ((size_t)rowbase + (size_t)(dir ? nch - 1 - (J) : (J)) * CL)
#define GLA_LOAD_QKV(J) do { const size_t r0_ = GLA_ROW0(J); const char* qp_ = (const char*)PROJ + (r0_ * 6400 + h * 256 + 64 * wave) * 2; const unsigned voff_ = (unsigned)(4 * g * 6400 + 2 * l16) * 2u;     \
        _Pragma("unroll") for (int pp = 0; pp < 2; ++pp) _Pragma("unroll") for (int mi = 0; mi < 2; ++mi) _Pragma("unroll") for (int r = 0; r < 4; ++r) { \
            qv[pp][mi][r] = *(const GAS unsigned*)(qp_ + (size_t)(16 * mi + r) * 12800 + pp * 64 + voff_); kv[pp][mi][r] = *(const GAS unsigned*)(qp_ + (size_t)(16 * mi + r) * 12800 + pp * 64 + 2048 + voff_); } \
        _Pragma("unroll") for (int jj = 0; jj < 2; ++jj) { const int idx = ptid + 256 * jj, pos = idx >> 4, e8 = (idx & 15) * 8; vv[jj] = *(const GAS v4u*)(PROJ + (r0_ + pos) * 6400 + 2048 + h * 512 + sl * 128 + e8); } } while (0)
#define GLA_LOAD_LOW(J) do { lw = *(const GAS unsigned*)(PROJ + (GLA_ROW0(J) + (ptid >> 3)) * 6400 + 6144 + dir * 16 + (ptid & 7) * 2); } while (0)
#define GLA_PUT_LOW(J) do { *(LAS unsigned*)(lds + OFF_LOW + ((J) & 1) * (CL * 64) + (ptid >> 3) * 64 + (ptid & 7) * 4) = lw; } while (0)
        { const int b_ = ptid >> 7, pos_ = (ptid >> 2) & 31, part_ = ptid & 3; *(LAS v2u*)(lds + OFF_LOW + b_ * (CL * 64) + pos_ * 64 + 32 + part_ * 8) = (v2u){0u, 0u}; }
        GLA_LOAD_LOW(0); GLA_PUT_LOW(0);
        if (nch > 1) GLA_LOAD_LOW(1);
        GLA_LOAD_QKV(0);
        GLA_BAR();
        for (int j = 0; j < nch; ++j) {
            LAS unsigned char* B = lds + (j & 1) * BUF_BYTES;
            if (j + 1 < nch) GLA_PUT_LOW(j + 1);
            f32x4 z[2][4];
            { bf16x8 fA[2];
#pragma unroll
              for (int mi = 0; mi < 2; ++mi) fA[mi] = *(const LAS bf16x8*)(lds + OFF_LOW + (j & 1) * (CL * 64) + (16 * mi + l16) * 64 + g * 16);
#pragma unroll
              for (int mi = 0; mi < 2; ++mi)
#pragma unroll
                  for (int nj = 0; nj < 4; ++nj) z[mi][nj] = __builtin_amdgcn_mfma_f32_16x16x32_bf16(fA[mi], wB[nj], (f32x4){bias[nj], bias[nj], bias[nj], bias[nj]}, 0, 0, 0); }
            float tot[4];
#pragma unroll
            for (int nj = 0; nj < 4; ++nj) {
                float s[2];
#pragma unroll
                for (int mi = 0; mi < 2; ++mi) {
#pragma unroll
                    for (int r = 0; r < 4; ++r) { const float zz = z[mi][nj][r]; const float t = __builtin_amdgcn_exp2f(-1.4426950408889634f * __builtin_fabsf(zz));
                        z[mi][nj][r] = __builtin_fmaf(__builtin_amdgcn_logf(1.0f + t), -0.0625f, __builtin_fminf(zz * 0.09016844005556021f, 0.f)); }
                    if (dir == 0) { z[mi][nj][1] += z[mi][nj][0]; z[mi][nj][2] += z[mi][nj][1]; z[mi][nj][3] += z[mi][nj][2]; s[mi] = z[mi][nj][3]; }
                    else          { z[mi][nj][2] += z[mi][nj][3]; z[mi][nj][1] += z[mi][nj][2]; z[mi][nj][0] += z[mi][nj][1]; s[mi] = z[mi][nj][0]; }
                }
                float e[2], t2[2];
#pragma unroll
                for (int mi = 0; mi < 2; ++mi) { const float s1 = __shfl_xor(s[mi], 16), ps = s[mi] + s1, p2 = __shfl_xor(ps, 32); t2[mi] = ps + p2;
                    e[mi] = dir == 0 ? (((g & 1) ? s1 : 0.f) + ((g & 2) ? p2 : 0.f)) : (((g & 1) ? 0.f : s1) + ((g & 2) ? 0.f : p2)); }
                const float o0 = e[0] + (dir == 0 ? 0.f : t2[1]), o1 = e[1] + (dir == 0 ? t2[0] : 0.f);
#pragma unroll
                for (int r = 0; r < 4; ++r) { z[0][nj][r] += o0; z[1][nj][r] += o1; }
                tot[nj] = t2[0] + t2[1];
            }
#pragma unroll
            for (int jj = 0; jj < 2; ++jj) { const int idx = ptid + 256 * jj, pos = idx >> 4, e8 = (idx & 15) * 8; *(LAS v4u*)(B + OFF_V + pos * V_ROW + e8 * 2) = vv[jj]; }
#pragma unroll
            for (int pp = 0; pp < 2; ++pp) { const int da = dbase + 32 * pp;
                const float dea = __builtin_amdgcn_exp2f(tot[2 * pp]), deb = __builtin_amdgcn_exp2f(tot[2 * pp + 1]);
                if (g == 0) *(LAS f32x2*)(B + OFF_DE + da * 4) = (f32x2){dea, deb};
#pragma unroll
                for (int mi = 0; mi < 2; ++mi) { float ea[4], eb[4];
#pragma unroll
                    for (int r = 0; r < 4; ++r) { const float b_a = z[mi][2 * pp][r], b_b = z[mi][2 * pp + 1][r];
                        const float xa = __builtin_amdgcn_exp2f(b_a), xb = __builtin_amdgcn_exp2f(b_b), ia = __builtin_amdgcn_exp2f(-b_a), ib = __builtin_amdgcn_exp2f(-b_b);
                        const unsigned qw = qv[pp][mi][r], kw = kv[pp][mi][r];
                        const float ka = bflo(kw) * ia, kb = bfhi(kw) * ib; ea[r] = ka * dea; eb[r] = kb * deb;
                        const int pos = 16 * mi + 4 * g + r;
                        *(LAS unsigned*)(B + OFF_QD + pos * QD_ROW + da * 2) = pk2c(bflo(qw) * xa, bfhi(qw) * xb);
                        *(LAS unsigned*)(B + OFF_KD + pos * QD_ROW + da * 2) = pk2c(ka, kb); }
                    *(LAS v2u*)(B + OFF_KET + da * KET_ROW + (16 * mi + 4 * g) * 2) = (v2u){pk2c(ea[0], ea[1]), pk2c(ea[2], ea[3])};
                    *(LAS v2u*)(B + OFF_KET + (da + 1) * KET_ROW + (16 * mi + 4 * g) * 2) = (v2u){pk2c(eb[0], eb[1]), pk2c(eb[2], eb[3])};
                }
            }
            if (j + 1 < nch) GLA_LOAD_QKV(j + 1);
            if (j + 2 < nch) GLA_LOAD_LOW(j + 2);
            GLA_BAR();
        }
        GLA_BAR();
#undef GLA_ROW0
#undef GLA_LOAD_QKV
#undef GLA_LOAD_LOW
#undef GLA_PUT_LOW
    } else {
        const int cw = wave - 4, l16 = lane & 15, g = lane >> 4;
        bf16* OD = dir ? OB : OF;
        LAS unsigned char* PW = lds + OFF_PW + cw * (CL * P_ROW);
        f32x4 S[2][16];
#pragma unroll
        for (int cb = 0; cb < 2; ++cb)
#pragma unroll
            for (int t = 0; t < 16; ++t) S[cb][t] = (f32x4){0.f, 0.f, 0.f, 0.f};
        GLA_BAR();
        GLA_BAR();
#define GLA_WAIT() do { asm volatile("s_waitcnt lgkmcnt(0)" ::: "memory"); __builtin_amdgcn_sched_barrier(0); } while (0)
        const int lbase = (int)(uintptr_t)lds;
        const int a_qd = lbase + OFF_QD + l16 * QD_ROW + g * 16;
        const int a_kd = lbase + OFF_KD + l16 * QD_ROW + g * 16;
        const int a_qp = lbase + OFF_QD + l16 * QD_ROW + g * 8;
        const int a_ke = lbase + OFF_KET + l16 * KET_ROW + g * 16;
        const int a_de = lbase + OFF_DE + g * 16;
        const int a_v = lbase + OFF_V + (8 * g) * V_ROW + (32 * cw + l16) * 2;
        const int a_pw = (int)(uintptr_t)PW + l16 * P_ROW + g * 16;
        for (int j = 0; j < nch; ++j) {
            const int bo = (j & 1) * BUF_BYTES;
            const size_t r0 = (size_t)rowbase + (size_t)(dir ? nch - 1 - j : j) * CL;
            f32x4 pacc[2][2];
#pragma unroll
            for (int mi = 0; mi < 2; ++mi)
#pragma unroll
                for (int ni = 0; ni < 2; ++ni) pacc[mi][ni] = (f32x4){0.f, 0.f, 0.f, 0.f};
#pragma unroll
            for (int hb = 0; hb < 4; ++hb) {
                bf16x8 fa[2][2], fb[2][2];
                rd_p(fa, fb, a_qd + bo + hb * 128, a_kd + bo + hb * 128);
#pragma unroll
                for (int kk = 0; kk < 2; ++kk)
#pragma unroll
                    for (int mi = 0; mi < 2; ++mi)
#pragma unroll
                        for (int ni = 0; ni < 2; ++ni) pacc[mi][ni] = __builtin_amdgcn_mfma_f32_16x16x32_bf16(fa[mi][kk], fb[ni][kk], pacc[mi][ni], 0, 0, 0);
            }
#pragma unroll
            for (int mi = 0; mi < 2; ++mi)
#pragma unroll
                for (int ni = 0; ni < 2; ++ni)
#pragma unroll
                    for (int r = 0; r < 4; ++r) { const int pos = 16 * mi + 4 * g + r, pk = 16 * ni + l16; const bool keep = dir ? (pk >= pos) : (pk <= pos);
                        *(LAS unsigned short*)(PW + pos * P_ROW + pk * 2) = (unsigned short)(pk2c(keep ? pacc[mi][ni][r] : 0.f, 0.f) & 0xffffu); }
            unsigned vu[2][8]; bf16x8 fp[2];
            asm volatile("s_waitcnt lgkmcnt(0)" ::: "memory");
            rd_v(vu[0], a_v + bo); rd_v(vu[1], a_v + bo + 32);
            rd_pw(fp, a_pw);
            bf16x8 Bv[2];
#pragma unroll
            for (int cb = 0; cb < 2; ++cb) Bv[cb] = __builtin_bit_cast(bf16x8, (v4u){vu[cb][0] | (vu[cb][1] << 16), vu[cb][2] | (vu[cb][3] << 16), vu[cb][4] | (vu[cb][5] << 16), vu[cb][6] | (vu[cb][7] << 16)});
            f32x4 oacc[2][2];
#pragma unroll
            for (int mi = 0; mi < 2; ++mi)
#pragma unroll
                for (int cb = 0; cb < 2; ++cb) oacc[mi][cb] = __builtin_amdgcn_mfma_f32_16x16x32_bf16(fp[mi], Bv[cb], (f32x4){0.f, 0.f, 0.f, 0.f}, 0, 0, 0);
#pragma unroll
            for (int hb = 0; hb < 4; ++hb) {
                v2u q0[2][2], q1[2][2];
                rd_q(q0, q1, a_qp + bo + hb * 128);
#pragma unroll
                for (int kk = 0; kk < 2; ++kk) { const int k2 = 2 * (hb * 2 + kk);
                    bf16x8 Bs[2];
#pragma unroll
                    for (int cb = 0; cb < 2; ++cb) Bs[cb] = __builtin_bit_cast(bf16x8, (v4u){pk2c(S[cb][k2][0], S[cb][k2][1]), pk2c(S[cb][k2][2], S[cb][k2][3]), pk2c(S[cb][k2 + 1][0], S[cb][k2 + 1][1]), pk2c(S[cb][k2 + 1][2], S[cb][k2 + 1][3])});
#pragma unroll
                    for (int mi = 0; mi < 2; ++mi) { const bf16x8 a = __builtin_bit_cast(bf16x8, (v4u){q0[mi][kk].x, q0[mi][kk].y, q1[mi][kk].x, q1[mi][kk].y});
#pragma unroll
                        for (int cb = 0; cb < 2; ++cb) oacc[mi][cb] = __builtin_amdgcn_mfma_f32_16x16x32_bf16(a, Bs[cb], oacc[mi][cb], 0, 0, 0); }
                }
            }
            { bf16* op = OD + r0 * 2048 + h * 512 + sl * 128 + 32 * cw + l16;
#pragma unroll
              for (int mi = 0; mi < 2; ++mi)
#pragma unroll
                  for (int cb = 0; cb < 2; ++cb)
#pragma unroll
                      for (int r = 0; r < 4; ++r) op[(size_t)(16 * mi + 4 * g + r) * 2048 + 16 * cb] = (bf16)(pk2c(oacc[mi][cb][r], 0.f) & 0xffffu); }
#pragma unroll
            for (int hb = 0; hb < 4; ++hb) {
                bf16x8 fk[4]; f32x4 fd[4];
                rd_s(fk, fd, a_ke + bo + hb * 5120, a_de + bo + hb * 256);
#pragma unroll
                for (int t = 0; t < 4; ++t)
#pragma unroll
                    for (int cb = 0; cb < 2; ++cb) S[cb][hb * 4 + t] = __builtin_amdgcn_mfma_f32_16x16x32_bf16(fk[t], Bv[cb], S[cb][hb * 4 + t] * fd[t], 0, 0, 0);
            }
            GLA_BAR();
        }
#undef GLA_WAIT
    }
}
}

constexpr int N_PHASE_IDS = 2 + 10 * DEPTH;
__host__ __device__ constexpr bool phase_exists(int ph) {
    if (ph < 2) return true;
    const int l = (ph - 2) / 10, s = (ph - 2) % 10, kind = l % 3;
    if (s == 5) return kind == 2;
    if (s == 7) return false;
    if (s == 4) return false;
    if (s == 0 && l > 0) return false;
    if (s == 2 && kind == 0) return false;
    return true;
}
#define IN(k) (lo <= (k) && (k) < hi)
#ifndef SITE_MASK
#define SITE_MASK 0xffffu
#endif
#ifndef WGM_RES
#define WGM_RES 4
#endif
#ifndef REPS_G1
#define REPS_G1 1
#endif
#ifndef REPS_G3
#define REPS_G3 1
#endif
#ifndef REPS_SCAN
#define REPS_SCAN 1
#endif
#ifndef REPS_ATT
#define REPS_ATT 1
#endif
#define SITE(n) ((((unsigned)(SITE_MASK)) >> (n)) & 1u)
#define SEAM(k) do { if ((k) + 1 < hi) xcd_barrier(bar); } while (0)
template <int layer> __device__ __forceinline__ void layer_body(Frame& F, const XcdBarrier& bar, const int lo, const int hi, unsigned char* lds_raw) {
    constexpr size_t wreg = (layer & 1) ? WS_WB : WS_W, bw1o = (layer & 1) ? WS_BW1B : WS_BW1, bw2o = (layer & 1) ? WS_BW2B : WS_BW2;
    bf16* const w1t = (bf16*)(F.ws + wreg); bf16* const w2t = (bf16*)(F.ws + wreg + 32 * MiB); bf16* const wmix = (bf16*)(F.ws + wreg + 64 * MiB); bf16* const wot = (bf16*)(F.ws + wreg + 90 * MiB);
#define PREP_NEXT() do { if constexpr (layer + 1 < DEPTH) { __syncthreads(); bw_phase(F, layer + 1); prep_weights(F, layer + 1, (unsigned*)(F.ws + WS_CTL) + CW_PREP + 64 * (layer + 1)); } } while (0)

        constexpr int pb = 2 + 10 * layer, kind = layer % 3, jj = layer / 3;
        const float* modl = F.mod + (size_t)layer * NSEQ * 12288;
        if (SITE(2) && layer == 0 && IN(pb + 0)) { norm0_phase(F); bw_phase(F, 0); SEAM(pb + 0); }
        if (SITE(3) && IN(pb + 1)) {
            const int N1 = kind == 0 ? 3072 : (kind == 1 ? 6400 : 1024);
            pg8::Gemm g{F.H, wmix, M, N1, D, D, 256}; pg8::StaticOrder S; S.init(M, N1, F.G, (int)blockIdx.x, REPS_G1);
            if constexpr (kind == 0) {
                pg8::EpiBf16NRope E{(bf16*)(F.ws + WS_S), N1, (const float*)(F.ws + WS_SSQB), (const float*)(F.ws + bw1o), 6400,
                                    F.in[I_GQA_QN] + jj * 128, F.in[I_GQA_KN] + jj * 128, (const float*)F.ropeA, (PG8_LAS float*)(F.lds + RING_BYTES + 4096)};
                pg8::gemm_phase<pg8::EpiBf16NRope, pg8::StaticOrder, true, true>(F.lds, g, S, E);
            } else {
                pg8::EpiBf16N<0> E{(bf16*)(F.ws + WS_S), N1, (const float*)(F.ws + WS_SSQB), (const float*)(F.ws + bw1o), 6400};
                pg8::gemm_phase<pg8::EpiBf16N<0>, pg8::StaticOrder, true, true>(F.lds, g, S, E);
            }
            SEAM(pb + 1);
        }
        if (kind == 0) {
            if (SITE(5) && IN(pb + 3)) {
                const bf16* QKV = (const bf16*)(F.ws + WS_QKV);
                for (int u_ = F.vcu; u_ < 4096 * REPS_ATT; u_ += F.G) { const int u = u_ & 4095;
                    int rowq, rowk, T, head;
                    if (u < 2048) { const int sq = u >> 9, r = u & 511; head = r >> 5; T = 8192; rowk = MP + sq * 8192; rowq = rowk + (r & 31) * 256; }
                    else { const int v = u - 2048, sq = v >> 7, r = v & 127; head = r >> 3; T = 2048; rowk = sq * 2048; rowq = rowk + (r & 7) * 256; }
                    const int kvh = head >> 2;
                    attn::attn_dense_body<128, 3072, 3072, 3072, 3072, 3072, 2>(QKV + (size_t)rowq * 3072 + head * 128, QKV + (size_t)rowk * 3072 + 2048 + kvh * 128, nullptr,
                        QKV + (size_t)rowk * 3072 + 2560 + kvh * 128, (bf16*)QKV + (size_t)rowq * 3072 + head * 128, T, (char*)lds_raw);
                }
                PREP_NEXT();
                SEAM(pb + 3);
            }
        } else if (kind == 1) {
            if (SITE(6) && IN(pb + 2)) {
                const bf16* PROJ = (const bf16*)(F.ws + WS_PROJ); bf16* OB = (bf16*)(F.ws + WS_OB);
                const int nrep = REPS_SCAN + (F.G >> 24);
                for (int rp = 0; rp < nrep; ++rp) {
                    const int nmine = F.G == 256 ? (F.vcu < 128 ? 1 : 4) : (640 - F.vcu + F.G - 1) / F.G;
                    for (int q = 0; q < nmine; ++q) { const int c = F.G == 256 ? (F.vcu < 128 ? F.vcu : 128 + (F.vcu - 128) * 4 + q) : F.vcu + q * F.G;
                        gla::chain(F.lds, PROJ, F.H, OB, F.in[I_GLA_WG2], F.in[I_GLA_BG], c); } }
                PREP_NEXT();
                SEAM(pb + 2);
            }
            if (SITE(7) && IN(pb + 3)) { gla_post_phase(F); SEAM(pb + 3); }
        } else {
            if (SITE(8) && IN(pb + 2)) { mla_down_norm_phase(F); SEAM(pb + 2); }
            if (SITE(9) && IN(pb + 3)) {
                const bf16* DN = (const bf16*)(F.ws + WS_DOWN);
                { pg8::Gemm g{DN, wmix + (size_t)4 * MiB / 2, M, 3072, 512, 1024, 256}; pg8::StaticOrder S; S.init(M, 3072, F.G, (int)blockIdx.x);
                  pg8::EpiBf16P E{(bf16*)(F.ws + WS_Q), 3072};
                  pg8::gemm_phase<pg8::EpiBf16P, pg8::StaticOrder, true, true>(F.lds, g, S, E); }
                __syncthreads();
                { int K2 = 256, lda2 = 1024; asm volatile("" : "+s"(K2), "+s"(lda2));
                  pg8::Gemm g{DN + 512, wmix + (size_t)8 * MiB / 2, M, 4096, K2, lda2, 256}; pg8::StaticOrder S; S.init(M, 4096, F.G, (int)blockIdx.x);
                  pg8::EpiBf16KV E{(bf16*)(F.ws + WS_KV), 4096, F.in[I_MLA_KNN], (PG8_LAS float*)(F.lds + RING_BYTES + 4096)};
                  pg8::gemm_phase<pg8::EpiBf16KV, pg8::StaticOrder, true, true>(F.lds, g, S, E); }
                SEAM(pb + 3);
            }
            if (SITE(11) && IN(pb + 5)) {
                const bf16* Q = (const bf16*)(F.ws + WS_Q); const bf16* KV = (const bf16*)(F.ws + WS_KV); const bf16* DN = (const bf16*)(F.ws + WS_DOWN);
                for (int u_ = F.vcu; u_ < 4096 * REPS_ATT; u_ += F.G) { const int u = u_ & 4095;
                    int rowq, rowk, T, head;
                    if (u < 2048) { const int sq = u >> 9, r = u & 511; head = r >> 5; T = 8192; rowk = MP + sq * 8192; rowq = rowk + (r & 31) * 256; }
                    else { const int v = u - 2048, sq = v >> 7, r = v & 127; head = r >> 3; T = 2048; rowk = sq * 2048; rowq = rowk + (r & 7) * 256; }
                    attn::attn_dense_body<192, 3072, 4096, 1024, 4096, 3072, 1, true>(Q + (size_t)rowq * 3072 + head * 192, KV + (size_t)rowk * 4096 + head * 256, DN + (size_t)rowk * 1024 + 768,
                        KV + (size_t)rowk * 4096 + head * 256 + 128, (bf16*)Q + (size_t)rowq * 3072 + head * 192, T, (char*)lds_raw, F.in[I_MLA_QN], (const float*)F.ropeC, rowq - rowk);
                }
                PREP_NEXT();
                SEAM(pb + 5);
            }
        }
        if (SITE(12) && IN(pb + 6)) {
            const bf16* A2 = kind == 0 ? (const bf16*)(F.ws + WS_QKV) : (kind == 1 ? (const bf16*)(F.ws + WS_OB) : (const bf16*)(F.ws + WS_Q));
            pg8::Gemm g{A2, wot, M, D, D, kind == 1 ? D : 3072, kind == 2 ? 384 : 256}; pg8::StaticOrder S; S.init(M, D, F.G, (int)blockIdx.x, 1, WGM_RES);
            typedef pg8::EpiResGateNormB<layer == 0 ? 0 : 1> EpiT;
            EpiT E{F.in[I_XP], F.in[I_XS], F.out, modl + 2 * D, F.H, F.in[I_N2G] + layer * D, modl + 4 * D, (float*)(F.ws + WS_SSQA), (PG8_LAS float*)(F.lds + RING_BYTES)};
            pg8::gemm_phase<EpiT, pg8::StaticOrder, true, true>(F.lds, g, S, E);
            SEAM(pb + 6);
        }
        if (SITE(14) && IN(pb + 8)) {
            pg8::Gemm g{F.H, w1t, M, FF, D, D, 256}; pg8::StaticOrder S; S.init(M, FF, F.G, (int)blockIdx.x, REPS_G3);
            pg8::EpiBf16N<1> E{(bf16*)(F.ws + WS_HID), FF, (const float*)(F.ws + WS_SSQA), (const float*)(F.ws + bw2o), FF};
            pg8::gemm_phase<pg8::EpiBf16N<1>, pg8::StaticOrder, true, true>(F.lds, g, S, E);
            SEAM(pb + 8);
        }
        if (SITE(15) && IN(pb + 9)) {
            pg8::Gemm g{(const bf16*)(F.ws + WS_HID), w2t, M, D, FF, FF, 256}; pg8::StaticOrder S; S.init(M, D, F.G, (int)blockIdx.x, 1, WGM_RES);
            typedef pg8::EpiResGateNormB<layer + 1 < DEPTH ? 1 : 2> EpiT;
            EpiT E{nullptr, F.in[I_XS], F.out, modl + 5 * D, layer + 1 < DEPTH ? F.H : nullptr, F.in[I_N1G] + (layer + 1 < DEPTH ? layer + 1 : 0) * D,
                   modl + (layer + 1 < DEPTH ? NSEQ * 12288 + D : 0), (float*)(F.ws + WS_SSQB), (PG8_LAS float*)(F.lds + RING_BYTES)};
            pg8::gemm_phase<EpiT, pg8::StaticOrder, true, true>(F.lds, g, S, E);
            SEAM(pb + 9);
        }
    }
#undef PREP_NEXT
__global__ void __launch_bounds__(NWAVES * 64, 2) trunk_fwd(Args args) {
    extern __shared__ __attribute__((aligned(16))) unsigned char lds_raw[];
    Frame F;
    F.lds = (LAS unsigned char*)lds_raw;
    F.tid = threadIdx.x; F.lane = F.tid & 63; F.wave = __builtin_amdgcn_readfirstlane(F.tid >> 6);
    F.G = gridDim.x; { const int bx = blockIdx.x; F.vcu = (F.G % 8 == 0) ? (bx % 8) * (F.G / 8) + bx / 8 : bx; }
    F.in = args.in; F.out = args.out; F.ws = args.ws;
    F.mod = (float*)(args.ws + WS_MOD); F.ropeA = (const f32x2*)(args.ws + WS_ROPE); F.ropeC = F.ropeA + 192 * 32;
    F.H = (bf16*)(args.ws + WS_H);
    for (int u = F.tid; u < (LDS_BYTES - LDSCTL_OFF) / 4; u += NWAVES * 64) ((LAS unsigned*)(F.lds + LDSCTL_OFF))[u] = 0u;
    __syncthreads();
    XcdBarrier bar; bar.bar = (unsigned*)(args.ws + WS_CTL) + CW_BAR; bar.x = 0; bar.st = nullptr;
    if (args.one_launch) bar = xcd_barrier_post((unsigned*)(args.ws + WS_CTL) + CW_BAR, (volatile LAS unsigned*)(F.lds + LDSCTL_OFF));
    const int lo = args.ph_lo, hi = args.ph_hi;

    if (SITE(0) && IN(0)) { ada_phase(F); rope_tables(F); prep_weights(F, 0, (unsigned*)(F.ws + WS_CTL) + CW_PREP); SEAM(0); }
    if (SITE(1) && IN(1)) { mod_finalize(F); SEAM(1); }

    layer_body<0>(F, bar, lo, hi, lds_raw); layer_body<1>(F, bar, lo, hi, lds_raw); layer_body<2>(F, bar, lo, hi, lds_raw); layer_body<3>(F, bar, lo, hi, lds_raw);
#undef IN
#undef SEAM
}

extern "C" void kernel_launch(void* const* d_in, const int* in_sizes, int n_in, void* d_out, int out_size, void* d_ws, size_t ws_size, hipStream_t stream) {
    static int grid = 0;
    if (grid == 0) {
        if (n_in != N_IN || out_size != M * D || ws_size < WS_END) { fprintf(stderr, "kernel_launch: unexpected shapes (n_in %d out %d ws %zu, need %zu)\n", n_in, out_size, ws_size, (size_t)WS_END); grid = -1; return; }
        int dev = 0, cus = 0, per_cu = 0;
        if (hipGetDevice(&dev) != hipSuccess || hipDeviceGetAttribute(&cus, hipDeviceAttributeMultiprocessorCount, dev) != hipSuccess) { grid = -1; return; }
        if (hipFuncSetAttribute((const void*)trunk_fwd, hipFuncAttributeMaxDynamicSharedMemorySize, LDS_BYTES) != hipSuccess) { fprintf(stderr, "kernel_launch: hipFuncSetAttribute failed\n"); grid = -1; return; }
        if (hipOccupancyMaxActiveBlocksPerMultiprocessor(&per_cu, (const void*)trunk_fwd, NWAVES * 64, LDS_BYTES) != hipSuccess || per_cu < 1) { fprintf(stderr, "kernel_launch: occupancy query says %d blocks per CU\n", per_cu); }
        (void)hipGetLastError();
        grid = cus;
    }
    if (grid < 0) return;
    (void)hipMemsetAsync((char*)d_ws + WS_CTL, 0, CTL_ZERO_BYTES, stream);
    Args a{};
    for (int i = 0; i < N_IN; ++i) a.in[i] = (const float*)d_in[i];
    a.out = (float*)d_out; a.ws = (unsigned char*)d_ws; a.pad = 0;
#if MK_ONE_LAUNCH
    a.ph_lo = 0; a.ph_hi = N_PHASE_IDS; a.one_launch = 1;
    hipLaunchKernelGGL(trunk_fwd, dim3(grid), dim3(NWAVES * 64), LDS_BYTES, stream, a);
#else
    for (int ph = 0; ph < N_PHASE_IDS; ++ph) { if (!phase_exists(ph)) continue;
        a.ph_lo = ph; a.ph_hi = ph + 1; a.one_launch = 0;
        hipLaunchKernelGGL(trunk_fwd, dim3(grid), dim3(NWAVES * 64), LDS_BYTES, stream, a); }
#endif
    const hipError_t le = hipPeekAtLastError();
    if (le != hipSuccess) fprintf(stderr, "kernel_launch: launch failed: %s\n", hipGetErrorName(le));
}
```

```cpp
#include <hip/hip_runtime.h>
#include <cstdio>
#include <cstdint>

#define GAS __attribute__((address_space(1)))
#define LAS __attribute__((address_space(3)))
#define PG8_LAS __attribute__((address_space(3)))

#ifndef MK_ONE_LAUNCH
#define MK_ONE_LAUNCH 1
#endif

constexpr int D = 2048, M = 65536, MP = 32768, NSEQ = 20, FF = 8192, DEPTH = 4;
constexpr float NORM_EPS = 1e-6f;
enum { I_XP = 0, I_XS, I_CP, I_CS, I_N1G, I_N2G, I_ADAW, I_ADAB, I_GQA_WQKV, I_GQA_QN, I_GQA_KN, I_GQA_WO, I_GLA_WIN, I_GLA_WG1, I_GLA_WG2, I_GLA_BG, I_GLA_ON, I_GLA_WO,
       I_MLA_WDOWN, I_MLA_QAN, I_MLA_KVAN, I_MLA_WUQ, I_MLA_WUKV, I_MLA_QN, I_MLA_KNN, I_MLA_KRN, I_MLA_WO, I_W1, I_W2, N_IN };

constexpr size_t MiB = 1u << 20;
constexpr size_t WS_CTL = 0, CTL_ZERO_BYTES = 1 * MiB;
constexpr size_t WS_MODP = 384 * MiB;
constexpr size_t WS_MOD = 16 * MiB;
constexpr size_t WS_ROPE = 20 * MiB;
constexpr size_t WS_BW1 = 20 * MiB + 256 * 1024, WS_BW2 = 21 * MiB;
constexpr size_t WS_BW1B = 26 * MiB, WS_BW2B = 26 * MiB + 768 * 1024;
constexpr size_t WS_SSQA = 22 * MiB, WS_SSQB = 24 * MiB;
constexpr size_t WS_W = 28 * MiB;
constexpr size_t WS_W1T = WS_W, WS_W2T = WS_W + 32 * MiB, WS_WMIX = WS_W + 64 * MiB;
constexpr size_t WS_WO_T = WS_WMIX + 26 * MiB;
constexpr size_t WS_H = 128 * MiB;
constexpr size_t WS_S = 384 * MiB;
constexpr size_t WS_QKV = WS_S;
constexpr size_t WS_PROJ = WS_S, WS_OB = WS_S + 800 * MiB;
constexpr size_t WS_DOWN = WS_S, WS_Q = WS_S + 128 * MiB, WS_KV = WS_S + 512 * MiB;
constexpr size_t WS_HID = WS_S;
constexpr size_t WS_WB = WS_S + 1056 * MiB;
constexpr size_t WS_END = WS_WB + 100 * MiB;
static_assert(WS_WO_T + 8 * MiB <= WS_H && WS_OB + 256 * MiB <= WS_END && WS_KV + 512 * MiB <= WS_END && WS_HID + 1024 * MiB <= WS_END, "ws map");
constexpr int CW_BAR = 4096;
constexpr int CW_PREP = 8192;

constexpr int RING_BYTES = 131072;
constexpr int LDSCTL_OFF = 144 * 1024 - 512;
constexpr int LDS_BYTES = 147456;

typedef unsigned short bf16;
typedef unsigned v4u __attribute__((ext_vector_type(4)));
typedef unsigned v2u __attribute__((ext_vector_type(2)));
typedef unsigned v3u __attribute__((ext_vector_type(3)));
typedef float f32x4 __attribute__((ext_vector_type(4)));
typedef float f32x2 __attribute__((ext_vector_type(2)));
typedef short bf16x8 __attribute__((ext_vector_type(8)));
typedef GAS unsigned gu32;
#define RLX_AGENT __ATOMIC_RELAXED, __HIP_MEMORY_SCOPE_AGENT
#define LDS_WAIT() asm volatile("s_waitcnt lgkmcnt(0)" ::: "memory")
#define VM_WAIT() asm volatile("s_waitcnt vmcnt(0)" ::: "memory")
__device__ __forceinline__ unsigned f2bf(float f) { unsigned u = __builtin_bit_cast(unsigned, f); return (u + 0x7fffu + ((u >> 16) & 1u)) >> 16; }
typedef __bf16 bf16x2_t __attribute__((ext_vector_type(2)));
__device__ __forceinline__ unsigned pk2c(float lo, float hi) { const f32x2 v = {lo, hi}; const bf16x2_t b = __builtin_convertvector(v, bf16x2_t); return __builtin_bit_cast(unsigned, b); }
__device__ __forceinline__ unsigned pk2(float lo, float hi) { unsigned r; asm volatile("v_cvt_pk_bf16_f32 %0, %1, %2" : "=v"(r) : "v"(lo), "v"(hi)); return r; }
__device__ __forceinline__ float bflo(unsigned u) { return __uint_as_float(u << 16); }
__device__ __forceinline__ float bfhi(unsigned u) { return __uint_as_float(u & 0xffff0000u); }
__device__ __forceinline__ int seq_of_row(int row) { return row < MP ? (row >> 11) : 16 + ((row - MP) >> 13); }
__device__ __forceinline__ int pos_of_row(int row) { return row < MP ? (row & 2047) : (row & 8191); }
__device__ __forceinline__ float wave_sum(float v) {
#pragma unroll
    for (int o = 1; o < 64; o <<= 1) v += __shfl_xor(v, o);
    return v;
}
namespace pg8 {
typedef unsigned short bf16_t;
typedef short bf16x8 __attribute__((ext_vector_type(8)));
typedef float f32x4 __attribute__((ext_vector_type(4)));
typedef unsigned u32x4 __attribute__((ext_vector_type(4)));
constexpr int BM = 256, BK = 64, HALF = 128, HTB = HALF * BK * 2  , STAGE_BYTES = 8 * HTB, NXCD = 8, WGM = 8;

__host__ __device__ __forceinline__ int lds_byte(int r, int c) { const int st = (r >> 4) * 2 + (c >> 5), rr = r & 15, cc = c & 31, ob = rr * 64 + cc * 2; return st * 1024 + (ob ^ (((ob >> 9) & 1) << 5)); }
__host__ __device__ __forceinline__ void stage_rc(int b, int& R, int& C) { const int st = b / 1024, sb = b % 1024, swz = sb ^ (((sb >> 9) & 1) << 5); R = (st >> 1) * 16 + swz / 64; C = (st & 1) * 32 + (swz % 64) / 2; }
__host__ __device__ __forceinline__ int perm32(int rho) { const int n = rho >> 4, i = rho & 15; return 8 * (i >> 2) + 4 * n + (i & 3); }

struct Unit { int pm, pn; };
struct Gemm { const bf16_t* A; const bf16_t* Bt; int M, N, K, lda, pairA; };

struct StaticOrder {
    int nM, nN, nwg, G, c, reps, wgm;
    __host__ __device__ void init(int M, int N, int G_, int c_, int reps_ = 1, int wgm_ = 4) { nM = M / BM; nN = N / BM; nwg = nM * nN; G = G_; c = c_; reps = reps_; wgm = wgm_; }
    __host__ __device__ bool next(int i, Unit& u) const {
        long L = (long)i * G + c; if (L >= (long)nwg * reps) return false;
        L %= nwg;
        int wgid = (int)L; { const int q = nwg / NXCD, r = nwg % NXCD, xcd = wgid % NXCD, off = wgid / NXCD; wgid = (xcd < r ? xcd * (q + 1) : r * (q + 1) + (xcd - r) * q) + off; }
        const int nig = wgm * nN, gid = wgid / nig, fm = gid * wgm, gsz = (nM - fm) < wgm ? (nM - fm) : wgm;
        u.pm = fm + ((wgid % nig) % gsz); u.pn = (wgid % nig) / gsz; return true;
    }
    __device__ __forceinline__ void a_ready(const Unit&) const {}
    __device__ __forceinline__ void done(const Unit&) const {}
};


__device__ __forceinline__ unsigned cvt_pk_bf16(float lo, float hi) { return ::pk2(lo, hi); }
template <int ACT> struct EpiBf16N {
    static constexpr bool PERM = true, AFTER_DRAIN = false, OWN_ALIGN = true;
    bf16_t* O; int ldc; const float* ssq; const float* bw; int ldbw;
    __device__ __forceinline__ void operator()(const f32x4 (&acc)[2][2][4][2], const Unit& u, int wr, int wc, int fr, int fq) const {
        const int rowt = u.pm * BM, row0 = rowt + wr * 64 + fr, col0 = u.pn * BM + wc * 32 + 8 * fq;
        const int seq = rowt < 32768 ? (rowt >> 11) : 16 + ((rowt - 32768) >> 13);
        typedef float f32x2v __attribute__((ext_vector_type(2)));
        f32x2v pv[8]; f32x4 bv[2][2];
#pragma unroll
        for (int i = 0; i < 8; ++i) pv[i] = *(const f32x2v*)(ssq + (size_t)(row0 + (i >> 2) * HALF + (i & 3) * 16) * 8 + 2 * fq);
#pragma unroll
        for (int bj = 0; bj < 2; ++bj)
#pragma unroll
            for (int n = 0; n < 2; ++n) bv[bj][n] = *(const f32x4*)(bw + (size_t)seq * ldbw + col0 + bj * HALF + 4 * n);
        asm volatile("" ::: "memory"); if (wr == 0) __builtin_amdgcn_s_barrier(); asm volatile("" ::: "memory");
        float rs[8];
#pragma unroll
        for (int i = 0; i < 8; ++i) { float s = pv[i].x + pv[i].y; s += __shfl_xor(s, 16); s += __shfl_xor(s, 32); rs[i] = __builtin_amdgcn_rsqf(s * (1.f / 2048.f) + 1e-6f); }
#pragma unroll
        for (int ai = 0; ai < 2; ++ai)
#pragma unroll
            for (int m = 0; m < 4; ++m) { const int r = row0 + ai * HALF + m * 16; const float rsr = rs[ai * 4 + m];
                bf16_t* rowp = O + (size_t)r * ldc + col0;
#pragma unroll
                for (int bj = 0; bj < 2; ++bj) { f32x4 v0 = acc[ai][bj][m][0] * rsr + bv[bj][0], v1 = acc[ai][bj][m][1] * rsr + bv[bj][1];
                    if (ACT == 1) {
#pragma unroll
                        for (int j = 0; j < 4; ++j) { const float a = fmaxf(v0[j], 0.f), b = fmaxf(v1[j], 0.f); v0[j] = a * a; v1[j] = b * b; } }
                    u32x4 w; w.x = cvt_pk_bf16(v0[0], v0[1]); w.y = cvt_pk_bf16(v0[2], v0[3]); w.z = cvt_pk_bf16(v1[0], v1[1]); w.w = cvt_pk_bf16(v1[2], v1[3]);
                    *(u32x4*)(rowp + bj * HALF) = w; } }
    }
};
struct EpiResGateNorm {
    static constexpr bool PERM = false, AFTER_DRAIN = false, OWN_ALIGN = false;
    const float* in0; const float* in1; float* out; const float* gate;
    bf16_t* xa; const float* gn; const float* sc; float* ssq; PG8_LAS float* xl;
    __device__ __forceinline__ void operator()(const f32x4 (&acc)[2][2][4][2], const Unit& u, int wr, int wc, int fr, int fq) const {
        const int rowt = u.pm * BM, row0 = rowt + wr * 64 + fr, col0 = u.pn * BM + wc * 32 + 4 * fq;
        const int seq = rowt < 32768 ? (rowt >> 11) : 16 + ((rowt - 32768) >> 13);
        const float* gp = gate + (size_t)seq * 12288 + col0;
        typedef unsigned u32x2 __attribute__((ext_vector_type(2)));
        u32x2 dp[2][2][4][2];
        {
            f32x4 gv[2][2];
#pragma unroll
            for (int bj = 0; bj < 2; ++bj)
#pragma unroll
                for (int n = 0; n < 2; ++n) gv[bj][n] = *(const f32x4*)(gp + bj * HALF + n * 16);
#pragma unroll
            for (int ai = 0; ai < 2; ++ai)
#pragma unroll
                for (int bj = 0; bj < 2; ++bj)
#pragma unroll
                    for (int m = 0; m < 4; ++m)
#pragma unroll
                        for (int n = 0; n < 2; ++n) { const f32x4 d = gv[bj][n] * acc[ai][bj][m][n]; dp[ai][bj][m][n] = (u32x2){cvt_pk_bf16(d[0], d[1]), cvt_pk_bf16(d[2], d[3])}; }
        }
        asm volatile("" ::: "memory");
        const float* base = in0 ? (rowt < 32768 ? in0 : in1 - (size_t)32768 * 2048) : out;
        f32x4 av[2][2];
#pragma unroll
        for (int bj = 0; bj < 2; ++bj)
#pragma unroll
            for (int n = 0; n < 2; ++n) { if (xa) av[bj][n] = *(const f32x4*)(gn + col0 + bj * HALF + n * 16) * (*(const f32x4*)(sc + (size_t)seq * 12288 + col0 + bj * HALF + n * 16) + 1.0f); else av[bj][n] = (f32x4){0.f, 0.f, 0.f, 0.f}; }
#pragma unroll
        for (int ai = 0; ai < 2; ++ai) {
            f32x4 bsv[4][2][2];
#pragma unroll
            for (int m = 0; m < 4; ++m)
#pragma unroll
                for (int bj = 0; bj < 2; ++bj)
#pragma unroll
                    for (int n = 0; n < 2; ++n) bsv[m][bj][n] = *(const f32x4*)(base + (size_t)(row0 + ai * HALF + m * 16) * 2048 + col0 + bj * HALF + n * 16);
            asm volatile("" ::: "memory");
#pragma unroll
            for (int m = 0; m < 4; ++m) { const size_t off = (size_t)(row0 + ai * HALF + m * 16) * 2048 + col0; float ss = 0.f;
#pragma unroll
                for (int bj = 0; bj < 2; ++bj)
#pragma unroll
                    for (int n = 0; n < 2; ++n) { const u32x2 dq = dp[ai][bj][m][n];
                        const f32x4 d = {__uint_as_float(dq.x << 16), __uint_as_float(dq.x & 0xffff0000u), __uint_as_float(dq.y << 16), __uint_as_float(dq.y & 0xffff0000u)};
                        const f32x4 o = bsv[m][bj][n] + d;
                        *(f32x4*)(out + off + bj * HALF + n * 16) = o;
                        if (xa) { const f32x4 y = o * av[bj][n]; ss += (o[0] * o[0] + o[1] * o[1]) + (o[2] * o[2] + o[3] * o[3]);
                            *(u32x2*)(xa + off + bj * HALF + n * 16) = (u32x2){cvt_pk_bf16(y[0], y[1]), cvt_pk_bf16(y[2], y[3])}; } }
                if (xa) { ss += __shfl_xor(ss, 16); ss += __shfl_xor(ss, 32);
                    if (fq == 0) xl[(ai * HALF + wr * 64 + m * 16 + fr) * 4 + wc] = ss; } }
            asm volatile("" ::: "memory");
        }
        if (xa) {
            asm volatile("s_waitcnt lgkmcnt(0)" ::: "memory"); __builtin_amdgcn_s_barrier(); asm volatile("" ::: "memory");
            const int t = threadIdx.x;
            if (t < 256) { const f32x4 p = *(const PG8_LAS f32x4*)(xl + t * 4); ssq[(size_t)(rowt + t) * 8 + u.pn] = (p[0] + p[1]) + (p[2] + p[3]); }
        }
    }
};
template <int MODE>
struct EpiResGateNormB {
    static constexpr bool PERM = true, AFTER_DRAIN = false, OWN_ALIGN = true;
    const float* in0; const float* in1; float* out; const float* gate;
    bf16_t* xa; const float* gn; const float* sc; float* ssq; PG8_LAS float* xl;
    static __device__ __forceinline__ void unpack(u32x4 w, f32x4& lo, f32x4& hi) {
        lo = (f32x4){__uint_as_float(w.x << 16), __uint_as_float(w.x & 0xffff0000u), __uint_as_float(w.y << 16), __uint_as_float(w.y & 0xffff0000u)};
        hi = (f32x4){__uint_as_float(w.z << 16), __uint_as_float(w.z & 0xffff0000u), __uint_as_float(w.w << 16), __uint_as_float(w.w & 0xffff0000u)};
    }
    static __device__ __forceinline__ u32x4 pack(f32x4 lo, f32x4 hi) { u32x4 w; w.x = cvt_pk_bf16(lo[0], lo[1]); w.y = cvt_pk_bf16(lo[2], lo[3]); w.z = cvt_pk_bf16(hi[0], hi[1]); w.w = cvt_pk_bf16(hi[2], hi[3]); return w; }
    __device__ __forceinline__ void operator()(const f32x4 (&acc)[2][2][4][2], const Unit& u, int wr, int wc, int fr, int fq) const {
        const int rowt = u.pm * BM, row0 = rowt + wr * 64 + fr, col0 = u.pn * BM + wc * 32 + 8 * fq;
        const int seq = rowt < 32768 ? (rowt >> 11) : 16 + ((rowt - 32768) >> 13);
        const float* gp = gate + (size_t)seq * 12288 + col0;
        bf16_t* const xb = (bf16_t*)out + (size_t)row0 * 4096 + u.pn * 512 + wc * 32 + 8 * fq;
        f32x4 gv[2][2], av[2][2];
        if constexpr (MODE == 0) {
            typedef unsigned u32x2 __attribute__((ext_vector_type(2)));
            u32x2 dp[2][2][4][2];
#pragma unroll
            for (int bj = 0; bj < 2; ++bj)
#pragma unroll
                for (int n = 0; n < 2; ++n) gv[bj][n] = *(const f32x4*)(gp + bj * HALF + 4 * n);
            asm volatile("" ::: "memory"); if (wr == 0) __builtin_amdgcn_s_barrier(); asm volatile("" ::: "memory");
#pragma unroll
            for (int ai = 0; ai < 2; ++ai)
#pragma unroll
                for (int bj = 0; bj < 2; ++bj)
#pragma unroll
                    for (int m = 0; m < 4; ++m)
#pragma unroll
                        for (int n = 0; n < 2; ++n) { const f32x4 d = gv[bj][n] * acc[ai][bj][m][n]; dp[ai][bj][m][n] = (u32x2){cvt_pk_bf16(d[0], d[1]), cvt_pk_bf16(d[2], d[3])}; }
            asm volatile("" ::: "memory");
#pragma unroll
            for (int bj = 0; bj < 2; ++bj)
#pragma unroll
                for (int n = 0; n < 2; ++n) av[bj][n] = *(const f32x4*)(sc + (size_t)seq * 12288 + col0 + bj * HALF + 4 * n);
            const float* base = rowt < 32768 ? in0 : in1 - (size_t)32768 * 2048;
#pragma unroll
            for (int ai = 0; ai < 2; ++ai) {
                f32x4 bsv[4][2][2];
#pragma unroll
                for (int m = 0; m < 4; ++m)
#pragma unroll
                    for (int bj = 0; bj < 2; ++bj)
#pragma unroll
                        for (int n = 0; n < 2; ++n) bsv[m][bj][n] = *(const f32x4*)(base + (size_t)(row0 + ai * HALF + m * 16) * 2048 + col0 + bj * HALF + 4 * n);
                asm volatile("" ::: "memory");
#pragma unroll
                for (int m = 0; m < 4; ++m) { const size_t off = (size_t)(row0 + ai * HALF + m * 16) * 2048 + col0; float ss = 0.f;
#pragma unroll
                    for (int bj = 0; bj < 2; ++bj) { f32x4 o[2];
#pragma unroll
                        for (int n = 0; n < 2; ++n) { const u32x2 dq = dp[ai][bj][m][n];
                            const f32x4 d = {__uint_as_float(dq.x << 16), __uint_as_float(dq.x & 0xffff0000u), __uint_as_float(dq.y << 16), __uint_as_float(dq.y & 0xffff0000u)};
                            o[n] = bsv[m][bj][n] + d; ss += (o[n][0] * o[n][0] + o[n][1] * o[n][1]) + (o[n][2] * o[n][2] + o[n][3] * o[n][3]); }
                        *(u32x4*)(xb + (size_t)(ai * HALF + m * 16) * 4096 + bj * HALF) = pack(o[0], o[1]);
                        *(u32x4*)(xa + off + bj * HALF) = pack(o[0] * av[bj][0], o[1] * av[bj][1]); }
                    ss += __shfl_xor(ss, 16); ss += __shfl_xor(ss, 32);
                    if (fq == 0) xl[(ai * HALF + wr * 64 + m * 16 + fr) * 4 + wc] = ss; }
                asm volatile("" ::: "memory");
            }
        } else {
            u32x4 xv[2][4][2], dpk[2][4][2];
#pragma unroll
            for (int bj = 0; bj < 2; ++bj)
#pragma unroll
                for (int n = 0; n < 2; ++n) gv[bj][n] = *(const f32x4*)(gp + bj * HALF + 4 * n);
#pragma unroll
            for (int m = 0; m < 4; ++m)
#pragma unroll
                for (int bj = 0; bj < 2; ++bj) xv[0][m][bj] = *(const u32x4*)(xb + (size_t)(m * 16) * 4096 + bj * HALF);
            asm volatile("" ::: "memory"); if (wr == 0) __builtin_amdgcn_s_barrier(); asm volatile("" ::: "memory");
#pragma unroll
            for (int ai = 0; ai < 2; ++ai)
#pragma unroll
                for (int m = 0; m < 4; ++m)
#pragma unroll
                    for (int bj = 0; bj < 2; ++bj) dpk[ai][m][bj] = pack(gv[bj][0] * acc[ai][bj][m][0], gv[bj][1] * acc[ai][bj][m][1]);
            asm volatile("" ::: "memory");
#pragma unroll
            for (int bj = 0; bj < 2; ++bj)
#pragma unroll
                for (int n = 0; n < 2; ++n) { if constexpr (MODE == 1) av[bj][n] = *(const f32x4*)(sc + (size_t)seq * 12288 + col0 + bj * HALF + 4 * n); else av[bj][n] = (f32x4){0.f, 0.f, 0.f, 0.f}; }
#pragma unroll
            for (int m = 0; m < 4; ++m)
#pragma unroll
                for (int bj = 0; bj < 2; ++bj) xv[1][m][bj] = *(const u32x4*)(xb + (size_t)(HALF + m * 16) * 4096 + bj * HALF);
            if constexpr (MODE == 2) { asm volatile("s_waitcnt vmcnt(0)" ::: "memory"); __builtin_amdgcn_s_barrier(); }
            asm volatile("" ::: "memory");
#pragma unroll
            for (int ai = 0; ai < 2; ++ai) {
#pragma unroll
                for (int m = 0; m < 4; ++m) { const size_t off = (size_t)(row0 + ai * HALF + m * 16) * 2048 + col0; float ss = 0.f;
#pragma unroll
                    for (int bj = 0; bj < 2; ++bj) { f32x4 o[2], d[2]; unpack(xv[ai][m][bj], o[0], o[1]); unpack(dpk[ai][m][bj], d[0], d[1]); o[0] += d[0]; o[1] += d[1];
                        if constexpr (MODE == 2) { *(f32x4*)(out + off + bj * HALF) = o[0]; *(f32x4*)(out + off + bj * HALF + 4) = o[1]; }
                        else {
#pragma unroll
                            for (int n = 0; n < 2; ++n) ss += (o[n][0] * o[n][0] + o[n][1] * o[n][1]) + (o[n][2] * o[n][2] + o[n][3] * o[n][3]);
                            *(u32x4*)(xb + (size_t)(ai * HALF + m * 16) * 4096 + bj * HALF) = pack(o[0], o[1]);
                            *(u32x4*)(xa + off + bj * HALF) = pack(o[0] * av[bj][0], o[1] * av[bj][1]); } }
                    if constexpr (MODE != 2) { ss += __shfl_xor(ss, 16); ss += __shfl_xor(ss, 32);
                        if (fq == 0) xl[(ai * HALF + wr * 64 + m * 16 + fr) * 4 + wc] = ss; } }
                asm volatile("" ::: "memory");
            }
        }
        if constexpr (MODE != 2) {
            asm volatile("s_waitcnt lgkmcnt(0)" ::: "memory"); __builtin_amdgcn_s_barrier(); asm volatile("" ::: "memory");
            const int t = threadIdx.x;
            if (t < 256) { const f32x4 p = *(const PG8_LAS f32x4*)(xl + t * 4); ssq[(size_t)(rowt + t) * 8 + u.pn] = (p[0] + p[1]) + (p[2] + p[3]); }
        }
    }
};
struct EpiBf16NRope {
    static constexpr bool PERM = true, AFTER_DRAIN = false, OWN_ALIGN = true;
    bf16_t* O; int ldc; const float* ssq; const float* bw; int ldbw;
    const float* qg; const float* kg; const float* rope; PG8_LAS float* hs;
    __device__ __forceinline__ void operator()(f32x4 (&acc)[2][2][4][2], const Unit& u, int wr, int wc, int fr, int fq) const {
        const int rowt = u.pm * BM, row0 = rowt + wr * 64 + fr, col0 = u.pn * BM + wc * 32 + 8 * fq;
        const int seq = rowt < 32768 ? (rowt >> 11) : 16 + ((rowt - 32768) >> 13);
        const bool roped = u.pn < 10;
        typedef float f32x2v __attribute__((ext_vector_type(2)));
        f32x2v pv[8]; f32x4 bv[2][2], gv[2];
#pragma unroll
        for (int i = 0; i < 8; ++i) pv[i] = *(const f32x2v*)(ssq + (size_t)(row0 + (i >> 2) * HALF + (i & 3) * 16) * 8 + 2 * fq);
#pragma unroll
        for (int bj = 0; bj < 2; ++bj)
#pragma unroll
            for (int n = 0; n < 2; ++n) bv[bj][n] = *(const f32x4*)(bw + (size_t)seq * ldbw + col0 + bj * HALF + 4 * n);
        { const float* g = (u.pn < 8 ? qg : kg) + wc * 32 + 8 * fq; gv[0] = *(const f32x4*)g; gv[1] = *(const f32x4*)(g + 4); }
        asm volatile("" ::: "memory"); if (wr == 0) __builtin_amdgcn_s_barrier(); asm volatile("" ::: "memory");
        float rs[8];
#pragma unroll
        for (int i = 0; i < 8; ++i) { float s = pv[i].x + pv[i].y; s += __shfl_xor(s, 16); s += __shfl_xor(s, 32); rs[i] = __builtin_amdgcn_rsqf(s * (1.f / 2048.f) + 1e-6f); }
#pragma unroll
        for (int ai = 0; ai < 2; ++ai)
#pragma unroll
            for (int m = 0; m < 4; ++m)
#pragma unroll
                for (int bj = 0; bj < 2; ++bj) { const float rsr = rs[ai * 4 + m];
                    acc[ai][bj][m][0] = acc[ai][bj][m][0] * rsr + bv[bj][0]; acc[ai][bj][m][1] = acc[ai][bj][m][1] * rsr + bv[bj][1];
                    if (roped) { const f32x4 a = acc[ai][bj][m][0], b = acc[ai][bj][m][1];
                        float s = ((a[0] * a[0] + a[1] * a[1]) + (a[2] * a[2] + a[3] * a[3])) + ((b[0] * b[0] + b[1] * b[1]) + (b[2] * b[2] + b[3] * b[3]));
                        s += __shfl_xor(s, 16); s += __shfl_xor(s, 32);
                        if (fq == 0) hs[((ai * HALF + wr * 64 + m * 16 + fr) * 2 + bj) * 4 + wc] = s; } }
        if (roped) { asm volatile("s_waitcnt lgkmcnt(0)" ::: "memory"); __builtin_amdgcn_s_barrier(); asm volatile("" ::: "memory"); }
#pragma unroll
        for (int ai = 0; ai < 2; ++ai) {
            f32x4 cs[4][2];
            if (roped) {
#pragma unroll
                for (int m = 0; m < 4; ++m) { const int r = row0 + ai * HALF + m * 16, t = r < 32768 ? (r & 2047) : (r & 8191);
                    const float* rp = rope + (size_t)((wc < 2 ? (t >> 6) : 128 + (t & 63)) * 32 + (wc & 1) * 16 + 4 * fq) * 2;
                    cs[m][0] = *(const f32x4*)rp; cs[m][1] = *(const f32x4*)(rp + 4); }
            }
#pragma unroll
            for (int m = 0; m < 4; ++m) { const int r = row0 + ai * HALF + m * 16; bf16_t* rowp = O + (size_t)r * ldc + col0;
#pragma unroll
                for (int bj = 0; bj < 2; ++bj) { f32x4 v0 = acc[ai][bj][m][0], v1 = acc[ai][bj][m][1];
                    if (roped) { const f32x4 hp = *(const PG8_LAS f32x4*)(hs + ((ai * HALF + wr * 64 + m * 16 + fr) * 2 + bj) * 4);
                        const float hr = __builtin_amdgcn_rsqf(((hp[0] + hp[1]) + (hp[2] + hp[3])) * (1.f / 128.f) + 1e-6f);
                        v0 = v0 * hr * gv[0]; v1 = v1 * hr * gv[1];
                        const f32x4 c0 = cs[m][0], c1 = cs[m][1];
                        const float a0 = v0[0] * c0[0] - v0[1] * c0[1], a1 = v0[0] * c0[1] + v0[1] * c0[0], a2 = v0[2] * c0[2] - v0[3] * c0[3], a3 = v0[2] * c0[3] + v0[3] * c0[2];
                        const float b0 = v1[0] * c1[0] - v1[1] * c1[1], b1 = v1[0] * c1[1] + v1[1] * c1[0], b2 = v1[2] * c1[2] - v1[3] * c1[3], b3 = v1[2] * c1[3] + v1[3] * c1[2];
                        v0 = (f32x4){a0, a1, a2, a3}; v1 = (f32x4){b0, b1, b2, b3}; }
                    u32x4 w; w.x = cvt_pk_bf16(v0[0], v0[1]); w.y = cvt_pk_bf16(v0[2], v0[3]); w.z = cvt_pk_bf16(v1[0], v1[1]); w.w = cvt_pk_bf16(v1[2], v1[3]);
                    *(u32x4*)(rowp + bj * HALF) = w; } }
        }
    }
};
struct EpiBf16KV {
    static constexpr bool PERM = true, AFTER_DRAIN = false, OWN_ALIGN = false;
    bf16_t* O; int ldc; const float* kg; PG8_LAS float* hs;
    __device__ __forceinline__ void operator()(const f32x4 (&acc)[2][2][4][2], const Unit& u, int wr, int wc, int fr, int fq) const {
        const int row0 = u.pm * BM + wr * 64 + fr, col0 = u.pn * BM + wc * 32 + 8 * fq;
        const f32x4 g0 = *(const f32x4*)(kg + wc * 32 + 8 * fq), g1 = *(const f32x4*)(kg + wc * 32 + 8 * fq + 4);
#pragma unroll
        for (int ai = 0; ai < 2; ++ai)
#pragma unroll
            for (int m = 0; m < 4; ++m) { const f32x4 a = acc[ai][0][m][0], b = acc[ai][0][m][1];
                float s = ((a[0] * a[0] + a[1] * a[1]) + (a[2] * a[2] + a[3] * a[3])) + ((b[0] * b[0] + b[1] * b[1]) + (b[2] * b[2] + b[3] * b[3]));
                s += __shfl_xor(s, 16); s += __shfl_xor(s, 32);
                if (fq == 0) hs[(ai * HALF + wr * 64 + m * 16 + fr) * 4 + wc] = s; }
#pragma unroll
        for (int ai = 0; ai < 2; ++ai)
#pragma unroll
            for (int m = 0; m < 4; ++m) { bf16_t* rowp = O + (size_t)(row0 + ai * HALF + m * 16) * ldc + col0 + HALF;
                const f32x4 v0 = acc[ai][1][m][0], v1 = acc[ai][1][m][1];
                u32x4 w; w.x = cvt_pk_bf16(v0[0], v0[1]); w.y = cvt_pk_bf16(v0[2], v0[3]); w.z = cvt_pk_bf16(v1[0], v1[1]); w.w = cvt_pk_bf16(v1[2], v1[3]); *(u32x4*)rowp = w; }
        asm volatile("s_waitcnt lgkmcnt(0)" ::: "memory"); __builtin_amdgcn_s_barrier(); asm volatile("" ::: "memory");
#pragma unroll
        for (int ai = 0; ai < 2; ++ai)
#pragma unroll
            for (int m = 0; m < 4; ++m) { bf16_t* rowp = O + (size_t)(row0 + ai * HALF + m * 16) * ldc + col0;
                const f32x4 hp = *(const PG8_LAS f32x4*)(hs + (ai * HALF + wr * 64 + m * 16 + fr) * 4);
                const float hr = __builtin_amdgcn_rsqf(((hp[0] + hp[1]) + (hp[2] + hp[3])) * (1.f / 128.f) + 1e-6f);
                const f32x4 v0 = acc[ai][0][m][0] * hr * g0, v1 = acc[ai][0][m][1] * hr * g1;
                u32x4 w; w.x = cvt_pk_bf16(v0[0], v0[1]); w.y = cvt_pk_bf16(v0[2], v0[3]); w.z = cvt_pk_bf16(v1[0], v1[1]); w.w = cvt_pk_bf16(v1[2], v1[3]); *(u32x4*)rowp = w; }
    }
};
struct EpiBf16P {
    static constexpr bool PERM = true, AFTER_DRAIN = false, OWN_ALIGN = false;
    bf16_t* O; int ldc;
    __device__ __forceinline__ void operator()(const f32x4 (&acc)[2][2][4][2], const Unit& u, int wr, int wc, int fr, int fq) const {
        const int row0 = u.pm * BM + wr * 64 + fr, col0 = u.pn * BM + wc * 32 + 8 * fq;
#pragma unroll
        for (int ai = 0; ai < 2; ++ai)
#pragma unroll
            for (int m = 0; m < 4; ++m) { bf16_t* rowp = O + (size_t)(row0 + ai * HALF + m * 16) * ldc + col0;
#pragma unroll
                for (int bj = 0; bj < 2; ++bj) { const f32x4 v0 = acc[ai][bj][m][0], v1 = acc[ai][bj][m][1];
                    u32x4 w; w.x = cvt_pk_bf16(v0[0], v0[1]); w.y = cvt_pk_bf16(v0[2], v0[3]); w.z = cvt_pk_bf16(v1[0], v1[1]); w.w = cvt_pk_bf16(v1[2], v1[3]);
                    *(u32x4*)(rowp + bj * HALF) = w; } }
    }
};
template <class Epi, class Sched, bool ALIGN_EPI = false, bool SP2 = false>
__device__ __forceinline__ void gemm_phase(PG8_LAS unsigned char* lds, const Gemm g, const Sched& S, const Epi& E) {
    const int tid = threadIdx.x, wid = __builtin_amdgcn_readfirstlane(tid >> 6), lane = tid & 63, wr = wid >> 2, wc = wid & 3, fr = lane & 15, fq = lane >> 4;
    const int K = g.K, nt = K / BK;
    unsigned voffA[2], voffB[2];
#pragma unroll
    for (int i = 0; i < 2; ++i) { int R, C; stage_rc(tid * 16 + i * 8192, R, C); const int Rb = Epi::PERM ? ((R & ~31) + perm32(R & 31)) : R;
        voffA[i] = (unsigned)(R * g.lda + C) * 2u; voffB[i] = (unsigned)(Rb * K + C) * 2u; }
    const size_t kstep = (size_t)(BK * 2);
    const size_t hstepB = (size_t)HALF * K * 2, hstepA = (size_t)HALF * g.lda * 2;
    const size_t tstepA = 2 * hstepA, tstepB = 2 * hstepB;
    const unsigned ldsw = (unsigned)wid * 1024u;
    const int aoff = lds_byte(wr * 64 + fr, fq * 8), boff = lds_byte(wc * 32 + fr, fq * 8);
#define PG8_SA(b, h) (((b) * 2 + (h)) * HTB)
#define PG8_SB(b, h) ((4 + (b) * 2 + (h)) * HTB)
#define PG8_STAGE(bufoff, gbase, voff) do { _Pragma("unroll") for (int _i = 0; _i < 2; ++_i) \
        __builtin_amdgcn_global_load_lds((const unsigned*)((const char*)(gbase) + (voff)[_i]), (PG8_LAS unsigned*)(lds + (bufoff) + ldsw + _i * 8192), 16, 0, 0); } while (0)
#define PG8_LDA(dst, b, h) do { _Pragma("unroll") for (int m = 0; m < 4; ++m) _Pragma("unroll") for (int k = 0; k < 2; ++k) dst[m][k] = *(const PG8_LAS bf16x8*)(lds + PG8_SA(b, h) + aoff + m * 2048 + k * 1024); } while (0)
#define PG8_LDB(dst, b, h) do { _Pragma("unroll") for (int n = 0; n < 2; ++n) _Pragma("unroll") for (int k = 0; k < 2; ++k) dst[n][k] = *(const PG8_LAS bf16x8*)(lds + PG8_SB(b, h) + boff + n * 2048 + k * 1024); } while (0)
#define PG8_MMA(ai, bj, At, Bt) do { __builtin_amdgcn_s_setprio(1); _Pragma("unroll") for (int m = 0; m < 4; ++m) _Pragma("unroll") for (int n = 0; n < 2; ++n) _Pragma("unroll") for (int k = 0; k < 2; ++k) \
        acc[ai][bj][m][n] = __builtin_amdgcn_mfma_f32_16x16x32_bf16(Bt[n][k], At[m][k], acc[ai][bj][m][n], 0, 0, 0); __builtin_amdgcn_s_setprio(0); } while (0)
#define PG8_WAIT_V(n) asm volatile("s_waitcnt vmcnt(" #n ")" ::: "memory")
#define PG8_WAIT_L(n) asm volatile("s_waitcnt lgkmcnt(" #n ")" ::: "memory")
#define PG8_BAR __builtin_amdgcn_s_barrier()
#define PG8_SCHED __builtin_amdgcn_sched_barrier(0)
    Unit cur, nxt; int ui = 0;
    if (!S.next(0, cur)) return;
    f32x4 acc[2][2][4][2];
#pragma unroll
    for (int a = 0; a < 2; ++a)
#pragma unroll
        for (int b = 0; b < 2; ++b)
#pragma unroll
            for (int m = 0; m < 4; ++m)
#pragma unroll
                for (int n = 0; n < 2; ++n) acc[a][b][m][n] = (f32x4){0.f, 0.f, 0.f, 0.f};
    bf16x8 At[4][2], B0[2][2], B1[2][2];
    const char* cA = (const char*)g.A + (size_t)cur.pm * tstepA; const char* cB = (const char*)g.Bt + (size_t)cur.pn * tstepB;
    S.a_ready(cur);
    if constexpr (SP2) {
        PG8_STAGE(PG8_SB(0, 0), cB, voffB); PG8_STAGE(PG8_SB(0, 1), cB + hstepB, voffB); PG8_STAGE(PG8_SA(0, 0), cA, voffA); PG8_STAGE(PG8_SA(0, 1), cA + hstepA, voffA);
        if (wr == 1) PG8_BAR;
        PG8_WAIT_V(2); PG8_BAR;
        PG8_STAGE(PG8_SB(1, 0), cB + kstep, voffB); PG8_STAGE(PG8_SA(1, 0), cA + kstep, voffA); PG8_STAGE(PG8_SB(1, 1), cB + hstepB + kstep, voffB);
        PG8_WAIT_V(6); PG8_BAR;
    } else {
        PG8_STAGE(PG8_SB(0, 0), cB, voffB); PG8_STAGE(PG8_SA(0, 0), cA, voffA); PG8_STAGE(PG8_SB(0, 1), cB + hstepB, voffB); PG8_STAGE(PG8_SA(0, 1), cA + hstepA, voffA);
        if (wr == 1) PG8_BAR;
        PG8_WAIT_V(4); PG8_BAR;
        PG8_STAGE(PG8_SB(1, 0), cB + kstep, voffB); PG8_STAGE(PG8_SA(1, 0), cA + kstep, voffA); PG8_STAGE(PG8_SB(1, 1), cB + hstepB + kstep, voffB);
        PG8_WAIT_V(6); PG8_BAR;
    }
    for (;;) {
        const bool has_next = S.next(ui + 1, nxt);
        const char* nA = has_next ? (const char*)g.A + (size_t)nxt.pm * tstepA : cA; const char* nB = has_next ? (const char*)g.Bt + (size_t)nxt.pn * tstepB : cB;
        for (int t = 0; t < nt; t += 2) {
            const bool last = (t == nt - 2);
            const char* a1 = cA + (size_t)(t >> 1) * g.pairA + kstep;
            const char* a2 = last ? nA : cA + (size_t)((t >> 1) + 1) * g.pairA; const char* b2 = last ? nB : cB + (size_t)(t + 2) * kstep;
            const char* a3 = a2 + kstep; const char* b3 = b2 + kstep;
            if (last && has_next) S.a_ready(nxt);
            if constexpr (SP2) {
            PG8_LDB(B0, 0, 0); PG8_LDB(B1, 0, 1); PG8_SCHED; PG8_LDA(At, 0, 0); PG8_STAGE(PG8_SA(1, 1), a1 + hstepA, voffA);
            PG8_WAIT_V(8); PG8_WAIT_L(0); PG8_BAR; PG8_MMA(0, 0, At, B0); PG8_MMA(0, 1, At, B1); PG8_BAR; PG8_SCHED;
            PG8_LDA(At, 0, 1); PG8_STAGE(PG8_SB(0, 0), b2, voffB); PG8_STAGE(PG8_SB(0, 1), b2 + hstepB, voffB); PG8_STAGE(PG8_SA(0, 0), a2, voffA);
            PG8_WAIT_V(8); PG8_WAIT_L(0); PG8_BAR; PG8_MMA(1, 0, At, B0); PG8_MMA(1, 1, At, B1); PG8_BAR; PG8_SCHED;
            PG8_LDB(B0, 1, 0); PG8_LDB(B1, 1, 1); PG8_SCHED; PG8_LDA(At, 1, 0); PG8_STAGE(PG8_SA(0, 1), a2 + hstepA, voffA);
            PG8_WAIT_V(8); PG8_WAIT_L(0); PG8_BAR; PG8_MMA(0, 0, At, B0); PG8_MMA(0, 1, At, B1); PG8_BAR; PG8_SCHED;
            PG8_LDA(At, 1, 1); PG8_STAGE(PG8_SB(1, 0), b3, voffB); PG8_STAGE(PG8_SB(1, 1), b3 + hstepB, voffB); PG8_STAGE(PG8_SA(1, 0), a3, voffA);
            PG8_WAIT_V(8); PG8_WAIT_L(0); PG8_BAR; PG8_MMA(1, 0, At, B0); PG8_MMA(1, 1, At, B1); PG8_BAR; PG8_SCHED;
            } else {
            PG8_LDB(B0, 0, 0); PG8_SCHED; PG8_LDA(At, 0, 0); PG8_STAGE(PG8_SA(1, 1), a1 + hstepA, voffA);
            PG8_WAIT_L(8); PG8_BAR; PG8_WAIT_L(0); PG8_MMA(0, 0, At, B0); PG8_BAR; PG8_SCHED;
            PG8_LDB(B1, 0, 1); PG8_STAGE(PG8_SB(0, 0), b2, voffB);
            PG8_BAR; PG8_WAIT_L(0); PG8_MMA(0, 1, At, B1); PG8_BAR;
            PG8_LDA(At, 0, 1); PG8_STAGE(PG8_SA(0, 0), a2, voffA);
            PG8_BAR; PG8_WAIT_L(0); PG8_MMA(1, 0, At, B0); PG8_BAR; PG8_SCHED;
            PG8_STAGE(PG8_SB(0, 1), b2 + hstepB, voffB);
            PG8_WAIT_V(6); PG8_BAR; PG8_MMA(1, 1, At, B1); PG8_BAR;
            PG8_LDB(B0, 1, 0); PG8_SCHED; PG8_LDA(At, 1, 0); PG8_STAGE(PG8_SA(0, 1), a2 + hstepA, voffA);
            PG8_WAIT_L(8); PG8_BAR; PG8_WAIT_L(0); PG8_MMA(0, 0, At, B0); PG8_BAR; PG8_SCHED;
            PG8_LDB(B1, 1, 1); PG8_STAGE(PG8_SB(1, 0), b3, voffB);
            PG8_BAR; PG8_WAIT_L(0); PG8_MMA(0, 1, At, B1); PG8_BAR;
            PG8_LDA(At, 1, 1); PG8_STAGE(PG8_SA(1, 0), a3, voffA);
            PG8_BAR; PG8_WAIT_L(0); PG8_MMA(1, 0, At, B0); PG8_BAR; PG8_SCHED;
            PG8_STAGE(PG8_SB(1, 1), b3 + hstepB, voffB);
            PG8_WAIT_V(6); PG8_BAR; PG8_MMA(1, 1, At, B1); PG8_BAR;
            }
        }
        if constexpr (ALIGN_EPI && !Epi::OWN_ALIGN) { if (wr == 0) PG8_BAR; }
        if constexpr (!Epi::AFTER_DRAIN) { E(acc, cur, wr, wc, fr, fq); S.done(cur); }
        if (!has_next) break;
#pragma unroll
        for (int a = 0; a < 2; ++a)
#pragma unroll
            for (int b = 0; b < 2; ++b)
#pragma unroll
                for (int m = 0; m < 4; ++m)
#pragma unroll
                    for (int n = 0; n < 2; ++n) acc[a][b][m][n] = (f32x4){0.f, 0.f, 0.f, 0.f};
        cur = nxt; cA = nA; cB = nB; ++ui;
        if constexpr (ALIGN_EPI) { if (wr == 1) PG8_BAR; }
    }
    PG8_WAIT_V(0);
    if constexpr (!ALIGN_EPI) { if (wr == 0) PG8_BAR; }
    PG8_BAR;
    if constexpr (Epi::AFTER_DRAIN) { E.fused(acc, cur, wr, wc, fr, fq, lds, wid, lane); S.done(cur); }
#undef PG8_SA
#undef PG8_SB
#undef PG8_STAGE
#undef PG8_LDA
#undef PG8_LDB
#undef PG8_MMA
#undef PG8_WAIT_V
#undef PG8_WAIT_L
#undef PG8_BAR
#undef PG8_SCHED
}
}

namespace attn {
using bf16x8 = __attribute__((ext_vector_type(8))) short;
using s16x4  = __attribute__((ext_vector_type(4))) short;
using f32x16 = __attribute__((ext_vector_type(16))) float;
using u32x4  = __attribute__((ext_vector_type(4))) unsigned;
using f32x4  = __attribute__((ext_vector_type(4))) float;
constexpr int NW = 8, QBLK = 32, KVBLK = 64;
constexpr float THR = 8.f;
#define SBAR() __builtin_amdgcn_sched_barrier(0)
__device__ __forceinline__ int crow(int r, int hi) { return (r & 3) + 8 * (r >> 2) + 4 * hi; }
__device__ __forceinline__ unsigned cvtpk(float lo, float hi) { unsigned r; asm volatile("v_cvt_pk_bf16_f32 %0, %1, %2\n\ts_nop 1" : "=v"(r) : "v"(lo), "v"(hi)); return r; }
template <bool VIS> __device__ __forceinline__ unsigned cvtpk_t(float lo, float hi) { if constexpr (VIS) return ::pk2c(lo, hi); else return cvtpk(lo, hi); }

template <int DQK> struct Cfg {
    static constexpr int KROW = DQK * 2;
    static constexpr int SHM_K = KVBLK * KROW, SHM_V = KVBLK * 128 * 2;
    static constexpr int NQR = DQK == 128 ? 8 : 6;
    static constexpr int QX_WAVE = (DQK / 16 - NQR) * 1024;
    static constexpr int SHM = 2 * SHM_V + 2 * SHM_K + NW * 64 * 4 + NW * QX_WAVE;
    static constexpr float SCALE = DQK == 128 ? 0.088388347648318440f : 0.072168783648703220f;
    static constexpr float C = SCALE * 1.4426950408889634f;
};
template <int DQK> __device__ __forceinline__ int kswz(int row, int colB) { return row * (DQK * 2) + (colB ^ ((row & 7) << 4)); }

template <int DQK, bool NOMAX = false> __device__ __forceinline__ void partialSM(f32x16& p0, f32x16& p1, float& m_reg, float& mn, float& alpha, float shiftC = 0.f) {
  constexpr float C = Cfg<DQK>::C, SCALE = Cfg<DQK>::SCALE;
  if constexpr (NOMAX) {
    alpha = 1.f; mn = 0.f; const float mnC0 = -shiftC;
#pragma unroll
    for (int r = 0; r < 16; ++r) p0[r] = fmaf(p0[r], C, mnC0);
#pragma unroll
    for (int r = 0; r < 16; ++r) p1[r] = fmaf(p1[r], C, mnC0);
#pragma unroll
    for (int r = 0; r < 16; ++r) p0[r] = __builtin_amdgcn_exp2f(p0[r]);
    return;
  }
  float pmax = p0[0];
#pragma unroll
  for (int r = 1; r < 16; ++r) pmax = fmaxf(pmax, p0[r]);
#pragma unroll
  for (int r = 0; r < 16; ++r) pmax = fmaxf(pmax, p1[r]);
  { auto rr = __builtin_amdgcn_permlane32_swap(__float_as_uint(pmax), __float_as_uint(pmax), false, false);
    pmax = fmaxf(__uint_as_float(rr[0]), __uint_as_float(rr[1])); }
  if (__builtin_expect(__all(pmax - m_reg <= THR / SCALE), 1)) { mn = m_reg; alpha = 1.f; }
  else { mn = fmaxf(m_reg, pmax); alpha = __builtin_amdgcn_exp2f((m_reg - mn) * C); m_reg = mn; }
  float mnC = -mn * C;
#pragma unroll
  for (int r = 0; r < 16; ++r) p0[r] = fmaf(p0[r], C, mnC);
#pragma unroll
  for (int r = 0; r < 16; ++r) p1[r] = fmaf(p1[r], C, mnC);
#pragma unroll
  for (int r = 0; r < 16; ++r) p0[r] = __builtin_amdgcn_exp2f(p0[r]);
}
template <bool VIS> __device__ __forceinline__ void finishSM(f32x16& p0, f32x16& p1, float alpha, float& l_reg, bf16x8& pa0, bf16x8& pa1, bf16x8& pa2, bf16x8& pa3) {
#pragma unroll
  for (int r = 0; r < 16; ++r) p1[r] = __builtin_amdgcn_exp2f(p1[r]);
  float ps = 0;
#pragma unroll
  for (int r = 0; r < 16; ++r) ps += p0[r];
#pragma unroll
  for (int r = 0; r < 16; ++r) ps += p1[r];
  { auto rr = __builtin_amdgcn_permlane32_swap(__float_as_uint(ps), __float_as_uint(ps), false, false);
    ps = __uint_as_float(rr[0]) + __uint_as_float(rr[1]); }
  l_reg = l_reg * alpha + ps;
#define PK4(P, BASE, OUT) do { unsigned a0 = cvtpk_t<VIS>(P[BASE + 0], P[BASE + 1]), a1 = cvtpk_t<VIS>(P[BASE + 2], P[BASE + 3]);   \
    unsigned b0 = cvtpk_t<VIS>(P[BASE + 4], P[BASE + 5]), b1 = cvtpk_t<VIS>(P[BASE + 6], P[BASE + 7]);                              \
    auto r0 = __builtin_amdgcn_permlane32_swap(a0, b0, false, false); auto r1 = __builtin_amdgcn_permlane32_swap(a1, b1, false, false); \
    u32x4 w = {r0[0], r1[0], r0[1], r1[1]}; OUT = *reinterpret_cast<bf16x8*>(&w); } while (0)
  PK4(p0, 0, pa0); PK4(p0, 8, pa1); PK4(p1, 0, pa2); PK4(p1, 8, pa3);
#undef PK4
}
template <int DQK, int NQR> __device__ __forceinline__ void qkt(f32x16& p0, f32x16& p1, const char* Ks, const bf16x8* qr, const char* qx, int r32, int hi) {
  p0 = f32x16{}; p1 = f32x16{};
#pragma unroll
  for (int d0 = 0; d0 < DQK / 16; ++d0) { const int cb = (d0 * 16 + hi * 8) * 2;
    bf16x8 b0 = *reinterpret_cast<const bf16x8*>(Ks + kswz<DQK>(r32, cb));
    bf16x8 b1 = *reinterpret_cast<const bf16x8*>(Ks + kswz<DQK>(32 + r32, cb));
    bf16x8 q; if (d0 < NQR) q = qr[d0]; else q = *reinterpret_cast<const bf16x8*>(qx + (d0 - NQR) * 1024);
    p0 = __builtin_amdgcn_mfma_f32_32x32x16_bf16(b0, q, p0, 0, 0, 0);
    p1 = __builtin_amdgcn_mfma_f32_32x32x16_bf16(b1, q, p1, 0, 0, 0);
    if (DQK > 128 && (d0 & 3) == 3 && d0 + 1 < DQK / 16) SBAR(); }
}
__device__ __forceinline__ int v_st(int k, int c) { const int kk = (k & ~0xC) | ((k & 4) << 1) | ((k & 8) >> 1); return ((kk >> 3) * 4 + (c >> 5)) * 512 + ((kk & 7) * 32 + (c & 31)) * 2; }
__device__ __forceinline__ int v_rd_base(int lane) { return ((lane & 3) << 3) | (((lane >> 2) & 3) << 6) | (((lane >> 4) & 1) << 5) | (((lane >> 5) & 1) << 8); }
constexpr int v_rd_off(int d0, int ks, int half) { return d0 * 512 + ks * 4096 + half * 2048; }
template <int OFF> __device__ __forceinline__ s16x4 tr_read(int vb) {
  s16x4 r; asm volatile("ds_read_b64_tr_b16 %0, %1 offset:%2" : "=&v"(r) : "v"(vb), "i"(OFF) : "memory"); return r;
}
template <int D0> __device__ __forceinline__ void pv_one(f32x16& od, int vb, bf16x8 pa0, bf16x8 pa1, bf16x8 pa2, bf16x8 pa3) {
  const s16x4 l0 = tr_read<v_rd_off(D0, 0, 0)>(vb), h0 = tr_read<v_rd_off(D0, 0, 1)>(vb), l1 = tr_read<v_rd_off(D0, 1, 0)>(vb), h1 = tr_read<v_rd_off(D0, 1, 1)>(vb);
  const s16x4 l2 = tr_read<v_rd_off(D0, 2, 0)>(vb), h2 = tr_read<v_rd_off(D0, 2, 1)>(vb), l3 = tr_read<v_rd_off(D0, 3, 0)>(vb), h3 = tr_read<v_rd_off(D0, 3, 1)>(vb);
  asm volatile("s_waitcnt lgkmcnt(0)" ::: "memory"); SBAR();
#define PK(L, H) (bf16x8){L[0], L[1], L[2], L[3], H[0], H[1], H[2], H[3]}
  od = __builtin_amdgcn_mfma_f32_32x32x16_bf16(pa0, PK(l0, h0), od, 0, 0, 0);
  od = __builtin_amdgcn_mfma_f32_32x32x16_bf16(pa1, PK(l1, h1), od, 0, 0, 0);
  od = __builtin_amdgcn_mfma_f32_32x32x16_bf16(pa2, PK(l2, h2), od, 0, 0, 0);
  od = __builtin_amdgcn_mfma_f32_32x32x16_bf16(pa3, PK(l3, h3), od, 0, 0, 0);
#undef PK
}
__device__ __forceinline__ void pv_d0(f32x16* o, int vb, bf16x8 pa0, bf16x8 pa1, bf16x8 pa2, bf16x8 pa3) {
  pv_one<0>(o[0], vb, pa0, pa1, pa2, pa3); pv_one<1>(o[1], vb, pa0, pa1, pa2, pa3); pv_one<2>(o[2], vb, pa0, pa1, pa2, pa3); pv_one<3>(o[3], vb, pa0, pa1, pa2, pa3);
}

template <int DQK, int LDQ, int LDK, int LDKR, int LDV, int LDO, int SDEPTH, bool QNORM = false, bool NOMAX = false>
__device__ __forceinline__ void attn_dense_body(const bf16* __restrict__ Qb, const bf16* __restrict__ Kh, const bf16* __restrict__ KRh, const bf16* __restrict__ Vh,
                                                bf16* __restrict__ Ob, int seq, char* lds, const float* qgain = nullptr, const float* ropetab = nullptr, int tq0 = 0, float shiftC = 0.f) {
  constexpr int SHM_V = Cfg<DQK>::SHM_V, SHM_K = Cfg<DQK>::SHM_K; constexpr float SCALE = Cfg<DQK>::SCALE;
  constexpr bool ROPE = (DQK == 192);
  const int tid = threadIdx.x, wid = tid >> 6, lane = tid & 63, r32 = lane & 31, hi = lane >> 5;
  char* V_lds = lds; char* K_lds = lds + 2 * SHM_V;
  float* ws = (float*)(lds + 2 * SHM_V + 2 * SHM_K) + wid * 64; float* li_l = ws; float* al_l = ws + 32;
  constexpr int NQR = Cfg<DQK>::NQR;
  float m_reg = -1e30f, l_reg = 0; f32x16 o[4] = {}; bf16x8 qr[NQR];
  const bf16* Qw = Qb + (long)(wid * QBLK + r32) * LDQ + hi * 8;
  char* qx = lds + 2 * SHM_V + 2 * SHM_K + NW * 64 * 4 + wid * Cfg<DQK>::QX_WAVE + lane * 16;
  if constexpr (!QNORM) {
#pragma unroll
    for (int d0 = 0; d0 < NQR; ++d0) qr[d0] = *reinterpret_cast<const bf16x8*>(Qw + d0 * 16);
#pragma unroll
    for (int d0 = NQR; d0 < DQK / 16; ++d0) *reinterpret_cast<bf16x8*>(qx + (d0 - NQR) * 1024) = *reinterpret_cast<const bf16x8*>(Qw + d0 * 16);
  } else {
    float ss = 0.f;
#pragma unroll
    for (int d0 = 0; d0 < DQK / 16; ++d0) { const u32x4 rw = *reinterpret_cast<const u32x4*>(Qw + d0 * 16);
#pragma unroll
      for (int w = 0; w < 4; ++w) { const float a = __uint_as_float(rw[w] << 16), b = __uint_as_float(rw[w] & 0xffff0000u); ss += a * a + b * b; } }
    asm volatile("" ::: "memory");
    { auto rr = __builtin_amdgcn_permlane32_swap(__float_as_uint(ss), __float_as_uint(ss), false, false); ss = __uint_as_float(rr[0]) + __uint_as_float(rr[1]); }
    const float rsn = __builtin_amdgcn_rsqf(ss * (1.f / DQK) + 1e-6f);
    const int tpos = tq0 + wid * QBLK + r32, eri = tpos >> 6, eci = 128 + (tpos & 63);
#pragma unroll
    for (int d0 = 0; d0 < DQK / 16; ++d0) {
      const f32x4 g0 = *reinterpret_cast<const f32x4*>(qgain + d0 * 16 + hi * 8), g1 = *reinterpret_cast<const f32x4*>(qgain + d0 * 16 + hi * 8 + 4);
      const u32x4 rw = *reinterpret_cast<const u32x4*>(Qw + d0 * 16);
      float x[8];
#pragma unroll
      for (int w = 0; w < 4; ++w) { x[2 * w] = __uint_as_float(rw[w] << 16) * rsn; x[2 * w + 1] = __uint_as_float(rw[w] & 0xffff0000u) * rsn; }
      x[0] *= g0[0]; x[1] *= g0[1]; x[2] *= g0[2]; x[3] *= g0[3]; x[4] *= g1[0]; x[5] *= g1[1]; x[6] *= g1[2]; x[7] *= g1[3];
      if (d0 >= 8) {
        const float* rp = ropetab + (size_t)((d0 < 10 ? eri : eci) * 16 + ((d0 - 8) & 1) * 8 + hi * 4) * 2;
        const f32x4 c0 = *reinterpret_cast<const f32x4*>(rp), c1 = *reinterpret_cast<const f32x4*>(rp + 4);
        const float a0 = x[0] * c0[0] - x[1] * c0[1], a1 = x[0] * c0[1] + x[1] * c0[0], a2 = x[2] * c0[2] - x[3] * c0[3], a3 = x[2] * c0[3] + x[3] * c0[2];
        const float a4 = x[4] * c1[0] - x[5] * c1[1], a5 = x[4] * c1[1] + x[5] * c1[0], a6 = x[6] * c1[2] - x[7] * c1[3], a7 = x[6] * c1[3] + x[7] * c1[2];
        x[0] = a0; x[1] = a1; x[2] = a2; x[3] = a3; x[4] = a4; x[5] = a5; x[6] = a6; x[7] = a7;
      }
      u32x4 w4 = {cvtpk(x[0], x[1]), cvtpk(x[2], x[3]), cvtpk(x[4], x[5]), cvtpk(x[6], x[7])};
      if (d0 < NQR) qr[d0 < NQR ? d0 : 0] = *reinterpret_cast<bf16x8*>(&w4); else *reinterpret_cast<bf16x8*>(qx + (d0 - NQR) * 1024) = *reinterpret_cast<bf16x8*>(&w4);
    }
  }
  const int sr = tid >> 4, sc = (tid & 15) * 8, vst0 = v_st(sr, sc), vst1 = v_st(32 + sr, sc);
  const int rr = tid >> 3, rc = (tid & 7) * 8;
  const int vb0 = (int)(uintptr_t)V_lds + v_rd_base(lane);
  struct { bf16x8 vs0, vs1, ks0, ks1, kr; } sr_[SDEPTH];
  const unsigned offV = (unsigned)(sr * LDV + sc) * 2u, offK = (unsigned)(sr * LDK + sc) * 2u, offR = (unsigned)(rr * LDKR + rc) * 2u;
#define SLOAD(i, k0) do { const char* vb_ = (const char*)Vh + (size_t)(k0) * (LDV * 2); const char* kb_ = (const char*)Kh + (size_t)(k0) * (LDK * 2); \
    sr_[i].vs0 = *reinterpret_cast<const bf16x8*>(vb_ + offV); sr_[i].vs1 = *reinterpret_cast<const bf16x8*>(vb_ + (size_t)32 * LDV * 2 + offV); \
    sr_[i].ks0 = *reinterpret_cast<const bf16x8*>(kb_ + offK); sr_[i].ks1 = *reinterpret_cast<const bf16x8*>(kb_ + (size_t)32 * LDK * 2 + offK); \
    if constexpr (ROPE) sr_[i].kr = *reinterpret_cast<const bf16x8*>((const char*)KRh + (size_t)(k0) * (LDKR * 2) + offR); } while (0)
#define SWRITE(b, i) do { *(bf16x8*)(V_lds + (b) * SHM_V + vst0) = sr_[i].vs0;          \
    *(bf16x8*)(V_lds + (b) * SHM_V + vst1) = sr_[i].vs1; const int kc = sc * 2;               \
    *(bf16x8*)(K_lds + (b) * SHM_K + kswz<DQK>(sr, kc)) = sr_[i].ks0;                       \
    *(bf16x8*)(K_lds + (b) * SHM_K + kswz<DQK>(32 + sr, kc)) = sr_[i].ks1;                   \
    if constexpr (ROPE) *(bf16x8*)(K_lds + (b) * SHM_K + kswz<DQK>(rr, 256 + rc * 2)) = sr_[i].kr; } while (0)
#define SWAIT() do { if constexpr (SDEPTH == 2) { if constexpr (ROPE) asm volatile("s_waitcnt vmcnt(5)" ::: "memory"); else asm volatile("s_waitcnt vmcnt(4)" ::: "memory"); } else asm volatile("s_waitcnt vmcnt(0)" ::: "memory"); } while (0)
#define RESC(a) do { if constexpr (!NOMAX) if (__any((a) < 1.f)) { if (hi == 0) al_l[r32] = (a); asm volatile("s_waitcnt lgkmcnt(0)" ::: "memory"); \
    _Pragma("unroll") for (int d = 0; d < 4; ++d) _Pragma("unroll") for (int r = 0; r < 16; ++r) o[d][r] *= al_l[crow(r, hi)]; } } while (0)
  f32x16 pA0, pA1, pB0, pB1; float mnA, mnB, alA, alB; bf16x8 pa0, pa1, pa2, pa3; const int NT = seq / KVBLK;
  constexpr int SE = 0, SO = SDEPTH - 1;
  SLOAD(SE, 0); asm volatile("s_waitcnt vmcnt(0)" ::: "memory"); SWRITE(0, SE); __syncthreads();
  qkt<DQK, NQR>(pA0, pA1, K_lds, qr, qx, r32, hi); partialSM<DQK, NOMAX>(pA0, pA1, m_reg, mnA, alA, shiftC);
  SLOAD(SO, KVBLK); if constexpr (SDEPTH == 2) { if (2 < NT) SLOAD(SE, 2 * KVBLK); }
  SWAIT(); SWRITE(1, SO); __syncthreads();
  for (int j = 1; j + 1 < NT; j += 2) {
    SBAR(); qkt<DQK, NQR>(pB0, pB1, K_lds + SHM_K, qr, qx, r32, hi);
    finishSM<true>(pA0, pA1, alA, l_reg, pa0, pa1, pa2, pa3); SBAR();
    SLOAD(SO, (j + SDEPTH) * KVBLK); SBAR();
    pv_d0(o, vb0, pa0, pa1, pa2, pa3); partialSM<DQK, NOMAX>(pB0, pB1, m_reg, mnB, alB, shiftC);
    __syncthreads(); SWAIT(); SWRITE(0, SE);
    RESC(alB); __syncthreads();
    SBAR(); qkt<DQK, NQR>(pA0, pA1, K_lds, qr, qx, r32, hi);
    finishSM<true>(pB0, pB1, alB, l_reg, pa0, pa1, pa2, pa3); SBAR();
    if (SDEPTH == 1 || j + 3 < NT) SLOAD(SE, (j + 1 + SDEPTH) * KVBLK); SBAR();
    pv_d0(o, vb0 + SHM_V, pa0, pa1, pa2, pa3); partialSM<DQK, NOMAX>(pA0, pA1, m_reg, mnA, alA, shiftC);
    __syncthreads(); SWAIT(); SWRITE(1, SO);
    RESC(alA); __syncthreads();
  }
  SBAR(); qkt<DQK, NQR>(pB0, pB1, K_lds + SHM_K, qr, qx, r32, hi);
  finishSM<true>(pA0, pA1, alA, l_reg, pa0, pa1, pa2, pa3); SBAR();
  pv_d0(o, vb0, pa0, pa1, pa2, pa3); partialSM<DQK, NOMAX>(pB0, pB1, m_reg, mnB, alB, shiftC);
  __syncthreads(); RESC(alB);
  finishSM<true>(pB0, pB1, alB, l_reg, pa0, pa1, pa2, pa3); SBAR();
  pv_d0(o, vb0 + SHM_V, pa0, pa1, pa2, pa3);
  if (hi == 0) li_l[r32] = l_reg; asm volatile("s_waitcnt lgkmcnt(0)" ::: "memory");
  float rli[16];
#pragma unroll
  for (int r = 0; r < 16; ++r) rli[r] = __builtin_amdgcn_rcpf(li_l[crow(r, hi)]);
  bf16* Ow = Ob + (long)(wid * QBLK) * LDO;
#pragma unroll
  for (int r = 0; r < 16; ++r) { const int orow = crow(r, hi);
#pragma unroll
    for (int d0 = 0; d0 < 4; ++d0) Ow[(long)orow * LDO + d0 * 32 + r32] = (bf16)(cvtpk(o[d0][r] * rli[r], 0.f) & 0xffffu); }
  __syncthreads();
#undef SLOAD
#undef SWRITE
#undef SWAIT
#undef RESC
}
}
#define XB_TMO      128
#define XB_XCNT(j)  (256  + 64 * (j))
#define XB_XSUB(j)  (1280 + 64 * (j))
#define XB_XGEN(j)  (2304 + 64 * (j))
#define XB_TOP      3328
#define XB_TOPGEN   3392
#define XCD_BAR_WORDS 3456
#define XB_SPIN_CAP (1u << 18)

__device__ __forceinline__ unsigned xb_ld(unsigned* p)              { return __hip_atomic_load(p, __ATOMIC_RELAXED, __HIP_MEMORY_SCOPE_AGENT); }
__device__ __forceinline__ unsigned xb_add(unsigned* p, unsigned v) { return __hip_atomic_fetch_add(p, v, __ATOMIC_RELAXED, __HIP_MEMORY_SCOPE_AGENT); }
__device__ __forceinline__ unsigned xb_xcc_id() { return (unsigned)__builtin_amdgcn_s_getreg((3 << 11) | 20) & 0xFu; }
#define XB_SPIN(cond, bar) do { unsigned _sp = 0; while (cond) { __builtin_amdgcn_s_sleep(1); \
    if ((++_sp & 255u) == 0u) { if (xb_ld(&(bar)[XB_TMO])) break; if (_sp > XB_SPIN_CAP) { atomicAdd(&(bar)[XB_TMO], 1u); break; } } } } while (0)

struct XcdBarrier {
    unsigned* bar; unsigned x;
    volatile LAS unsigned* st;
};

__device__ __forceinline__ XcdBarrier xcd_barrier_post(unsigned* bar, volatile LAS unsigned* st) {
    XcdBarrier b; b.bar = bar; b.x = xb_xcc_id(); b.st = st;
    if (threadIdx.x == 0) (void)xb_add(&bar[XB_XCNT(b.x)], 1u);
    return b;
}
__device__ __forceinline__ void xcd_barrier_complete(unsigned* bar, unsigned x, unsigned& nloc, unsigned& nx) {
    const unsigned G = gridDim.x * gridDim.y * gridDim.z;
    unsigned sum, cnt, mine, sp = 0u;
    for (;;) {
        sum = 0u; cnt = 0u; mine = 0u;
#pragma unroll
        for (unsigned j = 0; j < 16; ++j) { const unsigned c = xb_ld(&bar[XB_XCNT(j)]); sum += c; cnt += (c > 0u) ? 1u : 0u; mine = (j == x) ? c : mine; }
        if (sum == G) break;
        __builtin_amdgcn_s_sleep(1);
        if ((++sp & 255u) == 0u) { if (xb_ld(&bar[XB_TMO])) break; if (sp > XB_SPIN_CAP) { atomicAdd(&bar[XB_TMO], 1u); break; } }
    }
    nloc = mine > 0u ? mine : 1u; nx = cnt > 0u ? cnt : 1u;
}

__device__ __forceinline__ void xcd_barrier(const XcdBarrier& b) {
    asm volatile("s_waitcnt vmcnt(0)" ::: "memory");
    __syncthreads();
    if (threadIdx.x == 0) {
        unsigned* bar = b.bar;
        __builtin_amdgcn_s_waitcnt(0);
        unsigned nloc = b.st[0], nx = b.st[1];
        if (nloc == 0u) { xcd_barrier_complete(bar, b.x, nloc, nx); b.st[0] = nloc; b.st[1] = nx; }
        const unsigned old = xb_add(&bar[XB_XSUB(b.x)], 1u);
        const unsigned gen = old / nloc;
        if (old + 1u == (gen + 1u) * nloc) {
            __builtin_amdgcn_fence(__ATOMIC_RELEASE, "agent");
            asm volatile("s_waitcnt vmcnt(0)" ::: "memory");
            const unsigned og = xb_add(&bar[XB_TOP], 1u);
            const unsigned tg = og / nx;
            if (og + 1u == (tg + 1u) * nx) xb_add(&bar[XB_TOPGEN], 1u);
            else XB_SPIN(xb_ld(&bar[XB_TOPGEN]) == tg, bar);
            __builtin_amdgcn_fence(__ATOMIC_ACQUIRE, "agent");
            xb_add(&bar[XB_XGEN(b.x)], 1u);
            asm volatile("s_waitcnt vmcnt(0)" ::: "memory");
        } else {
            XB_SPIN(xb_ld(&bar[XB_XGEN(b.x)]) == gen, bar);
            __builtin_amdgcn_fence(__ATOMIC_ACQUIRE, "agent");
            asm volatile("s_waitcnt vmcnt(0)" ::: "memory");
        }
    }
    __syncthreads();
}

struct Args { const float* in[N_IN]; float* out; unsigned char* ws; int ph_lo, ph_hi, one_launch, pad; };
struct Frame {
    LAS unsigned char* lds;
    int tid, lane, wave, vcu, G;
    const float* const* in;
    float* out; unsigned char* ws;
    float* mod; const f32x2* ropeA; const f32x2* ropeC;
    bf16* H;
};
constexpr int NWAVES = 8;

__device__ __forceinline__ void transpose_item(const float* W, int ldw, int K, int N, bf16* WT, int row_off, float scale, LAS float* scr, int item, int lane) {
    const int nblk = N / 32, kb = item / nblk, nb = item % nblk, k0 = 64 * kb, n0 = 32 * nb;
#pragma unroll 8
    for (int i = 0; i < 32; ++i) { const int kk = 2 * i + (lane >> 5); scr[kk * 33 + (lane & 31)] = W[(size_t)(k0 + kk) * ldw + n0 + (lane & 31)] * scale; }
    LDS_WAIT(); asm volatile("" ::: "memory");
    const int c = lane & 7;
#pragma unroll
    for (int j = 0; j < 4; ++j) { const int n = (lane >> 3) + 8 * j; const LAS float* s = scr + (8 * c) * 33 + n;
        v4u o; o.x = pk2(s[0 * 33], s[1 * 33]); o.y = pk2(s[2 * 33], s[3 * 33]); o.z = pk2(s[4 * 33], s[5 * 33]); o.w = pk2(s[6 * 33], s[7 * 33]);
        *(GAS v4u*)(WT + (size_t)(row_off + n0 + n) * K + k0 + 8 * c) = o; }
    LDS_WAIT(); asm volatile("" ::: "memory");
}
struct ItemSrc { unsigned* head; int cur, step; };
__device__ __forceinline__ void item_next(ItemSrc& S) {
    if (S.head) { unsigned v = 0; if ((threadIdx.x & 63) == 0) v = __hip_atomic_fetch_add(S.head, 1u, __ATOMIC_RELAXED, __HIP_MEMORY_SCOPE_AGENT); S.cur = (int)__builtin_amdgcn_readfirstlane(v); }
    else S.cur += S.step;
}
__device__ __forceinline__ int transpose_matrix(Frame& F, ItemSrc& S, int base, const float* W, int ldw, int K, int N, bf16* WT, int row_off, float scale) {
    LAS float* scr = (LAS float*)(F.lds + F.wave * 16384);
    const int nit = (K / 64) * (N / 32), nb = (nit + 7) / 8;
    while (S.cur < base + nb) { const int i0 = (S.cur - base) * 8, i1 = i0 + 8 < nit ? i0 + 8 : nit;
        for (int it = i0; it < i1; ++it) transpose_item(W, ldw, K, N, WT, row_off, scale, scr, it, F.lane);
        item_next(S); }
    return base + nb;
}
__device__ __forceinline__ void zero_rows(Frame& F, bf16* WT, int row0, int nrows, int K) {
    const size_t n16 = (size_t)nrows * K / 8; GAS v4u* p = (GAS v4u*)(WT + (size_t)row0 * K);
    for (size_t i = (size_t)(F.vcu * NWAVES + F.wave) * 64 + F.lane; i < n16; i += (size_t)F.G * NWAVES * 64) p[i] = (v4u){0u, 0u, 0u, 0u};
}
__device__ __forceinline__ void prep_weights(Frame& F, int layer, unsigned* head) {
    const int kind = layer % 3, j = layer / 3;
    unsigned char* wr = F.ws + ((layer & 1) ? WS_WB : WS_W);
    bf16* w1t = (bf16*)wr; bf16* w2t = (bf16*)(wr + 32 * MiB); bf16* wmix = (bf16*)(wr + 64 * MiB); bf16* wot = (bf16*)(wr + 90 * MiB);
    if (kind == 1) {
        const float* g1 = F.in[I_GLA_WG1];
        for (int i = (F.vcu * NWAVES + F.wave) * 64 + F.lane; i < 2 * 16 * D; i += F.G * NWAVES * 64) { const int k = i % D, nr = i / D, n = nr >> 4, r = nr & 15;
            wmix[(size_t)(6144 + nr) * D + k] = (bf16)f2bf(g1[((size_t)n * D + k) * 16 + r]); }
        zero_rows(F, wmix, 6176, 224, D);
    } else if (kind == 2) zero_rows(F, wmix, 832, 192, D);
    ItemSrc S; S.head = head; S.step = F.G * NWAVES; S.cur = F.vcu * NWAVES + F.wave;
    if (head) item_next(S);
    int b = 0;
    b = transpose_matrix(F, S, b, F.in[I_W1] + (size_t)layer * D * FF, FF, D, FF, w1t, 0, 1.f);
    b = transpose_matrix(F, S, b, F.in[I_W2] + (size_t)layer * FF * D, D, FF, D, w2t, 0, 1.f);
    if (kind == 0) {
        b = transpose_matrix(F, S, b, F.in[I_GQA_WQKV] + (size_t)j * D * 3072, 3072, D, 3072, wmix, 0, 1.f);
        b = transpose_matrix(F, S, b, F.in[I_GQA_WO] + (size_t)j * D * D, D, D, D, wot, 0, 1.f);
    } else if (kind == 1) {
        const float* win = F.in[I_GLA_WIN];
        b = transpose_matrix(F, S, b, win, 6144, D, 1024, wmix, 0, 0.0625f);
        b = transpose_matrix(F, S, b, win + 1024, 6144, D, 5120, wmix, 1024, 1.f);
        b = transpose_matrix(F, S, b, F.in[I_GLA_WO], D, D, D, wot, 0, 1.f);
    } else {
        b = transpose_matrix(F, S, b, F.in[I_MLA_WDOWN], 832, D, 832, wmix, 0, 1.f);
        b = transpose_matrix(F, S, b, F.in[I_MLA_WUQ], 3072, 512, 3072, wmix + (size_t)4 * MiB / 2, 0, 1.f);
        b = transpose_matrix(F, S, b, F.in[I_MLA_WUKV], 4096, 256, 4096, wmix + (size_t)8 * MiB / 2, 0, 1.f);
        b = transpose_matrix(F, S, b, F.in[I_MLA_WO], D, D, D, wot, 0, 1.f);
    }
    (void)b;
}
__device__ __forceinline__ void ada_phase(Frame& F) {
    LAS float* cond = (LAS float*)(F.lds);
    float* modp = (float*)(F.ws + WS_MODP);
    const float* cp = F.in[I_CP]; const float* cs = F.in[I_CS]; const float* aw = F.in[I_ADAW];
    for (int item = F.vcu; item < 4 * 24 * 4; item += F.G) {
        const int kq = item & 3, cg = (item >> 2) % 24, l = item / 96;
        __syncthreads();
        for (int i = F.tid; i < 512 * NSEQ; i += 512) { const int k = i / NSEQ, s = i % NSEQ; const float c = s < 16 ? cp[s * D + kq * 512 + k] : cs[(s - 16) * D + kq * 512 + k];
            cond[i] = c / (1.f + __expf(-c)); }
        __syncthreads();
        const int col = cg * 512 + F.wave * 64 + F.lane;
        const float* wp = aw + ((size_t)l * D + kq * 512) * 12288 + col;
        float acc[NSEQ];
#pragma unroll
        for (int s = 0; s < NSEQ; ++s) acc[s] = 0.f;
        for (int k0 = 0; k0 < 512; k0 += 8) {
            float wv[8];
#pragma unroll
            for (int u = 0; u < 8; ++u) wv[u] = wp[(size_t)(k0 + u) * 12288];
#pragma unroll
            for (int u = 0; u < 8; ++u) { const LAS f32x4* cr = (const LAS f32x4*)(cond + (k0 + u) * NSEQ);
#pragma unroll
                for (int q = 0; q < 5; ++q) { const f32x4 cv = cr[q]; acc[4 * q] += cv.x * wv[u]; acc[4 * q + 1] += cv.y * wv[u]; acc[4 * q + 2] += cv.z * wv[u]; acc[4 * q + 3] += cv.w * wv[u]; } }
        }
#pragma unroll
        for (int s = 0; s < NSEQ; ++s) modp[(((size_t)kq * DEPTH + l) * NSEQ + s) * 12288 + col] = acc[s];
    }
    __syncthreads();
}
__device__ __forceinline__ void rope_tables(Frame& F) {
    f32x2* ra = (f32x2*)(F.ws + WS_ROPE); f32x2* rc = ra + 192 * 32;
    for (int i = (F.vcu * NWAVES + F.wave) * 64 + F.lane; i < 192 * 48; i += F.G * NWAVES * 64) {
        const int e = i / 48, f = i % 48; const double idx = (double)(e < 128 ? e : e - 128);
        const double inv = f < 32 ? pow(10000.0, -(double)f / 32.0) : pow(10000.0, -(double)(f - 32) / 16.0);
        const double a = idx * inv; const f32x2 v = {(float)cos(a), (float)sin(a)};
        if (f < 32) ra[e * 32 + f] = v; else rc[e * 16 + (f - 32)] = v;
    }
}
__device__ __forceinline__ void mod_finalize(Frame& F) {
    const float* modp = (const float*)(F.ws + WS_MODP); const float* ab = F.in[I_ADAB];
    constexpr int NTOT = DEPTH * NSEQ * 12288, Q = NTOT;
    for (int i = (F.vcu * NWAVES + F.wave) * 64 + F.lane; i < NTOT; i += F.G * NWAVES * 64) { const int l = i / (NSEQ * 12288), n = i % 12288;
        float v = ab[l * 12288 + n] + ((modp[i] + modp[i + Q]) + (modp[i + 2 * Q] + modp[i + 3 * Q]));
        const int slot = n >> 11; if (slot == 1) v = F.in[I_N1G][l * D + (n & 2047)] * (1.0f + v); else if (slot == 4) v = F.in[I_N2G][l * D + (n & 2047)] * (1.0f + v);
        F.mod[i] = v; }
}
__device__ __forceinline__ void norm0_phase(Frame& F) {
    const int gw = F.vcu * NWAVES + F.wave, NGW = F.G * NWAVES;
    float* ssq = (float*)(F.ws + WS_SSQB);
    for (int item = gw; item < M / 32; item += NGW) {
        const int row0 = item * 32, seq = seq_of_row(row0);
        const float* mp = F.mod + (size_t)seq * 12288;
        f32x4 A[8];
#pragma unroll
        for (int j = 0; j < 8; ++j) { const int c = j * 256 + F.lane * 4; A[j] = *(const f32x4*)(mp + D + c); }
        const float* xb = row0 < MP ? F.in[I_XP] + (size_t)row0 * D : F.in[I_XS] + (size_t)(row0 - MP) * D;
        bf16* hb = F.H + (size_t)row0 * D;
        for (int r = 0; r < 32; r += 2) {
            f32x4 v0[8], v1[8]; float s0 = 0.f, s1 = 0.f;
#pragma unroll
            for (int j = 0; j < 8; ++j) { v0[j] = *(const GAS f32x4*)(xb + (size_t)r * D + j * 256 + F.lane * 4); v1[j] = *(const GAS f32x4*)(xb + (size_t)(r + 1) * D + j * 256 + F.lane * 4); }
#pragma unroll
            for (int j = 0; j < 8; ++j) { s0 += (v0[j].x * v0[j].x + v0[j].y * v0[j].y) + (v0[j].z * v0[j].z + v0[j].w * v0[j].w); s1 += (v1[j].x * v1[j].x + v1[j].y * v1[j].y) + (v1[j].z * v1[j].z + v1[j].w * v1[j].w); }
            s0 = wave_sum(s0); s1 = wave_sum(s1);
            if (F.lane < 16) { const int rr = row0 + r + (F.lane >> 3), sl = F.lane & 7; ssq[(size_t)rr * 8 + sl] = sl == 0 ? ((F.lane >> 3) ? s1 : s0) : 0.f; }
#pragma unroll
            for (int j = 0; j < 8; ++j) { const f32x4 a = v0[j] * A[j], b = v1[j] * A[j];
                *(GAS v2u*)(hb + (size_t)r * D + j * 256 + F.lane * 4) = (v2u){pk2(a.x, a.y), pk2(a.z, a.w)};
                *(GAS v2u*)(hb + (size_t)(r + 1) * D + j * 256 + F.lane * 4) = (v2u){pk2(b.x, b.y), pk2(b.z, b.w)}; }
        }
    }
}
__device__ __forceinline__ void gemv20_item(Frame& F, const float* shift  , const float* W, int ldw, int ncols, float scale, float* out, int ldo, int c0) {
    LAS float* cond = (LAS float*)(F.lds);
    LAS float* red = (LAS float*)(F.lds + 98304);
    const int c = c0 + F.lane; const bool ok = c < ncols;
    for (int pass = 0; pass < 2; ++pass) {
        __syncthreads();
        for (int i = F.tid; i < 2048 * 10; i += 512) { const int k = i / 10, s = i % 10; cond[k * 12 + s] = shift[(size_t)(pass * 10 + s) * 12288 + k]; }
        __syncthreads();
        float acc[10];
#pragma unroll
        for (int s = 0; s < 10; ++s) acc[s] = 0.f;
        const float* wp = W + (size_t)(F.wave * 256) * ldw + (ok ? c : 0);
        const LAS float* cb = cond + F.wave * 256 * 12;
        for (int k0 = 0; k0 < 256; k0 += 16) {
            float wv[16];
#pragma unroll
            for (int u = 0; u < 16; ++u) { wv[u] = *wp; wp += ldw; }
#pragma unroll
            for (int u = 0; u < 16; ++u) { const LAS f32x4* cr = (const LAS f32x4*)(cb + (k0 + u) * 12); const f32x4 c0v = cr[0], c1v = cr[1], c2v = cr[2];
                acc[0] += c0v.x * wv[u]; acc[1] += c0v.y * wv[u]; acc[2] += c0v.z * wv[u]; acc[3] += c0v.w * wv[u]; acc[4] += c1v.x * wv[u]; acc[5] += c1v.y * wv[u];
                acc[6] += c1v.z * wv[u]; acc[7] += c1v.w * wv[u]; acc[8] += c2v.x * wv[u]; acc[9] += c2v.y * wv[u]; }
        }
#pragma unroll
        for (int s = 0; s < 10; ++s) red[(F.wave * 10 + s) * 64 + F.lane] = acc[s];
        __syncthreads();
        for (int i = F.tid; i < 640; i += 512) { const int s = i >> 6, l = i & 63; float t = 0.f;
#pragma unroll
            for (int w = 0; w < 8; ++w) t += red[(w * 10 + s) * 64 + l];
            if (c0 + l < ncols) out[(size_t)(pass * 10 + s) * ldo + c0 + l] = t * scale; }
    }
    __syncthreads();
}
__device__ __forceinline__ void bw_phase(Frame& F, int layer) {
    const int kind = layer % 3, j = layer / 3;
    const float* sh1 = F.mod + (size_t)layer * NSEQ * 12288; const float* sh2 = sh1 + 3 * D;
    float* bw1 = (float*)(F.ws + ((layer & 1) ? WS_BW1B : WS_BW1)); float* bw2 = (float*)(F.ws + ((layer & 1) ? WS_BW2B : WS_BW2));
    const int n1 = kind == 0 ? 48 : (kind == 1 ? 98 : 13);
    for (int it = F.G - 1 - F.vcu; it < n1 + 128; it += F.G) {
        if (it >= n1) { gemv20_item(F, sh2, F.in[I_W1] + (size_t)layer * D * FF, FF, FF, 1.f, bw2, FF, (it - n1) * 64); continue; }
        if (kind == 0) gemv20_item(F, sh1, F.in[I_GQA_WQKV] + (size_t)j * D * 3072, 3072, 3072, 1.f, bw1, 6400, it * 64);
        else if (kind == 1) {
            if (it < 16) gemv20_item(F, sh1, F.in[I_GLA_WIN], 6144, 1024, 0.0625f, bw1, 6400, it * 64);
            else if (it < 96) gemv20_item(F, sh1, F.in[I_GLA_WIN], 6144, 6144, 1.f, bw1, 6400, it * 64);
            else gemv20_item(F, sh1, F.in[I_GLA_WG1] + (size_t)(it - 96) * D * 16, 16, 16, 1.f, bw1 + 6144 + (it - 96) * 16, 6400, 0);
        } else gemv20_item(F, sh1, F.in[I_MLA_WDOWN], 832, 832, 1.f, bw1, 6400, it * 64);
    }
}
__device__ __forceinline__ void rot(float& y0, float& y1, f32x2 cs) { const float a = y0 * cs.x - y1 * cs.y, b = y0 * cs.y + y1 * cs.x; y0 = a; y1 = b; }
__device__ __forceinline__ void unpack8(v4u w, float* x) { x[0] = bflo(w.x); x[1] = bfhi(w.x); x[2] = bflo(w.y); x[3] = bfhi(w.y); x[4] = bflo(w.z); x[5] = bfhi(w.z); x[6] = bflo(w.w); x[7] = bfhi(w.w); }
__device__ __forceinline__ void mla_down_norm_phase(Frame& F) {
    bf16* DN = (bf16*)(F.ws + WS_DOWN); const float* qa = F.in[I_MLA_QAN]; const float* kva = F.in[I_MLA_KVAN]; const float* krn = F.in[I_MLA_KRN];
    const int gw = F.vcu * NWAVES + F.wave, NGW = F.G * NWAVES, lane = F.lane;
    float g0[8], g1[8], g2[8];
#pragma unroll
    for (int e = 0; e < 8; ++e) { g0[e] = qa[lane * 8 + e]; g1[e] = kva[(lane & 31) * 8 + e]; g2[e] = krn[(lane & 7) * 8 + e]; }
    for (int row = gw; row < M; row += NGW) {
        const int t = pos_of_row(row), ri = t >> 6, ci = 128 + (t & 63);
        bf16* rp = DN + (size_t)row * 1024;
        const v4u w0 = *(const GAS v4u*)(rp + lane * 8), w1 = *(const GAS v4u*)(rp + 512 + (lane & 31) * 8), w2 = *(const GAS v4u*)(rp + 768 + (lane & 7) * 8);
        float x[8], ss;
        unpack8(w0, x); ss = 0.f;
#pragma unroll
        for (int e = 0; e < 8; ++e) ss += x[e] * x[e];
        ss = wave_sum(ss); { const float rs = 1.0f / sqrtf(ss * (1.f / 512.f) + NORM_EPS);
#pragma unroll
            for (int e = 0; e < 8; ++e) x[e] = x[e] * rs * g0[e]; }
        *(GAS v4u*)(rp + lane * 8) = (v4u){pk2(x[0], x[1]), pk2(x[2], x[3]), pk2(x[4], x[5]), pk2(x[6], x[7])};
        unpack8(w1, x); ss = 0.f;
#pragma unroll
        for (int e = 0; e < 8; ++e) ss += x[e] * x[e];
        ss += __shfl_xor(ss, 1); ss += __shfl_xor(ss, 2); ss += __shfl_xor(ss, 4); ss += __shfl_xor(ss, 8); ss += __shfl_xor(ss, 16);
        { const float rs = 1.0f / sqrtf(ss * (1.f / 256.f) + NORM_EPS);
#pragma unroll
            for (int e = 0; e < 8; ++e) x[e] = x[e] * rs * g1[e]; }
        if (lane < 32) *(GAS v4u*)(rp + 512 + lane * 8) = (v4u){pk2(x[0], x[1]), pk2(x[2], x[3]), pk2(x[4], x[5]), pk2(x[6], x[7])};
        unpack8(w2, x); ss = 0.f;
#pragma unroll
        for (int e = 0; e < 8; ++e) ss += x[e] * x[e];
        ss += __shfl_xor(ss, 1); ss += __shfl_xor(ss, 2); ss += __shfl_xor(ss, 4);
        { const float rs = 1.0f / sqrtf(ss * (1.f / 64.f) + NORM_EPS);
#pragma unroll
            for (int e = 0; e < 8; ++e) x[e] = x[e] * rs * g2[e]; }
#pragma unroll
        for (int p = 0; p < 4; ++p) { const int i = (lane & 7) * 4 + p; rot(x[2 * p], x[2 * p + 1], F.ropeC[(i < 16 ? ri : ci) * 16 + (i & 15)]); }
        if (lane < 8) *(GAS v4u*)(rp + 768 + lane * 8) = (v4u){pk2(x[0], x[1]), pk2(x[2], x[3]), pk2(x[4], x[5]), pk2(x[6], x[7])};
    }
}
__device__ __forceinline__ void mla_knope_norm_phase(Frame& F) {
    bf16* KV = (bf16*)(F.ws + WS_KV); const float* knn = F.in[I_MLA_KNN];
    const int gw = F.vcu * NWAVES + F.wave, NGW = F.G * NWAVES, lane = F.lane, sub = lane & 15, hh = lane >> 4;
    float gk[8];
#pragma unroll
    for (int e = 0; e < 8; ++e) gk[e] = knn[sub * 8 + e];
    for (int row = gw; row < M; row += NGW) {
        v4u w[4];
#pragma unroll
        for (int ps = 0; ps < 4; ++ps) w[ps] = *(const GAS v4u*)(KV + (size_t)row * 4096 + (ps * 4 + hh) * 256 + sub * 8);
#pragma unroll
        for (int ps = 0; ps < 4; ++ps) {
            float x[8]; unpack8(w[ps], x); float ss = 0.f;
#pragma unroll
            for (int e = 0; e < 8; ++e) ss += x[e] * x[e];
            ss += __shfl_xor(ss, 1); ss += __shfl_xor(ss, 2); ss += __shfl_xor(ss, 4); ss += __shfl_xor(ss, 8);
            const float rs = 1.0f / sqrtf(ss * (1.f / 128.f) + NORM_EPS);
#pragma unroll
            for (int e = 0; e < 8; ++e) x[e] = x[e] * rs * gk[e];
            *(GAS v4u*)(KV + (size_t)row * 4096 + (ps * 4 + hh) * 256 + sub * 8) = (v4u){pk2(x[0], x[1]), pk2(x[2], x[3]), pk2(x[4], x[5]), pk2(x[6], x[7])};
        }
    }
}
__device__ __forceinline__ void gla_post_phase(Frame& F) {
    bf16* OB = (bf16*)(F.ws + WS_OB); const bf16* PROJ = (const bf16*)(F.ws + WS_PROJ); const float* on = F.in[I_GLA_ON];
    const int gw = F.vcu * NWAVES + F.wave, NGW = F.G * NWAVES, lane = F.lane;
    float g[8];
#pragma unroll
    for (int e = 0; e < 8; ++e) g[e] = on[lane * 8 + e];
    for (int row = gw; row < M; row += NGW) {
        v4u wf[4], wb[4], wr[4];
#pragma unroll
        for (int h = 0; h < 4; ++h) { wf[h] = *(const GAS v4u*)(F.H + (size_t)row * D + h * 512 + lane * 8); wb[h] = *(const GAS v4u*)(OB + (size_t)row * D + h * 512 + lane * 8);
            wr[h] = *(const GAS v4u*)(PROJ + (size_t)row * 6400 + 4096 + h * 512 + lane * 8); }
#pragma unroll
        for (int h = 0; h < 4; ++h) {
            float a[8], b[8], r[8]; unpack8(wf[h], a); unpack8(wb[h], b); unpack8(wr[h], r); float ss = 0.f;
#pragma unroll
            for (int e = 0; e < 8; ++e) { a[e] += b[e]; ss += a[e] * a[e]; }
            ss = wave_sum(ss); const float rs = 1.0f / sqrtf(ss * (1.f / 512.f) + NORM_EPS);
#pragma unroll
            for (int e = 0; e < 8; ++e) a[e] = a[e] * rs * g[e] * (r[e] / (1.f + __expf(-r[e])));
            *(GAS v4u*)(OB + (size_t)row * D + h * 512 + lane * 8) = (v4u){pk2(a[0], a[1]), pk2(a[2], a[3]), pk2(a[4], a[5]), pk2(a[6], a[7])};
        }
    }
}

namespace gla {
typedef float f32x4 __attribute__((ext_vector_type(4)));
typedef short bf16x8 __attribute__((ext_vector_type(8)));
constexpr int CL = 32;
constexpr int QD_ROW = 528, KET_ROW = 80, V_ROW = 272, P_ROW = 80;
constexpr int OFF_QD = 0, OFF_KD = OFF_QD + CL * QD_ROW, OFF_KET = OFF_KD + CL * QD_ROW, OFF_V = OFF_KET + 256 * KET_ROW, OFF_DE = OFF_V + CL * V_ROW, BUF_BYTES = OFF_DE + 1024;
constexpr int OFF_LOW = 2 * BUF_BYTES, OFF_PW = OFF_LOW + 2 * CL * 64, OFF_END = OFF_PW + 4 * CL * P_ROW;
static_assert(OFF_END <= LDSCTL_OFF, "gla LDS map");
__device__ __forceinline__ float log_sigmoid(float z) { return fminf(z, 0.f) - __logf(1.f + __expf(-fabsf(z))); }
__device__ __forceinline__ void rd_p(bf16x8 (&fa)[2][2], bf16x8 (&fb)[2][2], int aq, int ak) {
#pragma unroll
    for (int mi = 0; mi < 2; ++mi)
#pragma unroll
        for (int kk = 0; kk < 2; ++kk) { fa[mi][kk] = *(const LAS bf16x8*)(uintptr_t)(unsigned)(aq + mi * 8448 + kk * 64); fb[mi][kk] = *(const LAS bf16x8*)(uintptr_t)(unsigned)(ak + mi * 8448 + kk * 64); }
}
__device__ __forceinline__ void rd_v(unsigned (&vu)[8], int av) {
#pragma unroll
    for (int q = 0; q < 8; ++q) vu[q] = *(const LAS unsigned short*)(uintptr_t)(unsigned)(av + q * 272);
}
__device__ __forceinline__ void rd_pw(bf16x8 (&fp)[2], int ap) { fp[0] = *(const LAS bf16x8*)(uintptr_t)(unsigned)ap; fp[1] = *(const LAS bf16x8*)(uintptr_t)(unsigned)(ap + 1280); }
__device__ __forceinline__ void rd_q(v2u (&q0)[2][2], v2u (&q1)[2][2], int aq) {
#pragma unroll
    for (int mi = 0; mi < 2; ++mi)
#pragma unroll
        for (int kk = 0; kk < 2; ++kk) { q0[mi][kk] = *(const LAS v2u*)(uintptr_t)(unsigned)(aq + mi * 8448 + kk * 64); q1[mi][kk] = *(const LAS v2u*)(uintptr_t)(unsigned)(aq + mi * 8448 + kk * 64 + 32); }
}
__device__ __forceinline__ void rd_s(bf16x8 (&fk)[4], f32x4 (&fd)[4], int ak, int ad) {
#pragma unroll
    for (int t = 0; t < 4; ++t) { fk[t] = *(const LAS bf16x8*)(uintptr_t)(unsigned)(ak + t * 1280); fd[t] = *(const LAS f32x4*)(uintptr_t)(unsigned)(ad + t * 64); }
}
static_assert(16 * QD_ROW == 8448 && V_ROW == 272 && 16 * P_ROW == 1280 && 16 * KET_ROW == 1280, "asm offsets");
#define GLA_BAR() do { asm volatile("s_waitcnt lgkmcnt(0)" ::: "memory"); __builtin_amdgcn_s_barrier(); asm volatile("" ::: "memory"); } while (0)

__device__ __forceinline__ void chain(LAS unsigned char* lds, const bf16* PROJ, bf16* OF, bf16* OB, const float* wg2, const float* bgv, int c) {
    const int tid = threadIdx.x, wave = __builtin_amdgcn_readfirstlane(tid >> 6), lane = tid & 63;
    const int sl = c & 3, dir = (c >> 2) & 1, h = (c >> 3) & 3, s = c >> 5;
    int T, rowbase;
    if (c < 128) { T = 8192; rowbase = MP + s * 8192; } else { T = 2048; rowbase = (s - 4) * 2048; }
    const int nch = T / CL;
    GLA_BAR();
    if (wave < 4) {
        const int ptid = tid, l16 = lane & 15, g = lane >> 4, dbase = 64 * wave + 2 * l16;
        bf16x8 wB[4]; float bias[4];
#pragma unroll
        for (int nj = 0; nj < 4; ++nj) { const int d = dbase + 32 * (nj >> 1) + (nj & 1); float w[8];
#pragma unroll
            for (int jx = 0; jx < 8; ++jx) w[jx] = g < 2 ? wg2[((size_t)dir * 16 + 8 * g + jx) * 1024 + h * 256 + d] : 0.f;
            wB[nj] = __builtin_bit_cast(bf16x8, (v4u){pk2c(w[0], w[1]), pk2c(w[2], w[3]), pk2c(w[4], w[5]), pk2c(w[6], w[7])});
            bias[nj] = bgv[dir * 1024 + h * 256 + d]; }
        unsigned qv[2][2][4], kv[2][2][4]; v4u vv[2]; unsigned lw;
#define GLA_ROW0(J) ((size_t)rowbase + (size_t)(dir ? nch - 1 - (J) : (J)) * CL)
#define GLA_LOAD_QKV(J) do { const size_t r0_ = GLA_ROW0(J); const char* qp_ = (const char*)PROJ + (r0_ * 6400 + h * 256 + 64 * wave) * 2; const unsigned voff_ = (unsigned)(4 * g * 6400 + 2 * l16) * 2u;     \
        _Pragma("unroll") for (int pp = 0; pp < 2; ++pp) _Pragma("unroll") for (int mi = 0; mi < 2; ++mi) _Pragma("unroll") for (int r = 0; r < 4; ++r) { \
            qv[pp][mi][r] = *(const GAS unsigned*)(qp_ + (size_t)(16 * mi + r) * 12800 + pp * 64 + voff_); kv[pp][mi][r] = *(const GAS unsigned*)(qp_ + (size_t)(16 * mi + r) * 12800 + pp * 64 + 2048 + voff_); } \
        _Pragma("unroll") for (int jj = 0; jj < 2; ++jj) { const int idx = ptid + 256 * jj, pos = idx >> 4, e8 = (idx & 15) * 8; vv[jj] = *(const GAS v4u*)(PROJ + (r0_ + pos) * 6400 + 2048 + h * 512 + sl * 128 + e8); } } while (0)
#define GLA_LOAD_LOW(J) do { lw = *(const GAS unsigned*)(PROJ + (GLA_ROW0(J) + (ptid >> 3)) * 6400 + 6144 + dir * 16 + (ptid & 7) * 2); } while (0)
#define GLA_PUT_LOW(J) do { *(LAS unsigned*)(lds + OFF_LOW + ((J) & 1) * (CL * 64) + (ptid >> 3) * 64 + (ptid & 7) * 4) = lw; } while (0)
        { const int b_ = ptid >> 7, pos_ = (ptid >> 2) & 31, part_ = ptid & 3; *(LAS v2u*)(lds + OFF_LOW + b_ * (CL * 64) + pos_ * 64 + 32 + part_ * 8) = (v2u){0u, 0u}; }
        GLA_LOAD_LOW(0); GLA_PUT_LOW(0);
        if (nch > 1) GLA_LOAD_LOW(1);
        GLA_LOAD_QKV(0);
        GLA_BAR();
        for (int j = 0; j < nch; ++j) {
            LAS unsigned char* B = lds + (j & 1) * BUF_BYTES;
            if (j + 1 < nch) GLA_PUT_LOW(j + 1);
            f32x4 z[2][4];
            { bf16x8 fA[2];
#pragma unroll
              for (int mi = 0; mi < 2; ++mi) fA[mi] = *(const LAS bf16x8*)(lds + OFF_LOW + (j & 1) * (CL * 64) + (16 * mi + l16) * 64 + g * 16);
#pragma unroll
              for (int mi = 0; mi < 2; ++mi)
#pragma unroll
                  for (int nj = 0; nj < 4; ++nj) z[mi][nj] = __builtin_amdgcn_mfma_f32_16x16x32_bf16(fA[mi], wB[nj], (f32x4){bias[nj], bias[nj], bias[nj], bias[nj]}, 0, 0, 0); }
            float tot[4];
#pragma unroll
            for (int nj = 0; nj < 4; ++nj) {
                float s[2];
#pragma unroll
                for (int mi = 0; mi < 2; ++mi) {
#pragma unroll
                    for (int r = 0; r < 4; ++r) { const float zz = z[mi][nj][r]; const float t = __builtin_amdgcn_exp2f(-1.4426950408889634f * __builtin_fabsf(zz));
                        z[mi][nj][r] = __builtin_fmaf(__builtin_amdgcn_logf(1.0f + t), -0.0625f, __builtin_fminf(zz * 0.09016844005556021f, 0.f)); }
                    if (dir == 0) { z[mi][nj][1] += z[mi][nj][0]; z[mi][nj][2] += z[mi][nj][1]; z[mi][nj][3] += z[mi][nj][2]; s[mi] = z[mi][nj][3]; }
                    else          { z[mi][nj][2] += z[mi][nj][3]; z[mi][nj][1] += z[mi][nj][2]; z[mi][nj][0] += z[mi][nj][1]; s[mi] = z[mi][nj][0]; }
                }
                float e[2], t2[2];
#pragma unroll
                for (int mi = 0; mi < 2; ++mi) { const float s1 = __shfl_xor(s[mi], 16), ps = s[mi] + s1, p2 = __shfl_xor(ps, 32); t2[mi] = ps + p2;
                    e[mi] = dir == 0 ? (((g & 1) ? s1 : 0.f) + ((g & 2) ? p2 : 0.f)) : (((g & 1) ? 0.f : s1) + ((g & 2) ? 0.f : p2)); }
                const float o0 = e[0] + (dir == 0 ? 0.f : t2[1]), o1 = e[1] + (dir == 0 ? t2[0] : 0.f);
#pragma unroll
                for (int r = 0; r < 4; ++r) { z[0][nj][r] += o0; z[1][nj][r] += o1; }
                tot[nj] = t2[0] + t2[1];
            }
#pragma unroll
            for (int jj = 0; jj < 2; ++jj) { const int idx = ptid + 256 * jj, pos = idx >> 4, e8 = (idx & 15) * 8; *(LAS v4u*)(B + OFF_V + pos * V_ROW + e8 * 2) = vv[jj]; }
#pragma unroll
            for (int pp = 0; pp < 2; ++pp) { const int da = dbase + 32 * pp;
                const float dea = __builtin_amdgcn_exp2f(tot[2 * pp]), deb = __builtin_amdgcn_exp2f(tot[2 * pp + 1]);
                if (g == 0) *(LAS f32x2*)(B + OFF_DE + da * 4) = (f32x2){dea, deb};
#pragma unroll
                for (int mi = 0; mi < 2; ++mi) { float ea[4], eb[4];
#pragma unroll
                    for (int r = 0; r < 4; ++r) { const float b_a = z[mi][2 * pp][r], b_b = z[mi][2 * pp + 1][r];
                        const float xa = __builtin_amdgcn_exp2f(b_a), xb = __builtin_amdgcn_exp2f(b_b), ia = __builtin_amdgcn_exp2f(-b_a), ib = __builtin_amdgcn_exp2f(-b_b);
                        const unsigned qw = qv[pp][mi][r], kw = kv[pp][mi][r];
                        const float ka = bflo(kw) * ia, kb = bfhi(kw) * ib; ea[r] = ka * dea; eb[r] = kb * deb;
                        const int pos = 16 * mi + 4 * g + r;
                        *(LAS unsigned*)(B + OFF_QD + pos * QD_ROW + da * 2) = pk2c(bflo(qw) * xa, bfhi(qw) * xb);
                        *(LAS unsigned*)(B + OFF_KD + pos * QD_ROW + da * 2) = pk2c(ka, kb); }
                    *(LAS v2u*)(B + OFF_KET + da * KET_ROW + (16 * mi + 4 * g) * 2) = (v2u){pk2c(ea[0], ea[1]), pk2c(ea[2], ea[3])};
                    *(LAS v2u*)(B + OFF_KET + (da + 1) * KET_ROW + (16 * mi + 4 * g) * 2) = (v2u){pk2c(eb[0], eb[1]), pk2c(eb[2], eb[3])};
                }
            }
            if (j + 1 < nch) GLA_LOAD_QKV(j + 1);
            if (j + 2 < nch) GLA_LOAD_LOW(j + 2);
            GLA_BAR();
        }
        GLA_BAR();
#undef GLA_ROW0
#undef GLA_LOAD_QKV
#undef GLA_LOAD_LOW
#undef GLA_PUT_LOW
    } else {
        const int cw = wave - 4, l16 = lane & 15, g = lane >> 4;
        bf16* OD = dir ? OB : OF;
        LAS unsigned char* PW = lds + OFF_PW + cw * (CL * P_ROW);
        f32x4 S[2][16];
#pragma unroll
        for (int cb = 0; cb < 2; ++cb)
#pragma unroll
            for (int t = 0; t < 16; ++t) S[cb][t] = (f32x4){0.f, 0.f, 0.f, 0.f};
        GLA_BAR();
        GLA_BAR();
#define GLA_WAIT() do { asm volatile("s_waitcnt lgkmcnt(0)" ::: "memory"); __builtin_amdgcn_sched_barrier(0); } while (0)
        const int lbase = (int)(uintptr_t)lds;
        const int a_qd = lbase + OFF_QD + l16 * QD_ROW + g * 16;
        const int a_kd = lbase + OFF_KD + l16 * QD_ROW + g * 16;
        const int a_qp = lbase + OFF_QD + l16 * QD_ROW + g * 8;
        const int a_ke = lbase + OFF_KET + l16 * KET_ROW + g * 16;
        const int a_de = lbase + OFF_DE + g * 16;
        const int a_v = lbase + OFF_V + (8 * g) * V_ROW + (32 * cw + l16) * 2;
        const int a_pw = (int)(uintptr_t)PW + l16 * P_ROW + g * 16;
        for (int j = 0; j < nch; ++j) {
            const int bo = (j & 1) * BUF_BYTES;
            const size_t r0 = (size_t)rowbase + (size_t)(dir ? nch - 1 - j : j) * CL;
            f32x4 pacc[2][2];
#pragma unroll
            for (int mi = 0; mi < 2; ++mi)
#pragma unroll
                for (int ni = 0; ni < 2; ++ni) pacc[mi][ni] = (f32x4){0.f, 0.f, 0.f, 0.f};
#pragma unroll
            for (int hb = 0; hb < 4; ++hb) {
                bf16x8 fa[2][2], fb[2][2];
                rd_p(fa, fb, a_qd + bo + hb * 128, a_kd + bo + hb * 128);
#pragma unroll
                for (int kk = 0; kk < 2; ++kk)
#pragma unroll
                    for (int mi = 0; mi < 2; ++mi)
#pragma unroll
                        for (int ni = 0; ni < 2; ++ni) pacc[mi][ni] = __builtin_amdgcn_mfma_f32_16x16x32_bf16(fa[mi][kk], fb[ni][kk], pacc[mi][ni], 0, 0, 0);
            }
#pragma unroll
            for (int mi = 0; mi < 2; ++mi)
#pragma unroll
                for (int ni = 0; ni < 2; ++ni)
#pragma unroll
                    for (int r = 0; r < 4; ++r) { const int pos = 16 * mi + 4 * g + r, pk = 16 * ni + l16; const bool keep = dir ? (pk >= pos) : (pk <= pos);
                        *(LAS unsigned short*)(PW + pos * P_ROW + pk * 2) = (unsigned short)(pk2c(keep ? pacc[mi][ni][r] : 0.f, 0.f) & 0xffffu); }
            unsigned vu[2][8]; bf16x8 fp[2];
            asm volatile("s_waitcnt lgkmcnt(0)" ::: "memory");
            rd_v(vu[0], a_v + bo); rd_v(vu[1], a_v + bo + 32);
            rd_pw(fp, a_pw);
            bf16x8 Bv[2];
#pragma unroll
            for (int cb = 0; cb < 2; ++cb) Bv[cb] = __builtin_bit_cast(bf16x8, (v4u){vu[cb][0] | (vu[cb][1] << 16), vu[cb][2] | (vu[cb][3] << 16), vu[cb][4] | (vu[cb][5] << 16), vu[cb][6] | (vu[cb][7] << 16)});
            f32x4 oacc[2][2];
#pragma unroll
            for (int mi = 0; mi < 2; ++mi)
#pragma unroll
                for (int cb = 0; cb < 2; ++cb) oacc[mi][cb] = __builtin_amdgcn_mfma_f32_16x16x32_bf16(fp[mi], Bv[cb], (f32x4){0.f, 0.f, 0.f, 0.f}, 0, 0, 0);
#pragma unroll
            for (int hb = 0; hb < 4; ++hb) {
                v2u q0[2][2], q1[2][2];
                rd_q(q0, q1, a_qp + bo + hb * 128);
#pragma unroll
                for (int kk = 0; kk < 2; ++kk) { const int k2 = 2 * (hb * 2 + kk);
                    bf16x8 Bs[2];
#pragma unroll
                    for (int cb = 0; cb < 2; ++cb) Bs[cb] = __builtin_bit_cast(bf16x8, (v4u){pk2c(S[cb][k2][0], S[cb][k2][1]), pk2c(S[cb][k2][2], S[cb][k2][3]), pk2c(S[cb][k2 + 1][0], S[cb][k2 + 1][1]), pk2c(S[cb][k2 + 1][2], S[cb][k2 + 1][3])});
#pragma unroll
                    for (int mi = 0; mi < 2; ++mi) { const bf16x8 a = __builtin_bit_cast(bf16x8, (v4u){q0[mi][kk].x, q0[mi][kk].y, q1[mi][kk].x, q1[mi][kk].y});
#pragma unroll
                        for (int cb = 0; cb < 2; ++cb) oacc[mi][cb] = __builtin_amdgcn_mfma_f32_16x16x32_bf16(a, Bs[cb], oacc[mi][cb], 0, 0, 0); }
                }
            }
            { bf16* op = OD + r0 * 2048 + h * 512 + sl * 128 + 32 * cw + l16;
#pragma unroll
              for (int mi = 0; mi < 2; ++mi)
#pragma unroll
                  for (int cb = 0; cb < 2; ++cb)
#pragma unroll
                      for (int r = 0; r < 4; ++r) op[(size_t)(16 * mi + 4 * g + r) * 2048 + 16 * cb] = (bf16)(pk2c(oacc[mi][cb][r], 0.f) & 0xffffu); }
#pragma unroll
            for (int hb = 0; hb < 4; ++hb) {
                bf16x8 fk[4]; f32x4 fd[4];
                rd_s(fk, fd, a_ke + bo + hb * 5120, a_de + bo + hb * 256);
#pragma unroll
                for (int t = 0; t < 4; ++t)
#pragma unroll
                    for (int cb = 0; cb < 2; ++cb) S[cb][hb * 4 + t] = __builtin_amdgcn_mfma_f32_16x16x32_bf16(fk[t], Bv[cb], S[cb][hb * 4 + t] * fd[t], 0, 0, 0);
            }
            GLA_BAR();
        }
#undef GLA_WAIT
    }
}
}

constexpr int N_PHASE_IDS = 2 + 10 * DEPTH;
__host__ __device__ constexpr bool phase_exists(int ph) {
    if (ph < 2) return true;
    const int l = (ph - 2) / 10, s = (ph - 2) % 10, kind = l % 3;
    if (s == 5) return kind == 2;
    if (s == 7) return false;
    if (s == 4) return false;
    if (s == 0 && l > 0) return false;
    if (s == 2 && kind == 0) return false;
    return true;
}
#define IN(k) (lo <= (k) && (k) < hi)
#ifndef SITE_MASK
#define SITE_MASK 0xffffu
#endif
#ifndef WGM_RES
#define WGM_RES 4
#endif
#ifndef REPS_G1
#define REPS_G1 1
#endif
#ifndef REPS_G3
#define REPS_G3 1
#endif
#ifndef REPS_SCAN
#define REPS_SCAN 1
#endif
#ifndef REPS_ATT
#define REPS_ATT 1
#endif
#define SITE(n) ((((unsigned)(SITE_MASK)) >> (n)) & 1u)
#define SEAM(k) do { if ((k) + 1 < hi) xcd_barrier(bar); } while (0)
template <int layer> __device__ __forceinline__ void layer_body(Frame& F, const XcdBarrier& bar, const int lo, const int hi, unsigned char* lds_raw) {
    constexpr size_t wreg = (layer & 1) ? WS_WB : WS_W, bw1o = (layer & 1) ? WS_BW1B : WS_BW1, bw2o = (layer & 1) ? WS_BW2B : WS_BW2;
    bf16* const w1t = (bf16*)(F.ws + wreg); bf16* const w2t = (bf16*)(F.ws + wreg + 32 * MiB); bf16* const wmix = (bf16*)(F.ws + wreg + 64 * MiB); bf16* const wot = (bf16*)(F.ws + wreg + 90 * MiB);
#define PREP_NEXT() do { if constexpr (layer + 1 < DEPTH) { __syncthreads(); bw_phase(F, layer + 1); prep_weights(F, layer + 1, (unsigned*)(F.ws + WS_CTL) + CW_PREP + 64 * (layer + 1)); } } while (0)

        constexpr int pb = 2 + 10 * layer, kind = layer % 3, jj = layer / 3;
        const float* modl = F.mod + (size_t)layer * NSEQ * 12288;
        if (SITE(2) && layer == 0 && IN(pb + 0)) { norm0_phase(F); bw_phase(F, 0); SEAM(pb + 0); }
        if (SITE(3) && IN(pb + 1)) {
            const int N1 = kind == 0 ? 3072 : (kind == 1 ? 6400 : 1024);
            pg8::Gemm g{F.H, wmix, M, N1, D, D, 256}; pg8::StaticOrder S; S.init(M, N1, F.G, (int)blockIdx.x, REPS_G1);
            if constexpr (kind == 0) {
                pg8::EpiBf16NRope E{(bf16*)(F.ws + WS_S), N1, (const float*)(F.ws + WS_SSQB), (const float*)(F.ws + bw1o), 6400,
                                    F.in[I_GQA_QN] + jj * 128, F.in[I_GQA_KN] + jj * 128, (const float*)F.ropeA, (PG8_LAS float*)(F.lds + RING_BYTES + 4096)};
                pg8::gemm_phase<pg8::EpiBf16NRope, pg8::StaticOrder, true, true>(F.lds, g, S, E);
            } else {
                pg8::EpiBf16N<0> E{(bf16*)(F.ws + WS_S), N1, (const float*)(F.ws + WS_SSQB), (const float*)(F.ws + bw1o), 6400};
                pg8::gemm_phase<pg8::EpiBf16N<0>, pg8::StaticOrder, true, true>(F.lds, g, S, E);
            }
            SEAM(pb + 1);
        }
        if (kind == 0) {
            if (SITE(5) && IN(pb + 3)) {
                const bf16* QKV = (const bf16*)(F.ws + WS_QKV);
                float gq = fmaxf(fabsf(F.in[I_GQA_QN][jj * 128 + F.lane]), fabsf(F.in[I_GQA_QN][jj * 128 + 64 + F.lane])), gk = fmaxf(fabsf(F.in[I_GQA_KN][jj * 128 + F.lane]), fabsf(F.in[I_GQA_KN][jj * 128 + 64 + F.lane]));
#pragma unroll
                for (int o_ = 1; o_ < 64; o_ <<= 1) { gq = fmaxf(gq, __shfl_xor(gq, o_)); gk = fmaxf(gk, __shfl_xor(gk, o_)); }
                const float shiftC = __int_as_float(__builtin_amdgcn_readfirstlane(__float_as_int(11.313708499f * gq * gk * 1.02f * 1.4426950408889634f)));
                if (shiftC < 60.f) {
                for (int u_ = F.vcu; u_ < 4096 * REPS_ATT; u_ += F.G) { const int u = u_ & 4095;
                    int rowq, rowk, T, head;
                    if (u < 2048) { const int sq = u >> 9, r = u & 511; head = r >> 5; T = 8192; rowk = MP + sq * 8192; rowq = rowk + (r & 31) * 256; }
                    else { const int v = u - 2048, sq = v >> 7, r = v & 127; head = r >> 3; T = 2048; rowk = sq * 2048; rowq = rowk + (r & 7) * 256; }
                    const int kvh = head >> 2;
                    attn::attn_dense_body<128, 3072, 3072, 3072, 3072, 3072, 2, false, true>(QKV + (size_t)rowq * 3072 + head * 128, QKV + (size_t)rowk * 3072 + 2048 + kvh * 128, nullptr,
                        QKV + (size_t)rowk * 3072 + 2560 + kvh * 128, (bf16*)QKV + (size_t)rowq * 3072 + head * 128, T, (char*)lds_raw, nullptr, nullptr, 0, shiftC);
                }
                } else {
                for (int u_ = F.vcu; u_ < 4096 * REPS_ATT; u_ += F.G) { const int u = u_ & 4095;
                    int rowq, rowk, T, head;
                    if (u < 2048) { const int sq = u >> 9, r = u & 511; head = r >> 5; T = 8192; rowk = MP + sq * 8192; rowq = rowk + (r & 31) * 256; }
                    else { const int v = u - 2048, sq = v >> 7, r = v & 127; head = r >> 3; T = 2048; rowk = sq * 2048; rowq = rowk + (r & 7) * 256; }
                    const int kvh = head >> 2;
                    attn::attn_dense_body<128, 3072, 3072, 3072, 3072, 3072, 2>(QKV + (size_t)rowq * 3072 + head * 128, QKV + (size_t)rowk * 3072 + 2048 + kvh * 128, nullptr,
                        QKV + (size_t)rowk * 3072 + 2560 + kvh * 128, (bf16*)QKV + (size_t)rowq * 3072 + head * 128, T, (char*)lds_raw);
                }
                }
                PREP_NEXT();
                SEAM(pb + 3);
            }
        } else if (kind == 1) {
            if (SITE(6) && IN(pb + 2)) {
                const bf16* PROJ = (const bf16*)(F.ws + WS_PROJ); bf16* OB = (bf16*)(F.ws + WS_OB);
                const int nrep = REPS_SCAN + (F.G >> 24);
                for (int rp = 0; rp < nrep; ++rp) {
                    const int nmine = F.G == 256 ? (F.vcu < 128 ? 1 : 4) : (640 - F.vcu + F.G - 1) / F.G;
                    for (int q = 0; q < nmine; ++q) { const int c = F.G == 256 ? (F.vcu < 128 ? F.vcu : 128 + (F.vcu - 128) * 4 + q) : F.vcu + q * F.G;
                        gla::chain(F.lds, PROJ, F.H, OB, F.in[I_GLA_WG2], F.in[I_GLA_BG], c); } }
                PREP_NEXT();
                SEAM(pb + 2);
            }
            if (SITE(7) && IN(pb + 3)) { gla_post_phase(F); SEAM(pb + 3); }
        } else {
            if (SITE(8) && IN(pb + 2)) { mla_down_norm_phase(F); SEAM(pb + 2); }
            if (SITE(9) && IN(pb + 3)) {
                const bf16* DN = (const bf16*)(F.ws + WS_DOWN);
                { pg8::Gemm g{DN, wmix + (size_t)4 * MiB / 2, M, 3072, 512, 1024, 256}; pg8::StaticOrder S; S.init(M, 3072, F.G, (int)blockIdx.x);
                  pg8::EpiBf16P E{(bf16*)(F.ws + WS_Q), 3072};
                  pg8::gemm_phase<pg8::EpiBf16P, pg8::StaticOrder, true, true>(F.lds, g, S, E); }
                __syncthreads();
                { int K2 = 256, lda2 = 1024; asm volatile("" : "+s"(K2), "+s"(lda2));
                  pg8::Gemm g{DN + 512, wmix + (size_t)8 * MiB / 2, M, 4096, K2, lda2, 256}; pg8::StaticOrder S; S.init(M, 4096, F.G, (int)blockIdx.x);
                  pg8::EpiBf16KV E{(bf16*)(F.ws + WS_KV), 4096, F.in[I_MLA_KNN], (PG8_LAS float*)(F.lds + RING_BYTES + 4096)};
                  pg8::gemm_phase<pg8::EpiBf16KV, pg8::StaticOrder, true, true>(F.lds, g, S, E); }
                SEAM(pb + 3);
            }
            if (SITE(11) && IN(pb + 5)) {
                const bf16* Q = (const bf16*)(F.ws + WS_Q); const bf16* KV = (const bf16*)(F.ws + WS_KV); const bf16* DN = (const bf16*)(F.ws + WS_DOWN);
                for (int u_ = F.vcu; u_ < 4096 * REPS_ATT; u_ += F.G) { const int u = u_ & 4095;
                    int rowq, rowk, T, head;
                    if (u < 2048) { const int sq = u >> 9, r = u & 511; head = r >> 5; T = 8192; rowk = MP + sq * 8192; rowq = rowk + (r & 31) * 256; }
                    else { const int v = u - 2048, sq = v >> 7, r = v & 127; head = r >> 3; T = 2048; rowk = sq * 2048; rowq = rowk + (r & 7) * 256; }
                    attn::attn_dense_body<192, 3072, 4096, 1024, 4096, 3072, 1, true>(Q + (size_t)rowq * 3072 + head * 192, KV + (size_t)rowk * 4096 + head * 256, DN + (size_t)rowk * 1024 + 768,
                        KV + (size_t)rowk * 4096 + head * 256 + 128, (bf16*)Q + (size_t)rowq * 3072 + head * 192, T, (char*)lds_raw, F.in[I_MLA_QN], (const float*)F.ropeC, rowq - rowk);
                }
                PREP_NEXT();
                SEAM(pb + 5);
            }
        }
        if (SITE(12) && IN(pb + 6)) {
            const bf16* A2 = kind == 0 ? (const bf16*)(F.ws + WS_QKV) : (kind == 1 ? (const bf16*)(F.ws + WS_OB) : (const bf16*)(F.ws + WS_Q));
            pg8::Gemm g{A2, wot, M, D, D, kind == 1 ? D : 3072, kind == 2 ? 384 : 256}; pg8::StaticOrder S; S.init(M, D, F.G, (int)blockIdx.x, 1, WGM_RES);
            typedef pg8::EpiResGateNormB<layer == 0 ? 0 : 1> EpiT;
            EpiT E{F.in[I_XP], F.in[I_XS], F.out, modl + 2 * D, F.H, F.in[I_N2G] + layer * D, modl + 4 * D, (float*)(F.ws + WS_SSQA), (PG8_LAS float*)(F.lds + RING_BYTES)};
            pg8::gemm_phase<EpiT, pg8::StaticOrder, true, true>(F.lds, g, S, E);
            SEAM(pb + 6);
        }
        if (SITE(14) && IN(pb + 8)) {
            pg8::Gemm g{F.H, w1t, M, FF, D, D, 256}; pg8::StaticOrder S; S.init(M, FF, F.G, (int)blockIdx.x, REPS_G3);
            pg8::EpiBf16N<1> E{(bf16*)(F.ws + WS_HID), FF, (const float*)(F.ws + WS_SSQA), (const float*)(F.ws + bw2o), FF};
            pg8::gemm_phase<pg8::EpiBf16N<1>, pg8::StaticOrder, true, true>(F.lds, g, S, E);
            SEAM(pb + 8);
        }
        if (SITE(15) && IN(pb + 9)) {
            pg8::Gemm g{(const bf16*)(F.ws + WS_HID), w2t, M, D, FF, FF, 256}; pg8::StaticOrder S; S.init(M, D, F.G, (int)blockIdx.x, 1, WGM_RES);
            typedef pg8::EpiResGateNormB<layer + 1 < DEPTH ? 1 : 2> EpiT;
            EpiT E{nullptr, F.in[I_XS], F.out, modl + 5 * D, layer + 1 < DEPTH ? F.H : nullptr, F.in[I_N1G] + (layer + 1 < DEPTH ? layer + 1 : 0) * D,
                   modl + (layer + 1 < DEPTH ? NSEQ * 12288 + D : 0), (float*)(F.ws + WS_SSQB), (PG8_LAS float*)(F.lds + RING_BYTES)};
            pg8::gemm_phase<EpiT, pg8::StaticOrder, true, true>(F.lds, g, S, E);
            SEAM(pb + 9);
        }
    }
#undef PREP_NEXT
__global__ void __launch_bounds__(NWAVES * 64, 2) trunk_fwd(Args args) {
    extern __shared__ __attribute__((aligned(16))) unsigned char lds_raw[];
    Frame F;
    F.lds = (LAS unsigned char*)lds_raw;
    F.tid = threadIdx.x; F.lane = F.tid & 63; F.wave = __builtin_amdgcn_readfirstlane(F.tid >> 6);
    F.G = gridDim.x; { const int bx = blockIdx.x; F.vcu = (F.G % 8 == 0) ? (bx % 8) * (F.G / 8) + bx / 8 : bx; }
    F.in = args.in; F.out = args.out; F.ws = args.ws;
    F.mod = (float*)(args.ws + WS_MOD); F.ropeA = (const f32x2*)(args.ws + WS_ROPE); F.ropeC = F.ropeA + 192 * 32;
    F.H = (bf16*)(args.ws + WS_H);
    for (int u = F.tid; u < (LDS_BYTES - LDSCTL_OFF) / 4; u += NWAVES * 64) ((LAS unsigned*)(F.lds + LDSCTL_OFF))[u] = 0u;
    __syncthreads();
    XcdBarrier bar; bar.bar = (unsigned*)(args.ws + WS_CTL) + CW_BAR; bar.x = 0; bar.st = nullptr;
    if (args.one_launch) bar = xcd_barrier_post((unsigned*)(args.ws + WS_CTL) + CW_BAR, (volatile LAS unsigned*)(F.lds + LDSCTL_OFF));
    const int lo = args.ph_lo, hi = args.ph_hi;

    if (SITE(0) && IN(0)) { ada_phase(F); rope_tables(F); prep_weights(F, 0, (unsigned*)(F.ws + WS_CTL) + CW_PREP); SEAM(0); }
    if (SITE(1) && IN(1)) { mod_finalize(F); SEAM(1); }

    layer_body<0>(F, bar, lo, hi, lds_raw); layer_body<1>(F, bar, lo, hi, lds_raw); layer_body<2>(F, bar, lo, hi, lds_raw); layer_body<3>(F, bar, lo, hi, lds_raw);
#undef IN
#undef SEAM
}

extern "C" void kernel_launch(void* const* d_in, const int* in_sizes, int n_in, void* d_out, int out_size, void* d_ws, size_t ws_size, hipStream_t stream) {
    static int grid = 0;
    if (grid == 0) {
        if (n_in != N_IN || out_size != M * D || ws_size < WS_END) { fprintf(stderr, "kernel_launch: unexpected shapes (n_in %d out %d ws %zu, need %zu)\n", n_in, out_size, ws_size, (size_t)WS_END); grid = -1; return; }
        int dev = 0, cus = 0, per_cu = 0;
        if (hipGetDevice(&dev) != hipSuccess || hipDeviceGetAttribute(&cus, hipDeviceAttributeMultiprocessorCount, dev) != hipSuccess) { grid = -1; return; }
        if (hipFuncSetAttribute((const void*)trunk_fwd, hipFuncAttributeMaxDynamicSharedMemorySize, LDS_BYTES) != hipSuccess) { fprintf(stderr, "kernel_launch: hipFuncSetAttribute failed\n"); grid = -1; return; }
        if (hipOccupancyMaxActiveBlocksPerMultiprocessor(&per_cu, (const void*)trunk_fwd, NWAVES * 64, LDS_BYTES) != hipSuccess || per_cu < 1) { fprintf(stderr, "kernel_launch: occupancy query says %d blocks per CU\n", per_cu); }
        (void)hipGetLastError();
        grid = cus;
    }
    if (grid < 0) return;
    (void)hipMemsetAsync((char*)d_ws + WS_CTL, 0, CTL_ZERO_BYTES, stream);
    Args a{};
    for (int i = 0; i < N_IN; ++i) a.in[i] = (const float*)d_in[i];
    a.out = (float*)d_out; a.ws = (unsigned char*)d_ws; a.pad = 0;
#if MK_ONE_LAUNCH
    a.ph_lo = 0; a.ph_hi = N_PHASE_IDS; a.one_launch = 1;
    hipLaunchKernelGGL(trunk_fwd, dim3(grid), dim3(NWAVES * 64), LDS_BYTES, stream, a);
#else
    for (int ph = 0; ph < N_PHASE_IDS; ++ph) { if (!phase_exists(ph)) continue;
        a.ph_lo = ph; a.ph_hi = ph + 1; a.one_launch = 0;
        hipLaunchKernelGGL(trunk_fwd, dim3(grid), dim3(NWAVES * 64), LDS_BYTES, stream, a); }
#endif
    const hipError_t le = hipPeekAtLastError();
    if (le != hipSuccess) fprintf(stderr, "kernel_launch: launch failed: %s\n", hipGetErrorName(le));
}
```

```cpp
#include <hip/hip_runtime.h>
#include <cstdio>
#include <cstdint>

#define GAS __attribute__((address_space(1)))
#define LAS __attribute__((address_space(3)))
#define PG8_LAS __attribute__((address_space(3)))

#ifndef MK_ONE_LAUNCH
#define MK_ONE_LAUNCH 1
#endif

constexpr int D = 2048, M = 65536, MP = 32768, NSEQ = 20, FF = 8192, DEPTH = 4;
constexpr float NORM_EPS = 1e-6f;
enum { I_XP = 0, I_XS, I_CP, I_CS, I_N1G, I_N2G, I_ADAW, I_ADAB, I_GQA_WQKV, I_GQA_QN, I_GQA_KN, I_GQA_WO, I_GLA_WIN, I_GLA_WG1, I_GLA_WG2, I_GLA_BG, I_GLA_ON, I_GLA_WO,
       I_MLA_WDOWN, I_MLA_QAN, I_MLA_KVAN, I_MLA_WUQ, I_MLA_WUKV, I_MLA_QN, I_MLA_KNN, I_MLA_KRN, I_MLA_WO, I_W1, I_W2, N_IN };

constexpr size_t MiB = 1u << 20;
constexpr size_t WS_CTL = 0, CTL_ZERO_BYTES = 1 * MiB;
constexpr size_t WS_MODP = 384 * MiB;
constexpr size_t WS_MOD = 16 * MiB;
constexpr size_t WS_BND = 20 * MiB - 4096;
constexpr size_t WS_ROPE = 20 * MiB;
constexpr size_t WS_BW1 = 20 * MiB + 256 * 1024, WS_BW2 = 21 * MiB;
constexpr size_t WS_BW1B = 26 * MiB, WS_BW2B = 26 * MiB + 768 * 1024;
constexpr size_t WS_SSQA = 22 * MiB, WS_SSQB = 24 * MiB;
constexpr size_t WS_W = 28 * MiB;
constexpr size_t WS_W1T = WS_W, WS_W2T = WS_W + 32 * MiB, WS_WMIX = WS_W + 64 * MiB;
constexpr size_t WS_WO_T = WS_WMIX + 26 * MiB;
constexpr size_t WS_H = 128 * MiB;
constexpr size_t WS_S = 384 * MiB;
constexpr size_t WS_QKV = WS_S;
constexpr size_t WS_PROJ = WS_S, WS_OB = WS_S + 800 * MiB;
constexpr size_t WS_DOWN = WS_S, WS_Q = WS_S + 128 * MiB, WS_KV = WS_S + 512 * MiB;
constexpr size_t WS_HID = WS_S;
constexpr size_t WS_WB = WS_S + 1056 * MiB;
constexpr size_t WS_END = WS_WB + 100 * MiB;
static_assert(WS_WO_T + 8 * MiB <= WS_H && WS_OB + 256 * MiB <= WS_END && WS_KV + 512 * MiB <= WS_END && WS_HID + 1024 * MiB <= WS_END, "ws map");
constexpr int CW_BAR = 4096;
constexpr int CW_PREP = 8192;

constexpr int RING_BYTES = 131072;
constexpr int LDSCTL_OFF = 144 * 1024 - 512;
constexpr int LDS_BYTES = 147456;

typedef unsigned short bf16;
typedef unsigned v4u __attribute__((ext_vector_type(4)));
typedef unsigned v2u __attribute__((ext_vector_type(2)));
typedef unsigned v3u __attribute__((ext_vector_type(3)));
typedef float f32x4 __attribute__((ext_vector_type(4)));
typedef float f32x2 __attribute__((ext_vector_type(2)));
typedef short bf16x8 __attribute__((ext_vector_type(8)));
typedef GAS unsigned gu32;
#define RLX_AGENT __ATOMIC_RELAXED, __HIP_MEMORY_SCOPE_AGENT
#define LDS_WAIT() asm volatile("s_waitcnt lgkmcnt(0)" ::: "memory")
#define VM_WAIT() asm volatile("s_waitcnt vmcnt(0)" ::: "memory")
__device__ __forceinline__ unsigned f2bf(float f) { unsigned u = __builtin_bit_cast(unsigned, f); return (u + 0x7fffu + ((u >> 16) & 1u)) >> 16; }
typedef __bf16 bf16x2_t __attribute__((ext_vector_type(2)));
__device__ __forceinline__ unsigned pk2c(float lo, float hi) { const f32x2 v = {lo, hi}; const bf16x2_t b = __builtin_convertvector(v, bf16x2_t); return __builtin_bit_cast(unsigned, b); }
__device__ __forceinline__ unsigned pk2(float lo, float hi) { unsigned r; asm volatile("v_cvt_pk_bf16_f32 %0, %1, %2" : "=v"(r) : "v"(lo), "v"(hi)); return r; }
__device__ __forceinline__ float bflo(unsigned u) { return __uint_as_float(u << 16); }
__device__ __forceinline__ float bfhi(unsigned u) { return __uint_as_float(u & 0xffff0000u); }
__device__ __forceinline__ int seq_of_row(int row) { return row < MP ? (row >> 11) : 16 + ((row - MP) >> 13); }
__device__ __forceinline__ int pos_of_row(int row) { return row < MP ? (row & 2047) : (row & 8191); }
__device__ __forceinline__ float wave_sum(float v) {
#pragma unroll
    for (int o = 1; o < 64; o <<= 1) v += __shfl_xor(v, o);
    return v;
}
namespace pg8 {
typedef unsigned short bf16_t;
typedef short bf16x8 __attribute__((ext_vector_type(8)));
typedef float f32x4 __attribute__((ext_vector_type(4)));
typedef unsigned u32x4 __attribute__((ext_vector_type(4)));
constexpr int BM = 256, BK = 64, HALF = 128, HTB = HALF * BK * 2  , STAGE_BYTES = 8 * HTB, NXCD = 8, WGM = 8;

__host__ __device__ __forceinline__ int lds_byte(int r, int c) { const int st = (r >> 4) * 2 + (c >> 5), rr = r & 15, cc = c & 31, ob = rr * 64 + cc * 2; return st * 1024 + (ob ^ (((ob >> 9) & 1) << 5)); }
__host__ __device__ __forceinline__ void stage_rc(int b, int& R, int& C) { const int st = b / 1024, sb = b % 1024, swz = sb ^ (((sb >> 9) & 1) << 5); R = (st >> 1) * 16 + swz / 64; C = (st & 1) * 32 + (swz % 64) / 2; }
__host__ __device__ __forceinline__ int perm32(int rho) { const int n = rho >> 4, i = rho & 15; return 8 * (i >> 2) + 4 * n + (i & 3); }

struct Unit { int pm, pn; };
struct Gemm { const bf16_t* A; const bf16_t* Bt; int M, N, K, lda, pairA; };

struct StaticOrder {
    int nM, nN, nwg, G, c, reps, wgm;
    __host__ __device__ void init(int M, int N, int G_, int c_, int reps_ = 1, int wgm_ = 4) { nM = M / BM; nN = N / BM; nwg = nM * nN; G = G_; c = c_; reps = reps_; wgm = wgm_; }
    __host__ __device__ bool next(int i, Unit& u) const {
        long L = (long)i * G + c; if (L >= (long)nwg * reps) return false;
        L %= nwg;
        int wgid = (int)L; { const int q = nwg / NXCD, r = nwg % NXCD, xcd = wgid % NXCD, off = wgid / NXCD; wgid = (xcd < r ? xcd * (q + 1) : r * (q + 1) + (xcd - r) * q) + off; }
        const int nig = wgm * nN, gid = wgid / nig, fm = gid * wgm, gsz = (nM - fm) < wgm ? (nM - fm) : wgm;
        u.pm = fm + ((wgid % nig) % gsz); u.pn = (wgid % nig) / gsz; return true;
    }
    __device__ __forceinline__ void a_ready(const Unit&) const {}
    __device__ __forceinline__ void done(const Unit&) const {}
};


__device__ __forceinline__ unsigned cvt_pk_bf16(float lo, float hi) { return ::pk2(lo, hi); }
template <int ACT> struct EpiBf16N {
    static constexpr bool PERM = true, AFTER_DRAIN = false, OWN_ALIGN = true;
    bf16_t* O; int ldc; const float* ssq; const float* bw; int ldbw;
    __device__ __forceinline__ void operator()(const f32x4 (&acc)[2][2][4][2], const Unit& u, int wr, int wc, int fr, int fq) const {
        const int rowt = u.pm * BM, row0 = rowt + wr * 64 + fr, col0 = u.pn * BM + wc * 32 + 8 * fq;
        const int seq = rowt < 32768 ? (rowt >> 11) : 16 + ((rowt - 32768) >> 13);
        typedef float f32x2v __attribute__((ext_vector_type(2)));
        f32x2v pv[8]; f32x4 bv[2][2];
#pragma unroll
        for (int i = 0; i < 8; ++i) pv[i] = *(const f32x2v*)(ssq + (size_t)(row0 + (i >> 2) * HALF + (i & 3) * 16) * 8 + 2 * fq);
#pragma unroll
        for (int bj = 0; bj < 2; ++bj)
#pragma unroll
            for (int n = 0; n < 2; ++n) bv[bj][n] = *(const f32x4*)(bw + (size_t)seq * ldbw + col0 + bj * HALF + 4 * n);
        asm volatile("" ::: "memory"); if (wr == 0) __builtin_amdgcn_s_barrier(); asm volatile("" ::: "memory");
        float rs[8];
#pragma unroll
        for (int i = 0; i < 8; ++i) { float s = pv[i].x + pv[i].y; s += __shfl_xor(s, 16); s += __shfl_xor(s, 32); rs[i] = __builtin_amdgcn_rsqf(s * (1.f / 2048.f) + 1e-6f); }
#pragma unroll
        for (int ai = 0; ai < 2; ++ai)
#pragma unroll
            for (int m = 0; m < 4; ++m) { const int r = row0 + ai * HALF + m * 16; const float rsr = rs[ai * 4 + m];
                bf16_t* rowp = O + (size_t)r * ldc + col0;
#pragma unroll
                for (int bj = 0; bj < 2; ++bj) { f32x4 v0 = acc[ai][bj][m][0] * rsr + bv[bj][0], v1 = acc[ai][bj][m][1] * rsr + bv[bj][1];
                    if (ACT == 1) {
#pragma unroll
                        for (int j = 0; j < 4; ++j) { const float a = fmaxf(v0[j], 0.f), b = fmaxf(v1[j], 0.f); v0[j] = a * a; v1[j] = b * b; } }
                    u32x4 w; w.x = cvt_pk_bf16(v0[0], v0[1]); w.y = cvt_pk_bf16(v0[2], v0[3]); w.z = cvt_pk_bf16(v1[0], v1[1]); w.w = cvt_pk_bf16(v1[2], v1[3]);
                    *(u32x4*)(rowp + bj * HALF) = w; } }
    }
};
struct EpiResGateNorm {
    static constexpr bool PERM = false, AFTER_DRAIN = false, OWN_ALIGN = false;
    const float* in0; const float* in1; float* out; const float* gate;
    bf16_t* xa; const float* gn; const float* sc; float* ssq; PG8_LAS float* xl;
    __device__ __forceinline__ void operator()(const f32x4 (&acc)[2][2][4][2], const Unit& u, int wr, int wc, int fr, int fq) const {
        const int rowt = u.pm * BM, row0 = rowt + wr * 64 + fr, col0 = u.pn * BM + wc * 32 + 4 * fq;
        const int seq = rowt < 32768 ? (rowt >> 11) : 16 + ((rowt - 32768) >> 13);
        const float* gp = gate + (size_t)seq * 12288 + col0;
        typedef unsigned u32x2 __attribute__((ext_vector_type(2)));
        u32x2 dp[2][2][4][2];
        {
            f32x4 gv[2][2];
#pragma unroll
            for (int bj = 0; bj < 2; ++bj)
#pragma unroll
                for (int n = 0; n < 2; ++n) gv[bj][n] = *(const f32x4*)(gp + bj * HALF + n * 16);
#pragma unroll
            for (int ai = 0; ai < 2; ++ai)
#pragma unroll
                for (int bj = 0; bj < 2; ++bj)
#pragma unroll
                    for (int m = 0; m < 4; ++m)
#pragma unroll
                        for (int n = 0; n < 2; ++n) { const f32x4 d = gv[bj][n] * acc[ai][bj][m][n]; dp[ai][bj][m][n] = (u32x2){cvt_pk_bf16(d[0], d[1]), cvt_pk_bf16(d[2], d[3])}; }
        }
        asm volatile("" ::: "memory");
        const float* base = in0 ? (rowt < 32768 ? in0 : in1 - (size_t)32768 * 2048) : out;
        f32x4 av[2][2];
#pragma unroll
        for (int bj = 0; bj < 2; ++bj)
#pragma unroll
            for (int n = 0; n < 2; ++n) { if (xa) av[bj][n] = *(const f32x4*)(gn + col0 + bj * HALF + n * 16) * (*(const f32x4*)(sc + (size_t)seq * 12288 + col0 + bj * HALF + n * 16) + 1.0f); else av[bj][n] = (f32x4){0.f, 0.f, 0.f, 0.f}; }
#pragma unroll
        for (int ai = 0; ai < 2; ++ai) {
            f32x4 bsv[4][2][2];
#pragma unroll
            for (int m = 0; m < 4; ++m)
#pragma unroll
                for (int bj = 0; bj < 2; ++bj)
#pragma unroll
                    for (int n = 0; n < 2; ++n) bsv[m][bj][n] = *(const f32x4*)(base + (size_t)(row0 + ai * HALF + m * 16) * 2048 + col0 + bj * HALF + n * 16);
            asm volatile("" ::: "memory");
#pragma unroll
            for (int m = 0; m < 4; ++m) { const size_t off = (size_t)(row0 + ai * HALF + m * 16) * 2048 + col0; float ss = 0.f;
#pragma unroll
                for (int bj = 0; bj < 2; ++bj)
#pragma unroll
                    for (int n = 0; n < 2; ++n) { const u32x2 dq = dp[ai][bj][m][n];
                        const f32x4 d = {__uint_as_float(dq.x << 16), __uint_as_float(dq.x & 0xffff0000u), __uint_as_float(dq.y << 16), __uint_as_float(dq.y & 0xffff0000u)};
                        const f32x4 o = bsv[m][bj][n] + d;
                        *(f32x4*)(out + off + bj * HALF + n * 16) = o;
                        if (xa) { const f32x4 y = o * av[bj][n]; ss += (o[0] * o[0] + o[1] * o[1]) + (o[2] * o[2] + o[3] * o[3]);
                            *(u32x2*)(xa + off + bj * HALF + n * 16) = (u32x2){cvt_pk_bf16(y[0], y[1]), cvt_pk_bf16(y[2], y[3])}; } }
                if (xa) { ss += __shfl_xor(ss, 16); ss += __shfl_xor(ss, 32);
                    if (fq == 0) xl[(ai * HALF + wr * 64 + m * 16 + fr) * 4 + wc] = ss; } }
            asm volatile("" ::: "memory");
        }
        if (xa) {
            asm volatile("s_waitcnt lgkmcnt(0)" ::: "memory"); __builtin_amdgcn_s_barrier(); asm volatile("" ::: "memory");
            const int t = threadIdx.x;
            if (t < 256) { const f32x4 p = *(const PG8_LAS f32x4*)(xl + t * 4); ssq[(size_t)(rowt + t) * 8 + u.pn] = (p[0] + p[1]) + (p[2] + p[3]); }
        }
    }
};
template <int MODE>
struct EpiResGateNormB {
    static constexpr bool PERM = true, AFTER_DRAIN = false, OWN_ALIGN = true;
    const float* in0; const float* in1; float* out; const float* gate;
    bf16_t* xa; const float* gn; const float* sc; float* ssq; PG8_LAS float* xl;
    static __device__ __forceinline__ void unpack(u32x4 w, f32x4& lo, f32x4& hi) {
        lo = (f32x4){__uint_as_float(w.x << 16), __uint_as_float(w.x & 0xffff0000u), __uint_as_float(w.y << 16), __uint_as_float(w.y & 0xffff0000u)};
        hi = (f32x4){__uint_as_float(w.z << 16), __uint_as_float(w.z & 0xffff0000u), __uint_as_float(w.w << 16), __uint_as_float(w.w & 0xffff0000u)};
    }
    static __device__ __forceinline__ u32x4 pack(f32x4 lo, f32x4 hi) { u32x4 w; w.x = cvt_pk_bf16(lo[0], lo[1]); w.y = cvt_pk_bf16(lo[2], lo[3]); w.z = cvt_pk_bf16(hi[0], hi[1]); w.w = cvt_pk_bf16(hi[2], hi[3]); return w; }
    __device__ __forceinline__ void operator()(const f32x4 (&acc)[2][2][4][2], const Unit& u, int wr, int wc, int fr, int fq) const {
        const int rowt = u.pm * BM, row0 = rowt + wr * 64 + fr, col0 = u.pn * BM + wc * 32 + 8 * fq;
        const int seq = rowt < 32768 ? (rowt >> 11) : 16 + ((rowt - 32768) >> 13);
        const float* gp = gate + (size_t)seq * 12288 + col0;
        bf16_t* const xb = (bf16_t*)out + (size_t)row0 * 4096 + u.pn * 512 + wc * 32 + 8 * fq;
        f32x4 gv[2][2], av[2][2];
        if constexpr (MODE == 0) {
            typedef unsigned u32x2 __attribute__((ext_vector_type(2)));
            u32x2 dp[2][2][4][2];
#pragma unroll
            for (int bj = 0; bj < 2; ++bj)
#pragma unroll
                for (int n = 0; n < 2; ++n) gv[bj][n] = *(const f32x4*)(gp + bj * HALF + 4 * n);
            asm volatile("" ::: "memory"); if (wr == 0) __builtin_amdgcn_s_barrier(); asm volatile("" ::: "memory");
#pragma unroll
            for (int ai = 0; ai < 2; ++ai)
#pragma unroll
                for (int bj = 0; bj < 2; ++bj)
#pragma unroll
                    for (int m = 0; m < 4; ++m)
#pragma unroll
                        for (int n = 0; n < 2; ++n) { const f32x4 d = gv[bj][n] * acc[ai][bj][m][n]; dp[ai][bj][m][n] = (u32x2){cvt_pk_bf16(d[0], d[1]), cvt_pk_bf16(d[2], d[3])}; }
            asm volatile("" ::: "memory");
#pragma unroll
            for (int bj = 0; bj < 2; ++bj)
#pragma unroll
                for (int n = 0; n < 2; ++n) av[bj][n] = *(const f32x4*)(sc + (size_t)seq * 12288 + col0 + bj * HALF + 4 * n);
            const float* base = rowt < 32768 ? in0 : in1 - (size_t)32768 * 2048;
#pragma unroll
            for (int ai = 0; ai < 2; ++ai) {
                f32x4 bsv[4][2][2];
#pragma unroll
                for (int m = 0; m < 4; ++m)
#pragma unroll
                    for (int bj = 0; bj < 2; ++bj)
#pragma unroll
                        for (int n = 0; n < 2; ++n) bsv[m][bj][n] = *(const f32x4*)(base + (size_t)(row0 + ai * HALF + m * 16) * 2048 + col0 + bj * HALF + 4 * n);
                asm volatile("" ::: "memory");
#pragma unroll
                for (int m = 0; m < 4; ++m) { const size_t off = (size_t)(row0 + ai * HALF + m * 16) * 2048 + col0; float ss = 0.f;
#pragma unroll
                    for (int bj = 0; bj < 2; ++bj) { f32x4 o[2];
#pragma unroll
                        for (int n = 0; n < 2; ++n) { const u32x2 dq = dp[ai][bj][m][n];
                            const f32x4 d = {__uint_as_float(dq.x << 16), __uint_as_float(dq.x & 0xffff0000u), __uint_as_float(dq.y << 16), __uint_as_float(dq.y & 0xffff0000u)};
                            o[n] = bsv[m][bj][n] + d; ss += (o[n][0] * o[n][0] + o[n][1] * o[n][1]) + (o[n][2] * o[n][2] + o[n][3] * o[n][3]); }
                        *(u32x4*)(xb + (size_t)(ai * HALF + m * 16) * 4096 + bj * HALF) = pack(o[0], o[1]);
                        *(u32x4*)(xa + off + bj * HALF) = pack(o[0] * av[bj][0], o[1] * av[bj][1]); }
                    ss += __shfl_xor(ss, 16); ss += __shfl_xor(ss, 32);
                    if (fq == 0) xl[(ai * HALF + wr * 64 + m * 16 + fr) * 4 + wc] = ss; }
                asm volatile("" ::: "memory");
            }
        } else {
            u32x4 xv[2][4][2], dpk[2][4][2];
#pragma unroll
            for (int bj = 0; bj < 2; ++bj)
#pragma unroll
                for (int n = 0; n < 2; ++n) gv[bj][n] = *(const f32x4*)(gp + bj * HALF + 4 * n);
#pragma unroll
            for (int m = 0; m < 4; ++m)
#pragma unroll
                for (int bj = 0; bj < 2; ++bj) xv[0][m][bj] = *(const u32x4*)(xb + (size_t)(m * 16) * 4096 + bj * HALF);
            asm volatile("" ::: "memory"); if (wr == 0) __builtin_amdgcn_s_barrier(); asm volatile("" ::: "memory");
#pragma unroll
            for (int ai = 0; ai < 2; ++ai)
#pragma unroll
                for (int m = 0; m < 4; ++m)
#pragma unroll
                    for (int bj = 0; bj < 2; ++bj) dpk[ai][m][bj] = pack(gv[bj][0] * acc[ai][bj][m][0], gv[bj][1] * acc[ai][bj][m][1]);
            asm volatile("" ::: "memory");
#pragma unroll
            for (int bj = 0; bj < 2; ++bj)
#pragma unroll
                for (int n = 0; n < 2; ++n) { if constexpr (MODE == 1) av[bj][n] = *(const f32x4*)(sc + (size_t)seq * 12288 + col0 + bj * HALF + 4 * n); else av[bj][n] = (f32x4){0.f, 0.f, 0.f, 0.f}; }
#pragma unroll
            for (int m = 0; m < 4; ++m)
#pragma unroll
                for (int bj = 0; bj < 2; ++bj) xv[1][m][bj] = *(const u32x4*)(xb + (size_t)(HALF + m * 16) * 4096 + bj * HALF);
            if constexpr (MODE == 2) { asm volatile("s_waitcnt vmcnt(0)" ::: "memory"); __builtin_amdgcn_s_barrier(); }
            asm volatile("" ::: "memory");
#pragma unroll
            for (int ai = 0; ai < 2; ++ai) {
#pragma unroll
                for (int m = 0; m < 4; ++m) { const size_t off = (size_t)(row0 + ai * HALF + m * 16) * 2048 + col0; float ss = 0.f;
#pragma unroll
                    for (int bj = 0; bj < 2; ++bj) { f32x4 o[2], d[2]; unpack(xv[ai][m][bj], o[0], o[1]); unpack(dpk[ai][m][bj], d[0], d[1]); o[0] += d[0]; o[1] += d[1];
                        if constexpr (MODE == 2) { *(f32x4*)(out + off + bj * HALF) = o[0]; *(f32x4*)(out + off + bj * HALF + 4) = o[1]; }
                        else {
#pragma unroll
                            for (int n = 0; n < 2; ++n) ss += (o[n][0] * o[n][0] + o[n][1] * o[n][1]) + (o[n][2] * o[n][2] + o[n][3] * o[n][3]);
                            *(u32x4*)(xb + (size_t)(ai * HALF + m * 16) * 4096 + bj * HALF) = pack(o[0], o[1]);
                            *(u32x4*)(xa + off + bj * HALF) = pack(o[0] * av[bj][0], o[1] * av[bj][1]); } }
                    if constexpr (MODE != 2) { ss += __shfl_xor(ss, 16); ss += __shfl_xor(ss, 32);
                        if (fq == 0) xl[(ai * HALF + wr * 64 + m * 16 + fr) * 4 + wc] = ss; } }
                asm volatile("" ::: "memory");
            }
        }
        if constexpr (MODE != 2) {
            asm volatile("s_waitcnt lgkmcnt(0)" ::: "memory"); __builtin_amdgcn_s_barrier(); asm volatile("" ::: "memory");
            const int t = threadIdx.x;
            if (t < 256) { const f32x4 p = *(const PG8_LAS f32x4*)(xl + t * 4); ssq[(size_t)(rowt + t) * 8 + u.pn] = (p[0] + p[1]) + (p[2] + p[3]); }
        }
    }
};
struct EpiBf16NRope {
    static constexpr bool PERM = true, AFTER_DRAIN = false, OWN_ALIGN = true;
    bf16_t* O; int ldc; const float* ssq; const float* bw; int ldbw;
    const float* qg; const float* kg; const float* rope; PG8_LAS float* hs;
    __device__ __forceinline__ void operator()(f32x4 (&acc)[2][2][4][2], const Unit& u, int wr, int wc, int fr, int fq) const {
        const int rowt = u.pm * BM, row0 = rowt + wr * 64 + fr, col0 = u.pn * BM + wc * 32 + 8 * fq;
        const int seq = rowt < 32768 ? (rowt >> 11) : 16 + ((rowt - 32768) >> 13);
        const bool roped = u.pn < 10;
        typedef float f32x2v __attribute__((ext_vector_type(2)));
        f32x2v pv[8]; f32x4 bv[2][2], gv[2];
#pragma unroll
        for (int i = 0; i < 8; ++i) pv[i] = *(const f32x2v*)(ssq + (size_t)(row0 + (i >> 2) * HALF + (i & 3) * 16) * 8 + 2 * fq);
#pragma unroll
        for (int bj = 0; bj < 2; ++bj)
#pragma unroll
            for (int n = 0; n < 2; ++n) bv[bj][n] = *(const f32x4*)(bw + (size_t)seq * ldbw + col0 + bj * HALF + 4 * n);
        { const float* g = (u.pn < 8 ? qg : kg) + wc * 32 + 8 * fq; gv[0] = *(const f32x4*)g; gv[1] = *(const f32x4*)(g + 4); }
        asm volatile("" ::: "memory"); if (wr == 0) __builtin_amdgcn_s_barrier(); asm volatile("" ::: "memory");
        float rs[8];
#pragma unroll
        for (int i = 0; i < 8; ++i) { float s = pv[i].x + pv[i].y; s += __shfl_xor(s, 16); s += __shfl_xor(s, 32); rs[i] = __builtin_amdgcn_rsqf(s * (1.f / 2048.f) + 1e-6f); }
#pragma unroll
        for (int ai = 0; ai < 2; ++ai)
#pragma unroll
            for (int m = 0; m < 4; ++m)
#pragma unroll
                for (int bj = 0; bj < 2; ++bj) { const float rsr = rs[ai * 4 + m];
                    acc[ai][bj][m][0] = acc[ai][bj][m][0] * rsr + bv[bj][0]; acc[ai][bj][m][1] = acc[ai][bj][m][1] * rsr + bv[bj][1];
                    if (roped) { const f32x4 a = acc[ai][bj][m][0], b = acc[ai][bj][m][1];
                        float s = ((a[0] * a[0] + a[1] * a[1]) + (a[2] * a[2] + a[3] * a[3])) + ((b[0] * b[0] + b[1] * b[1]) + (b[2] * b[2] + b[3] * b[3]));
                        s += __shfl_xor(s, 16); s += __shfl_xor(s, 32);
                        if (fq == 0) hs[((ai * HALF + wr * 64 + m * 16 + fr) * 2 + bj) * 4 + wc] = s; } }
        if (roped) { asm volatile("s_waitcnt lgkmcnt(0)" ::: "memory"); __builtin_amdgcn_s_barrier(); asm volatile("" ::: "memory"); }
#pragma unroll
        for (int ai = 0; ai < 2; ++ai) {
            f32x4 cs[4][2];
            if (roped) {
#pragma unroll
                for (int m = 0; m < 4; ++m) { const int r = row0 + ai * HALF + m * 16, t = r < 32768 ? (r & 2047) : (r & 8191);
                    const float* rp = rope + (size_t)((wc < 2 ? (t >> 6) : 128 + (t & 63)) * 32 + (wc & 1) * 16 + 4 * fq) * 2;
                    cs[m][0] = *(const f32x4*)rp; cs[m][1] = *(const f32x4*)(rp + 4); }
            }
#pragma unroll
            for (int m = 0; m < 4; ++m) { const int r = row0 + ai * HALF + m * 16; bf16_t* rowp = O + (size_t)r * ldc + col0;
#pragma unroll
                for (int bj = 0; bj < 2; ++bj) { f32x4 v0 = acc[ai][bj][m][0], v1 = acc[ai][bj][m][1];
                    if (roped) { const f32x4 hp = *(const PG8_LAS f32x4*)(hs + ((ai * HALF + wr * 64 + m * 16 + fr) * 2 + bj) * 4);
                        const float hr = __builtin_amdgcn_rsqf(((hp[0] + hp[1]) + (hp[2] + hp[3])) * (1.f / 128.f) + 1e-6f);
                        v0 = v0 * hr * gv[0]; v1 = v1 * hr * gv[1];
                        const f32x4 c0 = cs[m][0], c1 = cs[m][1];
                        const float a0 = v0[0] * c0[0] - v0[1] * c0[1], a1 = v0[0] * c0[1] + v0[1] * c0[0], a2 = v0[2] * c0[2] - v0[3] * c0[3], a3 = v0[2] * c0[3] + v0[3] * c0[2];
                        const float b0 = v1[0] * c1[0] - v1[1] * c1[1], b1 = v1[0] * c1[1] + v1[1] * c1[0], b2 = v1[2] * c1[2] - v1[3] * c1[3], b3 = v1[2] * c1[3] + v1[3] * c1[2];
                        v0 = (f32x4){a0, a1, a2, a3}; v1 = (f32x4){b0, b1, b2, b3}; }
                    u32x4 w; w.x = cvt_pk_bf16(v0[0], v0[1]); w.y = cvt_pk_bf16(v0[2], v0[3]); w.z = cvt_pk_bf16(v1[0], v1[1]); w.w = cvt_pk_bf16(v1[2], v1[3]);
                    *(u32x4*)(rowp + bj * HALF) = w; } }
        }
    }
};
struct EpiBf16KV {
    static constexpr bool PERM = true, AFTER_DRAIN = false, OWN_ALIGN = false;
    bf16_t* O; int ldc; const float* kg; PG8_LAS float* hs;
    __device__ __forceinline__ void operator()(const f32x4 (&acc)[2][2][4][2], const Unit& u, int wr, int wc, int fr, int fq) const {
        const int row0 = u.pm * BM + wr * 64 + fr, col0 = u.pn * BM + wc * 32 + 8 * fq;
        const f32x4 g0 = *(const f32x4*)(kg + wc * 32 + 8 * fq), g1 = *(const f32x4*)(kg + wc * 32 + 8 * fq + 4);
#pragma unroll
        for (int ai = 0; ai < 2; ++ai)
#pragma unroll
            for (int m = 0; m < 4; ++m) { const f32x4 a = acc[ai][0][m][0], b = acc[ai][0][m][1];
                float s = ((a[0] * a[0] + a[1] * a[1]) + (a[2] * a[2] + a[3] * a[3])) + ((b[0] * b[0] + b[1] * b[1]) + (b[2] * b[2] + b[3] * b[3]));
                s += __shfl_xor(s, 16); s += __shfl_xor(s, 32);
                if (fq == 0) hs[(ai * HALF + wr * 64 + m * 16 + fr) * 4 + wc] = s; }
#pragma unroll
        for (int ai = 0; ai < 2; ++ai)
#pragma unroll
            for (int m = 0; m < 4; ++m) { bf16_t* rowp = O + (size_t)(row0 + ai * HALF + m * 16) * ldc + col0 + HALF;
                const f32x4 v0 = acc[ai][1][m][0], v1 = acc[ai][1][m][1];
                u32x4 w; w.x = cvt_pk_bf16(v0[0], v0[1]); w.y = cvt_pk_bf16(v0[2], v0[3]); w.z = cvt_pk_bf16(v1[0], v1[1]); w.w = cvt_pk_bf16(v1[2], v1[3]); *(u32x4*)rowp = w; }
        asm volatile("s_waitcnt lgkmcnt(0)" ::: "memory"); __builtin_amdgcn_s_barrier(); asm volatile("" ::: "memory");
#pragma unroll
        for (int ai = 0; ai < 2; ++ai)
#pragma unroll
            for (int m = 0; m < 4; ++m) { bf16_t* rowp = O + (size_t)(row0 + ai * HALF + m * 16) * ldc + col0;
                const f32x4 hp = *(const PG8_LAS f32x4*)(hs + (ai * HALF + wr * 64 + m * 16 + fr) * 4);
                const float hr = __builtin_amdgcn_rsqf(((hp[0] + hp[1]) + (hp[2] + hp[3])) * (1.f / 128.f) + 1e-6f);
                const f32x4 v0 = acc[ai][0][m][0] * hr * g0, v1 = acc[ai][0][m][1] * hr * g1;
                u32x4 w; w.x = cvt_pk_bf16(v0[0], v0[1]); w.y = cvt_pk_bf16(v0[2], v0[3]); w.z = cvt_pk_bf16(v1[0], v1[1]); w.w = cvt_pk_bf16(v1[2], v1[3]); *(u32x4*)rowp = w; }
    }
};
struct EpiBf16P {
    static constexpr bool PERM = true, AFTER_DRAIN = false, OWN_ALIGN = false;
    bf16_t* O; int ldc;
    __device__ __forceinline__ void operator()(const f32x4 (&acc)[2][2][4][2], const Unit& u, int wr, int wc, int fr, int fq) const {
        const int row0 = u.pm * BM + wr * 64 + fr, col0 = u.pn * BM + wc * 32 + 8 * fq;
#pragma unroll
        for (int ai = 0; ai < 2; ++ai)
#pragma unroll
            for (int m = 0; m < 4; ++m) { bf16_t* rowp = O + (size_t)(row0 + ai * HALF + m * 16) * ldc + col0;
#pragma unroll
                for (int bj = 0; bj < 2; ++bj) { const f32x4 v0 = acc[ai][bj][m][0], v1 = acc[ai][bj][m][1];
                    u32x4 w; w.x = cvt_pk_bf16(v0[0], v0[1]); w.y = cvt_pk_bf16(v0[2], v0[3]); w.z = cvt_pk_bf16(v1[0], v1[1]); w.w = cvt_pk_bf16(v1[2], v1[3]);
                    *(u32x4*)(rowp + bj * HALF) = w; } }
    }
};
template <class Epi, class Sched, bool ALIGN_EPI = false, bool SP2 = false>
__device__ __forceinline__ void gemm_phase(PG8_LAS unsigned char* lds, const Gemm g, const Sched& S, const Epi& E) {
    const int tid = threadIdx.x, wid = __builtin_amdgcn_readfirstlane(tid >> 6), lane = tid & 63, wr = wid >> 2, wc = wid & 3, fr = lane & 15, fq = lane >> 4;
    const int K = g.K, nt = K / BK;
    unsigned voffA[2], voffB[2];
#pragma unroll
    for (int i = 0; i < 2; ++i) { int R, C; stage_rc(tid * 16 + i * 8192, R, C); const int Rb = Epi::PERM ? ((R & ~31) + perm32(R & 31)) : R;
        voffA[i] = (unsigned)(R * g.lda + C) * 2u; voffB[i] = (unsigned)(Rb * K + C) * 2u; }
    const size_t kstep = (size_t)(BK * 2);
    const size_t hstepB = (size_t)HALF * K * 2, hstepA = (size_t)HALF * g.lda * 2;
    const size_t tstepA = 2 * hstepA, tstepB = 2 * hstepB;
    const unsigned ldsw = (unsigned)wid * 1024u;
    const int aoff = lds_byte(wr * 64 + fr, fq * 8), boff = lds_byte(wc * 32 + fr, fq * 8);
#define PG8_SA(b, h) (((b) * 2 + (h)) * HTB)
#define PG8_SB(b, h) ((4 + (b) * 2 + (h)) * HTB)
#define PG8_STAGE(bufoff, gbase, voff) do { _Pragma("unroll") for (int _i = 0; _i < 2; ++_i) \
        __builtin_amdgcn_global_load_lds((const unsigned*)((const char*)(gbase) + (voff)[_i]), (PG8_LAS unsigned*)(lds + (bufoff) + ldsw + _i * 8192), 16, 0, 0); } while (0)
#define PG8_LDA(dst, b, h) do { _Pragma("unroll") for (int m = 0; m < 4; ++m) _Pragma("unroll") for (int k = 0; k < 2; ++k) dst[m][k] = *(const PG8_LAS bf16x8*)(lds + PG8_SA(b, h) + aoff + m * 2048 + k * 1024); } while (0)
#define PG8_LDB(dst, b, h) do { _Pragma("unroll") for (int n = 0; n < 2; ++n) _Pragma("unroll") for (int k = 0; k < 2; ++k) dst[n][k] = *(const PG8_LAS bf16x8*)(lds + PG8_SB(b, h) + boff + n * 2048 + k * 1024); } while (0)
#define PG8_MMA(ai, bj, At, Bt) do { __builtin_amdgcn_s_setprio(1); _Pragma("unroll") for (int m = 0; m < 4; ++m) _Pragma("unroll") for (int n = 0; n < 2; ++n) _Pragma("unroll") for (int k = 0; k < 2; ++k) \
        acc[ai][bj][m][n] = __builtin_amdgcn_mfma_f32_16x16x32_bf16(Bt[n][k], At[m][k], acc[ai][bj][m][n], 0, 0, 0); __builtin_amdgcn_s_setprio(0); } while (0)
#define PG8_WAIT_V(n) asm volatile("s_waitcnt vmcnt(" #n ")" ::: "memory")
#define PG8_WAIT_L(n) asm volatile("s_waitcnt lgkmcnt(" #n ")" ::: "memory")
#define PG8_BAR __builtin_amdgcn_s_barrier()
#define PG8_SCHED __builtin_amdgcn_sched_barrier(0)
    Unit cur, nxt; int ui = 0;
    if (!S.next(0, cur)) return;
    f32x4 acc[2][2][4][2];
#pragma unroll
    for (int a = 0; a < 2; ++a)
#pragma unroll
        for (int b = 0; b < 2; ++b)
#pragma unroll
            for (int m = 0; m < 4; ++m)
#pragma unroll
                for (int n = 0; n < 2; ++n) acc[a][b][m][n] = (f32x4){0.f, 0.f, 0.f, 0.f};
    bf16x8 At[4][2], B0[2][2], B1[2][2];
    const char* cA = (const char*)g.A + (size_t)cur.pm * tstepA; const char* cB = (const char*)g.Bt + (size_t)cur.pn * tstepB;
    S.a_ready(cur);
    if constexpr (SP2) {
        PG8_STAGE(PG8_SB(0, 0), cB, voffB); PG8_STAGE(PG8_SB(0, 1), cB + hstepB, voffB); PG8_STAGE(PG8_SA(0, 0), cA, voffA); PG8_STAGE(PG8_SA(0, 1), cA + hstepA, voffA);
        if (wr == 1) PG8_BAR;
        PG8_WAIT_V(2); PG8_BAR;
        PG8_STAGE(PG8_SB(1, 0), cB + kstep, voffB); PG8_STAGE(PG8_SA(1, 0), cA + kstep, voffA); PG8_STAGE(PG8_SB(1, 1), cB + hstepB + kstep, voffB);
        PG8_WAIT_V(6); PG8_BAR;
    } else {
        PG8_STAGE(PG8_SB(0, 0), cB, voffB); PG8_STAGE(PG8_SA(0, 0), cA, voffA); PG8_STAGE(PG8_SB(0, 1), cB + hstepB, voffB); PG8_STAGE(PG8_SA(0, 1), cA + hstepA, voffA);
        if (wr == 1) PG8_BAR;
        PG8_WAIT_V(4); PG8_BAR;
        PG8_STAGE(PG8_SB(1, 0), cB + kstep, voffB); PG8_STAGE(PG8_SA(1, 0), cA + kstep, voffA); PG8_STAGE(PG8_SB(1, 1), cB + hstepB + kstep, voffB);
        PG8_WAIT_V(6); PG8_BAR;
    }
    for (;;) {
        const bool has_next = S.next(ui + 1, nxt);
        const char* nA = has_next ? (const char*)g.A + (size_t)nxt.pm * tstepA : cA; const char* nB = has_next ? (const char*)g.Bt + (size_t)nxt.pn * tstepB : cB;
        for (int t = 0; t < nt; t += 2) {
            const bool last = (t == nt - 2);
            const char* a1 = cA + (size_t)(t >> 1) * g.pairA + kstep;
            const char* a2 = last ? nA : cA + (size_t)((t >> 1) + 1) * g.pairA; const char* b2 = last ? nB : cB + (size_t)(t + 2) * kstep;
            const char* a3 = a2 + kstep; const char* b3 = b2 + kstep;
            if (last && has_next) S.a_ready(nxt);
            if constexpr (SP2) {
            PG8_LDB(B0, 0, 0); PG8_LDB(B1, 0, 1); PG8_SCHED; PG8_LDA(At, 0, 0); PG8_STAGE(PG8_SA(1, 1), a1 + hstepA, voffA);
            PG8_WAIT_V(8); PG8_WAIT_L(0); PG8_BAR; PG8_MMA(0, 0, At, B0); PG8_MMA(0, 1, At, B1); PG8_BAR; PG8_SCHED;
            PG8_LDA(At, 0, 1); PG8_STAGE(PG8_SB(0, 0), b2, voffB); PG8_STAGE(PG8_SB(0, 1), b2 + hstepB, voffB); PG8_STAGE(PG8_SA(0, 0), a2, voffA);
            PG8_WAIT_V(8); PG8_WAIT_L(0); PG8_BAR; PG8_MMA(1, 0, At, B0); PG8_MMA(1, 1, At, B1); PG8_BAR; PG8_SCHED;
            PG8_LDB(B0, 1, 0); PG8_LDB(B1, 1, 1); PG8_SCHED; PG8_LDA(At, 1, 0); PG8_STAGE(PG8_SA(0, 1), a2 + hstepA, voffA);
            PG8_WAIT_V(8); PG8_WAIT_L(0); PG8_BAR; PG8_MMA(0, 0, At, B0); PG8_MMA(0, 1, At, B1); PG8_BAR; PG8_SCHED;
            PG8_LDA(At, 1, 1); PG8_STAGE(PG8_SB(1, 0), b3, voffB); PG8_STAGE(PG8_SB(1, 1), b3 + hstepB, voffB); PG8_STAGE(PG8_SA(1, 0), a3, voffA);
            PG8_WAIT_V(8); PG8_WAIT_L(0); PG8_BAR; PG8_MMA(1, 0, At, B0); PG8_MMA(1, 1, At, B1); PG8_BAR; PG8_SCHED;
            } else {
            PG8_LDB(B0, 0, 0); PG8_SCHED; PG8_LDA(At, 0, 0); PG8_STAGE(PG8_SA(1, 1), a1 + hstepA, voffA);
            PG8_WAIT_L(8); PG8_BAR; PG8_WAIT_L(0); PG8_MMA(0, 0, At, B0); PG8_BAR; PG8_SCHED;
            PG8_LDB(B1, 0, 1); PG8_STAGE(PG8_SB(0, 0), b2, voffB);
            PG8_BAR; PG8_WAIT_L(0); PG8_MMA(0, 1, At, B1); PG8_BAR;
            PG8_LDA(At, 0, 1); PG8_STAGE(PG8_SA(0, 0), a2, voffA);
            PG8_BAR; PG8_WAIT_L(0); PG8_MMA(1, 0, At, B0); PG8_BAR; PG8_SCHED;
            PG8_STAGE(PG8_SB(0, 1), b2 + hstepB, voffB);
            PG8_WAIT_V(6); PG8_BAR; PG8_MMA(1, 1, At, B1); PG8_BAR;
            PG8_LDB(B0, 1, 0); PG8_SCHED; PG8_LDA(At, 1, 0); PG8_STAGE(PG8_SA(0, 1), a2 + hstepA, voffA);
            PG8_WAIT_L(8); PG8_BAR; PG8_WAIT_L(0); PG8_MMA(0, 0, At, B0); PG8_BAR; PG8_SCHED;
            PG8_LDB(B1, 1, 1); PG8_STAGE(PG8_SB(1, 0), b3, voffB);
            PG8_BAR; PG8_WAIT_L(0); PG8_MMA(0, 1, At, B1); PG8_BAR;
            PG8_LDA(At, 1, 1); PG8_STAGE(PG8_SA(1, 0), a3, voffA);
            PG8_BAR; PG8_WAIT_L(0); PG8_MMA(1, 0, At, B0); PG8_BAR; PG8_SCHED;
            PG8_STAGE(PG8_SB(1, 1), b3 + hstepB, voffB);
            PG8_WAIT_V(6); PG8_BAR; PG8_MMA(1, 1, At, B1); PG8_BAR;
            }
        }
        if constexpr (ALIGN_EPI && !Epi::OWN_ALIGN) { if (wr == 0) PG8_BAR; }
        if constexpr (!Epi::AFTER_DRAIN) { E(acc, cur, wr, wc, fr, fq); S.done(cur); }
        if (!has_next) break;
#pragma unroll
        for (int a = 0; a < 2; ++a)
#pragma unroll
            for (int b = 0; b < 2; ++b)
#pragma unroll
                for (int m = 0; m < 4; ++m)
#pragma unroll
                    for (int n = 0; n < 2; ++n) acc[a][b][m][n] = (f32x4){0.f, 0.f, 0.f, 0.f};
        cur = nxt; cA = nA; cB = nB; ++ui;
        if constexpr (ALIGN_EPI) { if (wr == 1) PG8_BAR; }
    }
    PG8_WAIT_V(0);
    if constexpr (!ALIGN_EPI) { if (wr == 0) PG8_BAR; }
    PG8_BAR;
    if constexpr (Epi::AFTER_DRAIN) { E.fused(acc, cur, wr, wc, fr, fq, lds, wid, lane); S.done(cur); }
#undef PG8_SA
#undef PG8_SB
#undef PG8_STAGE
#undef PG8_LDA
#undef PG8_LDB
#undef PG8_MMA
#undef PG8_WAIT_V
#undef PG8_WAIT_L
#undef PG8_BAR
#undef PG8_SCHED
}
}

namespace attn {
using bf16x8 = __attribute__((ext_vector_type(8))) short;
using s16x4  = __attribute__((ext_vector_type(4))) short;
using f32x16 = __attribute__((ext_vector_type(16))) float;
using u32x4  = __attribute__((ext_vector_type(4))) unsigned;
using f32x4  = __attribute__((ext_vector_type(4))) float;
constexpr int NW = 8, QBLK = 32, KVBLK = 64;
constexpr float THR = 8.f;
#define SBAR() __builtin_amdgcn_sched_barrier(0)
__device__ __forceinline__ int crow(int r, int hi) { return (r & 3) + 8 * (r >> 2) + 4 * hi; }
__device__ __forceinline__ unsigned cvtpk(float lo, float hi) { unsigned r; asm volatile("v_cvt_pk_bf16_f32 %0, %1, %2\n\ts_nop 1" : "=v"(r) : "v"(lo), "v"(hi)); return r; }
template <bool VIS> __device__ __forceinline__ unsigned cvtpk_t(float lo, float hi) { if constexpr (VIS) return ::pk2c(lo, hi); else return cvtpk(lo, hi); }

template <int DQK> struct Cfg {
    static constexpr int KROW = DQK * 2;
    static constexpr int SHM_K = KVBLK * KROW, SHM_V = KVBLK * 128 * 2;
    static constexpr int NQR = DQK == 128 ? 8 : 6;
    static constexpr int QX_WAVE = (DQK / 16 - NQR) * 1024;
    static constexpr int SHM = 2 * SHM_V + 2 * SHM_K + NW * 64 * 4 + NW * QX_WAVE;
    static constexpr float SCALE = DQK == 128 ? 0.088388347648318440f : 0.072168783648703220f;
    static constexpr float C = SCALE * 1.4426950408889634f;
};
template <int DQK> __device__ __forceinline__ int kswz(int row, int colB) { return row * (DQK * 2) + (colB ^ ((row & 7) << 4)); }

template <int DQK, bool NOMAX = false> __device__ __forceinline__ void partialSM(f32x16& p0, f32x16& p1, float& m_reg, float& mn, float& alpha, float shiftC = 0.f) {
  constexpr float C = Cfg<DQK>::C, SCALE = Cfg<DQK>::SCALE;
  if constexpr (NOMAX) {
    alpha = 1.f; mn = 0.f; const float mnC0 = -shiftC;
#pragma unroll
    for (int r = 0; r < 16; ++r) p0[r] = fmaf(p0[r], C, mnC0);
#pragma unroll
    for (int r = 0; r < 16; ++r) p1[r] = fmaf(p1[r], C, mnC0);
#pragma unroll
    for (int r = 0; r < 16; ++r) p0[r] = __builtin_amdgcn_exp2f(p0[r]);
    return;
  }
  float pmax = p0[0];
#pragma unroll
  for (int r = 1; r < 16; ++r) pmax = fmaxf(pmax, p0[r]);
#pragma unroll
  for (int r = 0; r < 16; ++r) pmax = fmaxf(pmax, p1[r]);
  { auto rr = __builtin_amdgcn_permlane32_swap(__float_as_uint(pmax), __float_as_uint(pmax), false, false);
    pmax = fmaxf(__uint_as_float(rr[0]), __uint_as_float(rr[1])); }
  if (__builtin_expect(__all(pmax - m_reg <= THR / SCALE), 1)) { mn = m_reg; alpha = 1.f; }
  else { mn = fmaxf(m_reg, pmax); alpha = __builtin_amdgcn_exp2f((m_reg - mn) * C); m_reg = mn; }
  float mnC = -mn * C;
#pragma unroll
  for (int r = 0; r < 16; ++r) p0[r] = fmaf(p0[r], C, mnC);
#pragma unroll
  for (int r = 0; r < 16; ++r) p1[r] = fmaf(p1[r], C, mnC);
#pragma unroll
  for (int r = 0; r < 16; ++r) p0[r] = __builtin_amdgcn_exp2f(p0[r]);
}
template <bool VIS> __device__ __forceinline__ void finishSM(f32x16& p0, f32x16& p1, float alpha, float& l_reg, bf16x8& pa0, bf16x8& pa1, bf16x8& pa2, bf16x8& pa3) {
#pragma unroll
  for (int r = 0; r < 16; ++r) p1[r] = __builtin_amdgcn_exp2f(p1[r]);
  float ps = 0;
#pragma unroll
  for (int r = 0; r < 16; ++r) ps += p0[r];
#pragma unroll
  for (int r = 0; r < 16; ++r) ps += p1[r];
  { auto rr = __builtin_amdgcn_permlane32_swap(__float_as_uint(ps), __float_as_uint(ps), false, false);
    ps = __uint_as_float(rr[0]) + __uint_as_float(rr[1]); }
  l_reg = l_reg * alpha + ps;
#define PK4(P, BASE, OUT) do { unsigned a0 = cvtpk_t<VIS>(P[BASE + 0], P[BASE + 1]), a1 = cvtpk_t<VIS>(P[BASE + 2], P[BASE + 3]);   \
    unsigned b0 = cvtpk_t<VIS>(P[BASE + 4], P[BASE + 5]), b1 = cvtpk_t<VIS>(P[BASE + 6], P[BASE + 7]);                              \
    auto r0 = __builtin_amdgcn_permlane32_swap(a0, b0, false, false); auto r1 = __builtin_amdgcn_permlane32_swap(a1, b1, false, false); \
    u32x4 w = {r0[0], r1[0], r0[1], r1[1]}; OUT = *reinterpret_cast<bf16x8*>(&w); } while (0)
  PK4(p0, 0, pa0); PK4(p0, 8, pa1); PK4(p1, 0, pa2); PK4(p1, 8, pa3);
#undef PK4
}
template <int DQK, int NQR> __device__ __forceinline__ void qkt(f32x16& p0, f32x16& p1, const char* Ks, const bf16x8* qr, const char* qx, int r32, int hi) {
  p0 = f32x16{}; p1 = f32x16{};
#pragma unroll
  for (int d0 = 0; d0 < DQK / 16; ++d0) { const int cb = (d0 * 16 + hi * 8) * 2;
    bf16x8 b0 = *reinterpret_cast<const bf16x8*>(Ks + kswz<DQK>(r32, cb));
    bf16x8 b1 = *reinterpret_cast<const bf16x8*>(Ks + kswz<DQK>(32 + r32, cb));
    bf16x8 q; if (d0 < NQR) q = qr[d0]; else q = *reinterpret_cast<const bf16x8*>(qx + (d0 - NQR) * 1024);
    p0 = __builtin_amdgcn_mfma_f32_32x32x16_bf16(b0, q, p0, 0, 0, 0);
    p1 = __builtin_amdgcn_mfma_f32_32x32x16_bf16(b1, q, p1, 0, 0, 0);
    if (DQK > 128 && (d0 & 3) == 3 && d0 + 1 < DQK / 16) SBAR(); }
}
__device__ __forceinline__ int v_st(int k, int c) { const int kk = (k & ~0xC) | ((k & 4) << 1) | ((k & 8) >> 1); return ((kk >> 3) * 4 + (c >> 5)) * 512 + ((kk & 7) * 32 + (c & 31)) * 2; }
__device__ __forceinline__ int v_rd_base(int lane) { return ((lane & 3) << 3) | (((lane >> 2) & 3) << 6) | (((lane >> 4) & 1) << 5) | (((lane >> 5) & 1) << 8); }
constexpr int v_rd_off(int d0, int ks, int half) { return d0 * 512 + ks * 4096 + half * 2048; }
template <int OFF> __device__ __forceinline__ s16x4 tr_read(int vb) {
  s16x4 r; asm volatile("ds_read_b64_tr_b16 %0, %1 offset:%2" : "=&v"(r) : "v"(vb), "i"(OFF) : "memory"); return r;
}
template <int D0> __device__ __forceinline__ void pv_one(f32x16& od, int vb, bf16x8 pa0, bf16x8 pa1, bf16x8 pa2, bf16x8 pa3) {
  const s16x4 l0 = tr_read<v_rd_off(D0, 0, 0)>(vb), h0 = tr_read<v_rd_off(D0, 0, 1)>(vb), l1 = tr_read<v_rd_off(D0, 1, 0)>(vb), h1 = tr_read<v_rd_off(D0, 1, 1)>(vb);
  const s16x4 l2 = tr_read<v_rd_off(D0, 2, 0)>(vb), h2 = tr_read<v_rd_off(D0, 2, 1)>(vb), l3 = tr_read<v_rd_off(D0, 3, 0)>(vb), h3 = tr_read<v_rd_off(D0, 3, 1)>(vb);
  asm volatile("s_waitcnt lgkmcnt(0)" ::: "memory"); SBAR();
#define PK(L, H) (bf16x8){L[0], L[1], L[2], L[3], H[0], H[1], H[2], H[3]}
  od = __builtin_amdgcn_mfma_f32_32x32x16_bf16(pa0, PK(l0, h0), od, 0, 0, 0);
  od = __builtin_amdgcn_mfma_f32_32x32x16_bf16(pa1, PK(l1, h1), od, 0, 0, 0);
  od = __builtin_amdgcn_mfma_f32_32x32x16_bf16(pa2, PK(l2, h2), od, 0, 0, 0);
  od = __builtin_amdgcn_mfma_f32_32x32x16_bf16(pa3, PK(l3, h3), od, 0, 0, 0);
#undef PK
}
__device__ __forceinline__ void pv_d0(f32x16* o, int vb, bf16x8 pa0, bf16x8 pa1, bf16x8 pa2, bf16x8 pa3) {
  pv_one<0>(o[0], vb, pa0, pa1, pa2, pa3); pv_one<1>(o[1], vb, pa0, pa1, pa2, pa3); pv_one<2>(o[2], vb, pa0, pa1, pa2, pa3); pv_one<3>(o[3], vb, pa0, pa1, pa2, pa3);
}

template <int DQK, int LDQ, int LDK, int LDKR, int LDV, int LDO, int SDEPTH, bool QNORM = false, bool NOMAX = false>
__device__ __forceinline__ void attn_dense_body(const bf16* __restrict__ Qb, const bf16* __restrict__ Kh, const bf16* __restrict__ KRh, const bf16* __restrict__ Vh,
                                                bf16* __restrict__ Ob, int seq, char* lds, const float* qgain = nullptr, const float* ropetab = nullptr, int tq0 = 0, float shiftC = 0.f) {
  constexpr int SHM_V = Cfg<DQK>::SHM_V, SHM_K = Cfg<DQK>::SHM_K; constexpr float SCALE = Cfg<DQK>::SCALE;
  constexpr bool ROPE = (DQK == 192);
  const int tid = threadIdx.x, wid = tid >> 6, lane = tid & 63, r32 = lane & 31, hi = lane >> 5;
  char* V_lds = lds; char* K_lds = lds + 2 * SHM_V;
  float* ws = (float*)(lds + 2 * SHM_V + 2 * SHM_K) + wid * 64; float* li_l = ws; float* al_l = ws + 32;
  constexpr int NQR = Cfg<DQK>::NQR;
  float m_reg = -1e30f, l_reg = 0; f32x16 o[4] = {}; bf16x8 qr[NQR];
  const bf16* Qw = Qb + (long)(wid * QBLK + r32) * LDQ + hi * 8;
  char* qx = lds + 2 * SHM_V + 2 * SHM_K + NW * 64 * 4 + wid * Cfg<DQK>::QX_WAVE + lane * 16;
  if constexpr (!QNORM) {
#pragma unroll
    for (int d0 = 0; d0 < NQR; ++d0) qr[d0] = *reinterpret_cast<const bf16x8*>(Qw + d0 * 16);
#pragma unroll
    for (int d0 = NQR; d0 < DQK / 16; ++d0) *reinterpret_cast<bf16x8*>(qx + (d0 - NQR) * 1024) = *reinterpret_cast<const bf16x8*>(Qw + d0 * 16);
  } else {
    float ss = 0.f;
#pragma unroll
    for (int d0 = 0; d0 < DQK / 16; ++d0) { const u32x4 rw = *reinterpret_cast<const u32x4*>(Qw + d0 * 16);
#pragma unroll
      for (int w = 0; w < 4; ++w) { const float a = __uint_as_float(rw[w] << 16), b = __uint_as_float(rw[w] & 0xffff0000u); ss += a * a + b * b; } }
    asm volatile("" ::: "memory");
    { auto rr = __builtin_amdgcn_permlane32_swap(__float_as_uint(ss), __float_as_uint(ss), false, false); ss = __uint_as_float(rr[0]) + __uint_as_float(rr[1]); }
    const float rsn = __builtin_amdgcn_rsqf(ss * (1.f / DQK) + 1e-6f);
    const int tpos = tq0 + wid * QBLK + r32, eri = tpos >> 6, eci = 128 + (tpos & 63);
#pragma unroll
    for (int d0 = 0; d0 < DQK / 16; ++d0) {
      const f32x4 g0 = *reinterpret_cast<const f32x4*>(qgain + d0 * 16 + hi * 8), g1 = *reinterpret_cast<const f32x4*>(qgain + d0 * 16 + hi * 8 + 4);
      const u32x4 rw = *reinterpret_cast<const u32x4*>(Qw + d0 * 16);
      float x[8];
#pragma unroll
      for (int w = 0; w < 4; ++w) { x[2 * w] = __uint_as_float(rw[w] << 16) * rsn; x[2 * w + 1] = __uint_as_float(rw[w] & 0xffff0000u) * rsn; }
      x[0] *= g0[0]; x[1] *= g0[1]; x[2] *= g0[2]; x[3] *= g0[3]; x[4] *= g1[0]; x[5] *= g1[1]; x[6] *= g1[2]; x[7] *= g1[3];
      if (d0 >= 8) {
        const float* rp = ropetab + (size_t)((d0 < 10 ? eri : eci) * 16 + ((d0 - 8) & 1) * 8 + hi * 4) * 2;
        const f32x4 c0 = *reinterpret_cast<const f32x4*>(rp), c1 = *reinterpret_cast<const f32x4*>(rp + 4);
        const float a0 = x[0] * c0[0] - x[1] * c0[1], a1 = x[0] * c0[1] + x[1] * c0[0], a2 = x[2] * c0[2] - x[3] * c0[3], a3 = x[2] * c0[3] + x[3] * c0[2];
        const float a4 = x[4] * c1[0] - x[5] * c1[1], a5 = x[4] * c1[1] + x[5] * c1[0], a6 = x[6] * c1[2] - x[7] * c1[3], a7 = x[6] * c1[3] + x[7] * c1[2];
        x[0] = a0; x[1] = a1; x[2] = a2; x[3] = a3; x[4] = a4; x[5] = a5; x[6] = a6; x[7] = a7;
      }
      u32x4 w4 = {cvtpk(x[0], x[1]), cvtpk(x[2], x[3]), cvtpk(x[4], x[5]), cvtpk(x[6], x[7])};
      if (d0 < NQR) qr[d0 < NQR ? d0 : 0] = *reinterpret_cast<bf16x8*>(&w4); else *reinterpret_cast<bf16x8*>(qx + (d0 - NQR) * 1024) = *reinterpret_cast<bf16x8*>(&w4);
    }
  }
  const int sr = tid >> 4, sc = (tid & 15) * 8, vst0 = v_st(sr, sc), vst1 = v_st(32 + sr, sc);
  const int rr = tid >> 3, rc = (tid & 7) * 8;
  const int vb0 = (int)(uintptr_t)V_lds + v_rd_base(lane);
  struct { bf16x8 vs0, vs1, ks0, ks1, kr; } sr_[SDEPTH];
  const unsigned offV = (unsigned)(sr * LDV + sc) * 2u, offK = (unsigned)(sr * LDK + sc) * 2u, offR = (unsigned)(rr * LDKR + rc) * 2u;
#define SLOAD(i, k0) do { const char* vb_ = (const char*)Vh + (size_t)(k0) * (LDV * 2); const char* kb_ = (const char*)Kh + (size_t)(k0) * (LDK * 2); \
    sr_[i].vs0 = *reinterpret_cast<const bf16x8*>(vb_ + offV); sr_[i].vs1 = *reinterpret_cast<const bf16x8*>(vb_ + (size_t)32 * LDV * 2 + offV); \
    sr_[i].ks0 = *reinterpret_cast<const bf16x8*>(kb_ + offK); sr_[i].ks1 = *reinterpret_cast<const bf16x8*>(kb_ + (size_t)32 * LDK * 2 + offK); \
    if constexpr (ROPE) sr_[i].kr = *reinterpret_cast<const bf16x8*>((const char*)KRh + (size_t)(k0) * (LDKR * 2) + offR); } while (0)
#define SWRITE(b, i) do { *(bf16x8*)(V_lds + (b) * SHM_V + vst0) = sr_[i].vs0;          \
    *(bf16x8*)(V_lds + (b) * SHM_V + vst1) = sr_[i].vs1; const int kc = sc * 2;               \
    *(bf16x8*)(K_lds + (b) * SHM_K + kswz<DQK>(sr, kc)) = sr_[i].ks0;                       \
    *(bf16x8*)(K_lds + (b) * SHM_K + kswz<DQK>(32 + sr, kc)) = sr_[i].ks1;                   \
    if constexpr (ROPE) *(bf16x8*)(K_lds + (b) * SHM_K + kswz<DQK>(rr, 256 + rc * 2)) = sr_[i].kr; } while (0)
#define SWAIT() do { if constexpr (SDEPTH == 2) { if constexpr (ROPE) asm volatile("s_waitcnt vmcnt(5)" ::: "memory"); else asm volatile("s_waitcnt vmcnt(4)" ::: "memory"); } else asm volatile("s_waitcnt vmcnt(0)" ::: "memory"); } while (0)
#define RESC(a) do { if constexpr (!NOMAX) if (__any((a) < 1.f)) { if (hi == 0) al_l[r32] = (a); asm volatile("s_waitcnt lgkmcnt(0)" ::: "memory"); \
    _Pragma("unroll") for (int d = 0; d < 4; ++d) _Pragma("unroll") for (int r = 0; r < 16; ++r) o[d][r] *= al_l[crow(r, hi)]; } } while (0)
  f32x16 pA0, pA1, pB0, pB1; float mnA, mnB, alA, alB; bf16x8 pa0, pa1, pa2, pa3; const int NT = seq / KVBLK;
  constexpr int SE = 0, SO = SDEPTH - 1;
  SLOAD(SE, 0); asm volatile("s_waitcnt vmcnt(0)" ::: "memory"); SWRITE(0, SE); __syncthreads();
  qkt<DQK, NQR>(pA0, pA1, K_lds, qr, qx, r32, hi); partialSM<DQK, NOMAX>(pA0, pA1, m_reg, mnA, alA, shiftC);
  SLOAD(SO, KVBLK); if constexpr (SDEPTH == 2) { if (2 < NT) SLOAD(SE, 2 * KVBLK); }
  SWAIT(); SWRITE(1, SO); __syncthreads();
  for (int j = 1; j + 1 < NT; j += 2) {
    SBAR(); qkt<DQK, NQR>(pB0, pB1, K_lds + SHM_K, qr, qx, r32, hi);
    finishSM<true>(pA0, pA1, alA, l_reg, pa0, pa1, pa2, pa3); SBAR();
    SLOAD(SO, (j + SDEPTH) * KVBLK); SBAR();
    pv_d0(o, vb0, pa0, pa1, pa2, pa3); partialSM<DQK, NOMAX>(pB0, pB1, m_reg, mnB, alB, shiftC);
    __syncthreads(); SWAIT(); SWRITE(0, SE);
    RESC(alB); __syncthreads();
    SBAR(); qkt<DQK, NQR>(pA0, pA1, K_lds, qr, qx, r32, hi);
    finishSM<true>(pB0, pB1, alB, l_reg, pa0, pa1, pa2, pa3); SBAR();
    if (SDEPTH == 1 || j + 3 < NT) SLOAD(SE, (j + 1 + SDEPTH) * KVBLK); SBAR();
    pv_d0(o, vb0 + SHM_V, pa0, pa1, pa2, pa3); partialSM<DQK, NOMAX>(pA0, pA1, m_reg, mnA, alA, shiftC);
    __syncthreads(); SWAIT(); SWRITE(1, SO);
    RESC(alA); __syncthreads();
  }
  SBAR(); qkt<DQK, NQR>(pB0, pB1, K_lds + SHM_K, qr, qx, r32, hi);
  finishSM<true>(pA0, pA1, alA, l_reg, pa0, pa1, pa2, pa3); SBAR();
  pv_d0(o, vb0, pa0, pa1, pa2, pa3); partialSM<DQK, NOMAX>(pB0, pB1, m_reg, mnB, alB, shiftC);
  __syncthreads(); RESC(alB);
  finishSM<true>(pB0, pB1, alB, l_reg, pa0, pa1, pa2, pa3); SBAR();
  pv_d0(o, vb0 + SHM_V, pa0, pa1, pa2, pa3);
  { int w2 = tid; asm volatile("" : "+v"(w2)); li_l = (float*)(lds + 2 * SHM_V + 2 * SHM_K) + (w2 >> 6) * 64; }
  if (hi == 0) li_l[r32] = l_reg; asm volatile("s_waitcnt lgkmcnt(0)" ::: "memory");
  float rli[16];
#pragma unroll
  for (int r = 0; r < 16; ++r) rli[r] = __builtin_amdgcn_rcpf(li_l[crow(r, hi)]);
  bf16* Ow = Ob + (long)(wid * QBLK) * LDO;
#pragma unroll
  for (int r = 0; r < 16; ++r) { const int orow = crow(r, hi);
#pragma unroll
    for (int d0 = 0; d0 < 4; ++d0) Ow[(long)orow * LDO + d0 * 32 + r32] = (bf16)(cvtpk(o[d0][r] * rli[r], 0.f) & 0xffffu); }
  __syncthreads();
#undef SLOAD
#undef SWRITE
#undef SWAIT
#undef RESC
}
}
#define XB_TMO      128
#define XB_XCNT(j)  (256  + 64 * (j))
#define XB_XSUB(j)  (1280 + 64 * (j))
#define XB_XGEN(j)  (2304 + 64 * (j))
#define XB_TOP      3328
#define XB_TOPGEN   3392
#define XCD_BAR_WORDS 3456
#define XB_SPIN_CAP (1u << 18)

__device__ __forceinline__ unsigned xb_ld(unsigned* p)              { return __hip_atomic_load(p, __ATOMIC_RELAXED, __HIP_MEMORY_SCOPE_AGENT); }
__device__ __forceinline__ unsigned xb_add(unsigned* p, unsigned v) { return __hip_atomic_fetch_add(p, v, __ATOMIC_RELAXED, __HIP_MEMORY_SCOPE_AGENT); }
__device__ __forceinline__ unsigned xb_xcc_id() { return (unsigned)__builtin_amdgcn_s_getreg((3 << 11) | 20) & 0xFu; }
#define XB_SPIN(cond, bar) do { unsigned _sp = 0; while (cond) { __builtin_amdgcn_s_sleep(1); \
    if ((++_sp & 255u) == 0u) { if (xb_ld(&(bar)[XB_TMO])) break; if (_sp > XB_SPIN_CAP) { atomicAdd(&(bar)[XB_TMO], 1u); break; } } } } while (0)

struct XcdBarrier {
    unsigned* bar; unsigned x;
    volatile LAS unsigned* st;
};

__device__ __forceinline__ XcdBarrier xcd_barrier_post(unsigned* bar, volatile LAS unsigned* st) {
    XcdBarrier b; b.bar = bar; b.x = xb_xcc_id(); b.st = st;
    if (threadIdx.x == 0) (void)xb_add(&bar[XB_XCNT(b.x)], 1u);
    return b;
}
__device__ __forceinline__ void xcd_barrier_complete(unsigned* bar, unsigned x, unsigned& nloc, unsigned& nx) {
    const unsigned G = gridDim.x * gridDim.y * gridDim.z;
    unsigned sum, cnt, mine, sp = 0u;
    for (;;) {
        sum = 0u; cnt = 0u; mine = 0u;
#pragma unroll
        for (unsigned j = 0; j < 16; ++j) { const unsigned c = xb_ld(&bar[XB_XCNT(j)]); sum += c; cnt += (c > 0u) ? 1u : 0u; mine = (j == x) ? c : mine; }
        if (sum == G) break;
        __builtin_amdgcn_s_sleep(1);
        if ((++sp & 255u) == 0u) { if (xb_ld(&bar[XB_TMO])) break; if (sp > XB_SPIN_CAP) { atomicAdd(&bar[XB_TMO], 1u); break; } }
    }
    nloc = mine > 0u ? mine : 1u; nx = cnt > 0u ? cnt : 1u;
}

__device__ __forceinline__ void xcd_barrier(const XcdBarrier& b) {
    asm volatile("s_waitcnt vmcnt(0)" ::: "memory");
    __syncthreads();
    if (threadIdx.x == 0) {
        unsigned* bar = b.bar; asm volatile("" : "+s"(bar));
        __builtin_amdgcn_s_waitcnt(0);
        unsigned nloc = b.st[0], nx = b.st[1];
        if (nloc == 0u) { xcd_barrier_complete(bar, b.x, nloc, nx); b.st[0] = nloc; b.st[1] = nx; }
        const unsigned old = xb_add(&bar[XB_XSUB(b.x)], 1u);
        const unsigned gen = old / nloc;
        if (old + 1u == (gen + 1u) * nloc) {
            __builtin_amdgcn_fence(__ATOMIC_RELEASE, "agent");
            asm volatile("s_waitcnt vmcnt(0)" ::: "memory");
            const unsigned og = xb_add(&bar[XB_TOP], 1u);
            const unsigned tg = og / nx;
            if (og + 1u == (tg + 1u) * nx) xb_add(&bar[XB_TOPGEN], 1u);
            else XB_SPIN(xb_ld(&bar[XB_TOPGEN]) == tg, bar);
            __builtin_amdgcn_fence(__ATOMIC_ACQUIRE, "agent");
            xb_add(&bar[XB_XGEN(b.x)], 1u);
            asm volatile("s_waitcnt vmcnt(0)" ::: "memory");
        } else {
            XB_SPIN(xb_ld(&bar[XB_XGEN(b.x)]) == gen, bar);
            __builtin_amdgcn_fence(__ATOMIC_ACQUIRE, "agent");
            asm volatile("s_waitcnt vmcnt(0)" ::: "memory");
        }
    }
    __syncthreads();
}

struct Args { const float* in[N_IN]; float* out; unsigned char* ws; int ph_lo, ph_hi, one_launch, pad; };
struct Frame {
    LAS unsigned char* lds;
    int tid, lane, wave, vcu, G;
    const float* const* in;
    float* out; unsigned char* ws;
    float* mod; const f32x2* ropeA; const f32x2* ropeC;
    bf16* H;
};
constexpr int NWAVES = 8;

__device__ __forceinline__ void transpose_item(const float* W, int ldw, int K, int N, bf16* WT, int row_off, float scale, LAS float* scr, int item, int lane) {
    const int nblk = N / 32, kb = item / nblk, nb = item % nblk, k0 = 64 * kb, n0 = 32 * nb;
#pragma unroll 8
    for (int i = 0; i < 32; ++i) { const int kk = 2 * i + (lane >> 5); scr[kk * 33 + (lane & 31)] = W[(size_t)(k0 + kk) * ldw + n0 + (lane & 31)] * scale; }
    LDS_WAIT(); asm volatile("" ::: "memory");
    const int c = lane & 7;
#pragma unroll
    for (int j = 0; j < 4; ++j) { const int n = (lane >> 3) + 8 * j; const LAS float* s = scr + (8 * c) * 33 + n;
        v4u o; o.x = pk2(s[0 * 33], s[1 * 33]); o.y = pk2(s[2 * 33], s[3 * 33]); o.z = pk2(s[4 * 33], s[5 * 33]); o.w = pk2(s[6 * 33], s[7 * 33]);
        *(GAS v4u*)(WT + (size_t)(row_off + n0 + n) * K + k0 + 8 * c) = o; }
    LDS_WAIT(); asm volatile("" ::: "memory");
}
struct ItemSrc { unsigned* head; int cur, step; };
__device__ __forceinline__ void item_next(ItemSrc& S) {
    if (S.head) { unsigned v = 0; if ((threadIdx.x & 63) == 0) v = __hip_atomic_fetch_add(S.head, 1u, __ATOMIC_RELAXED, __HIP_MEMORY_SCOPE_AGENT); S.cur = (int)__builtin_amdgcn_readfirstlane(v); }
    else S.cur += S.step;
}
__device__ __forceinline__ int transpose_matrix(Frame& F, ItemSrc& S, int base, const float* W, int ldw, int K, int N, bf16* WT, int row_off, float scale) {
    LAS float* scr = (LAS float*)(F.lds + F.wave * 16384);
    const int nit = (K / 64) * (N / 32), nb = (nit + 7) / 8;
    while (S.cur < base + nb) { const int i0 = (S.cur - base) * 8, i1 = i0 + 8 < nit ? i0 + 8 : nit;
        for (int it = i0; it < i1; ++it) transpose_item(W, ldw, K, N, WT, row_off, scale, scr, it, F.lane);
        item_next(S); }
    return base + nb;
}
__device__ __forceinline__ void zero_rows(Frame& F, bf16* WT, int row0, int nrows, int K) {
    const size_t n16 = (size_t)nrows * K / 8; GAS v4u* p = (GAS v4u*)(WT + (size_t)row0 * K);
    for (size_t i = (size_t)(F.vcu * NWAVES + F.wave) * 64 + F.lane; i < n16; i += (size_t)F.G * NWAVES * 64) p[i] = (v4u){0u, 0u, 0u, 0u};
}
__device__ __forceinline__ void prep_weights(Frame& F, int layer, unsigned* head) {
    const int kind = layer % 3, j = layer / 3;
    unsigned char* wr = F.ws + ((layer & 1) ? WS_WB : WS_W);
    bf16* w1t = (bf16*)wr; bf16* w2t = (bf16*)(wr + 32 * MiB); bf16* wmix = (bf16*)(wr + 64 * MiB); bf16* wot = (bf16*)(wr + 90 * MiB);
    if (kind == 1) {
        const float* g1 = F.in[I_GLA_WG1];
        for (int i = (F.vcu * NWAVES + F.wave) * 64 + F.lane; i < 2 * 16 * D; i += F.G * NWAVES * 64) { const int k = i % D, nr = i / D, n = nr >> 4, r = nr & 15;
            wmix[(size_t)(6144 + nr) * D + k] = (bf16)f2bf(g1[((size_t)n * D + k) * 16 + r]); }
        zero_rows(F, wmix, 6176, 224, D);
    } else if (kind == 2) zero_rows(F, wmix, 832, 192, D);
    ItemSrc S; S.head = head; S.step = F.G * NWAVES; S.cur = F.vcu * NWAVES + F.wave;
    if (head) item_next(S);
    int b = 0;
    b = transpose_matrix(F, S, b, F.in[I_W1] + (size_t)layer * D * FF, FF, D, FF, w1t, 0, 1.f);
    b = transpose_matrix(F, S, b, F.in[I_W2] + (size_t)layer * FF * D, D, FF, D, w2t, 0, 1.f);
    if (kind == 0) {
        b = transpose_matrix(F, S, b, F.in[I_GQA_WQKV] + (size_t)j * D * 3072, 3072, D, 3072, wmix, 0, 1.f);
        b = transpose_matrix(F, S, b, F.in[I_GQA_WO] + (size_t)j * D * D, D, D, D, wot, 0, 1.f);
    } else if (kind == 1) {
        const float* win = F.in[I_GLA_WIN];
        b = transpose_matrix(F, S, b, win, 6144, D, 1024, wmix, 0, 0.0625f);
        b = transpose_matrix(F, S, b, win + 1024, 6144, D, 5120, wmix, 1024, 1.f);
        b = transpose_matrix(F, S, b, F.in[I_GLA_WO], D, D, D, wot, 0, 1.f);
    } else {
        b = transpose_matrix(F, S, b, F.in[I_MLA_WDOWN], 832, D, 832, wmix, 0, 1.f);
        b = transpose_matrix(F, S, b, F.in[I_MLA_WUQ], 3072, 512, 3072, wmix + (size_t)4 * MiB / 2, 0, 1.f);
        b = transpose_matrix(F, S, b, F.in[I_MLA_WUKV], 4096, 256, 4096, wmix + (size_t)8 * MiB / 2, 0, 1.f);
        b = transpose_matrix(F, S, b, F.in[I_MLA_WO], D, D, D, wot, 0, 1.f);
    }
    (void)b;
}
__device__ __forceinline__ void ada_phase(Frame& F) {
    LAS float* cond = (LAS float*)(F.lds);
    float* modp = (float*)(F.ws + WS_MODP);
    const float* cp = F.in[I_CP]; const float* cs = F.in[I_CS]; const float* aw = F.in[I_ADAW];
    for (int item = F.vcu; item < 4 * 24 * 4; item += F.G) {
        const int kq = item & 3, cg = (item >> 2) % 24, l = item / 96;
        __syncthreads();
        for (int i = F.tid; i < 512 * NSEQ; i += 512) { const int k = i / NSEQ, s = i % NSEQ; const float c = s < 16 ? cp[s * D + kq * 512 + k] : cs[(s - 16) * D + kq * 512 + k];
            cond[i] = c / (1.f + __expf(-c)); }
        __syncthreads();
        const int col = cg * 512 + F.wave * 64 + F.lane;
        const float* wp = aw + ((size_t)l * D + kq * 512) * 12288 + col;
        float acc[NSEQ];
#pragma unroll
        for (int s = 0; s < NSEQ; ++s) acc[s] = 0.f;
        for (int k0 = 0; k0 < 512; k0 += 8) {
            float wv[8];
#pragma unroll
            for (int u = 0; u < 8; ++u) wv[u] = wp[(size_t)(k0 + u) * 12288];
#pragma unroll
            for (int u = 0; u < 8; ++u) { const LAS f32x4* cr = (const LAS f32x4*)(cond + (k0 + u) * NSEQ);
#pragma unroll
                for (int q = 0; q < 5; ++q) { const f32x4 cv = cr[q]; acc[4 * q] += cv.x * wv[u]; acc[4 * q + 1] += cv.y * wv[u]; acc[4 * q + 2] += cv.z * wv[u]; acc[4 * q + 3] += cv.w * wv[u]; } }
        }
#pragma unroll
        for (int s = 0; s < NSEQ; ++s) modp[(((size_t)kq * DEPTH + l) * NSEQ + s) * 12288 + col] = acc[s];
    }
    __syncthreads();
}
__device__ __forceinline__ void rope_tables(Frame& F) {
    f32x2* ra = (f32x2*)(F.ws + WS_ROPE); f32x2* rc = ra + 192 * 32;
    for (int i = (F.vcu * NWAVES + F.wave) * 64 + F.lane; i < 192 * 48; i += F.G * NWAVES * 64) {
        const int e = i / 48, f = i % 48; const double idx = (double)(e < 128 ? e : e - 128);
        const double inv = f < 32 ? pow(10000.0, -(double)f / 32.0) : pow(10000.0, -(double)(f - 32) / 16.0);
        const double a = idx * inv; const f32x2 v = {(float)cos(a), (float)sin(a)};
        if (f < 32) ra[e * 32 + f] = v; else rc[e * 16 + (f - 32)] = v;
    }
}
__device__ __forceinline__ void score_bounds(Frame& F) {
    if (F.vcu != 0 || F.wave != 0) return;
    const int l = F.tid & 63; float* bnd = (float*)(F.ws + WS_BND);
    auto wmax = [](float v) { for (int o = 1; o < 64; o <<= 1) v = fmaxf(v, __shfl_xor(v, o)); return v; };
    for (int j = 0; j < 2; ++j) {
        const float gq = wmax(fmaxf(fabsf(F.in[I_GQA_QN][j * 128 + l]), fabsf(F.in[I_GQA_QN][j * 128 + 64 + l]))), gk = wmax(fmaxf(fabsf(F.in[I_GQA_KN][j * 128 + l]), fabsf(F.in[I_GQA_KN][j * 128 + 64 + l])));
        if (l == 0) bnd[j] = 11.313708499f * gq * gk * (1.02f * 1.4426950408889634f); }
    const float gq = wmax(fmaxf(fmaxf(fabsf(F.in[I_MLA_QN][l]), fabsf(F.in[I_MLA_QN][64 + l])), fabsf(F.in[I_MLA_QN][128 + l])));
    const float gkn = wmax(fmaxf(fabsf(F.in[I_MLA_KNN][l]), fabsf(F.in[I_MLA_KNN][64 + l]))), gkr = wmax(fabsf(F.in[I_MLA_KRN][l]));
    if (l == 0) bnd[2] = gq * sqrtf(128.f * gkn * gkn + 64.f * gkr * gkr) * (1.02f * 1.4426950408889634f);
}
__device__ __forceinline__ void mod_finalize(Frame& F) {
    const float* modp = (const float*)(F.ws + WS_MODP); const float* ab = F.in[I_ADAB];
    constexpr int NTOT = DEPTH * NSEQ * 12288, Q = NTOT;
    for (int i = (F.vcu * NWAVES + F.wave) * 64 + F.lane; i < NTOT; i += F.G * NWAVES * 64) { const int l = i / (NSEQ * 12288), n = i % 12288;
        float v = ab[l * 12288 + n] + ((modp[i] + modp[i + Q]) + (modp[i + 2 * Q] + modp[i + 3 * Q]));
        const int slot = n >> 11; if (slot == 1) v = F.in[I_N1G][l * D + (n & 2047)] * (1.0f + v); else if (slot == 4) v = F.in[I_N2G][l * D + (n & 2047)] * (1.0f + v);
        F.mod[i] = v; }
}
__device__ __forceinline__ void norm0_phase(Frame& F) {
    const int gw = F.vcu * NWAVES + F.wave, NGW = F.G * NWAVES;
    float* ssq = (float*)(F.ws + WS_SSQB);
    for (int item = gw; item < M / 32; item += NGW) {
        const int row0 = item * 32, seq = seq_of_row(row0);
        const float* mp = F.mod + (size_t)seq * 12288;
        f32x4 A[8];
#pragma unroll
        for (int j = 0; j < 8; ++j) { const int c = j * 256 + F.lane * 4; A[j] = *(const f32x4*)(mp + D + c); }
        const float* xb = row0 < MP ? F.in[I_XP] + (size_t)row0 * D : F.in[I_XS] + (size_t)(row0 - MP) * D;
        bf16* hb = F.H + (size_t)row0 * D;
        for (int r = 0; r < 32; r += 2) {
            f32x4 v0[8], v1[8]; float s0 = 0.f, s1 = 0.f;
#pragma unroll
            for (int j = 0; j < 8; ++j) { v0[j] = *(const GAS f32x4*)(xb + (size_t)r * D + j * 256 + F.lane * 4); v1[j] = *(const GAS f32x4*)(xb + (size_t)(r + 1) * D + j * 256 + F.lane * 4); }
#pragma unroll
            for (int j = 0; j < 8; ++j) { s0 += (v0[j].x * v0[j].x + v0[j].y * v0[j].y) + (v0[j].z * v0[j].z + v0[j].w * v0[j].w); s1 += (v1[j].x * v1[j].x + v1[j].y * v1[j].y) + (v1[j].z * v1[j].z + v1[j].w * v1[j].w); }
            s0 = wave_sum(s0); s1 = wave_sum(s1);
            if (F.lane < 16) { const int rr = row0 + r + (F.lane >> 3), sl = F.lane & 7; ssq[(size_t)rr * 8 + sl] = sl == 0 ? ((F.lane >> 3) ? s1 : s0) : 0.f; }
#pragma unroll
            for (int j = 0; j < 8; ++j) { const f32x4 a = v0[j] * A[j], b = v1[j] * A[j];
                *(GAS v2u*)(hb + (size_t)r * D + j * 256 + F.lane * 4) = (v2u){pk2(a.x, a.y), pk2(a.z, a.w)};
                *(GAS v2u*)(hb + (size_t)(r + 1) * D + j * 256 + F.lane * 4) = (v2u){pk2(b.x, b.y), pk2(b.z, b.w)}; }
        }
    }
}
__device__ __forceinline__ void gemv20_item(Frame& F, const float* shift  , const float* W, int ldw, int ncols, float scale, float* out, int ldo, int c0) {
    LAS float* cond = (LAS float*)(F.lds);
    LAS float* red = (LAS float*)(F.lds + 98304);
    const int c = c0 + F.lane; const bool ok = c < ncols;
    for (int pass = 0; pass < 2; ++pass) {
        __syncthreads();
        for (int i = F.tid; i < 2048 * 10; i += 512) { const int k = i / 10, s = i % 10; cond[k * 12 + s] = shift[(size_t)(pass * 10 + s) * 12288 + k]; }
        __syncthreads();
        float acc[10];
#pragma unroll
        for (int s = 0; s < 10; ++s) acc[s] = 0.f;
        const float* wp = W + (size_t)(F.wave * 256) * ldw + (ok ? c : 0);
        const LAS float* cb = cond + F.wave * 256 * 12;
        for (int k0 = 0; k0 < 256; k0 += 16) {
            float wv[16];
#pragma unroll
            for (int u = 0; u < 16; ++u) { wv[u] = *wp; wp += ldw; }
#pragma unroll
            for (int u = 0; u < 16; ++u) { const LAS f32x4* cr = (const LAS f32x4*)(cb + (k0 + u) * 12); const f32x4 c0v = cr[0], c1v = cr[1], c2v = cr[2];
                acc[0] += c0v.x * wv[u]; acc[1] += c0v.y * wv[u]; acc[2] += c0v.z * wv[u]; acc[3] += c0v.w * wv[u]; acc[4] += c1v.x * wv[u]; acc[5] += c1v.y * wv[u];
                acc[6] += c1v.z * wv[u]; acc[7] += c1v.w * wv[u]; acc[8] += c2v.x * wv[u]; acc[9] += c2v.y * wv[u]; }
        }
#pragma unroll
        for (int s = 0; s < 10; ++s) red[(F.wave * 10 + s) * 64 + F.lane] = acc[s];
        __syncthreads();
        for (int i = F.tid; i < 640; i += 512) { const int s = i >> 6, l = i & 63; float t = 0.f;
#pragma unroll
            for (int w = 0; w < 8; ++w) t += red[(w * 10 + s) * 64 + l];
            if (c0 + l < ncols) out[(size_t)(pass * 10 + s) * ldo + c0 + l] = t * scale; }
    }
    __syncthreads();
}
__device__ __forceinline__ void bw_phase(Frame& F, int layer) {
    const int kind = layer % 3, j = layer / 3;
    const float* sh1 = F.mod + (size_t)layer * NSEQ * 12288; const float* sh2 = sh1 + 3 * D;
    float* bw1 = (float*)(F.ws + ((layer & 1) ? WS_BW1B : WS_BW1)); float* bw2 = (float*)(F.ws + ((layer & 1) ? WS_BW2B : WS_BW2));
    const int n1 = kind == 0 ? 48 : (kind == 1 ? 98 : 13);
    for (int it = F.G - 1 - F.vcu; it < n1 + 128; it += F.G) {
        if (it >= n1) { gemv20_item(F, sh2, F.in[I_W1] + (size_t)layer * D * FF, FF, FF, 1.f, bw2, FF, (it - n1) * 64); continue; }
        if (kind == 0) gemv20_item(F, sh1, F.in[I_GQA_WQKV] + (size_t)j * D * 3072, 3072, 3072, 1.f, bw1, 6400, it * 64);
        else if (kind == 1) {
            if (it < 16) gemv20_item(F, sh1, F.in[I_GLA_WIN], 6144, 1024, 0.0625f, bw1, 6400, it * 64);
            else if (it < 96) gemv20_item(F, sh1, F.in[I_GLA_WIN], 6144, 6144, 1.f, bw1, 6400, it * 64);
            else gemv20_item(F, sh1, F.in[I_GLA_WG1] + (size_t)(it - 96) * D * 16, 16, 16, 1.f, bw1 + 6144 + (it - 96) * 16, 6400, 0);
        } else gemv20_item(F, sh1, F.in[I_MLA_WDOWN], 832, 832, 1.f, bw1, 6400, it * 64);
    }
}
__device__ __forceinline__ void rot(float& y0, float& y1, f32x2 cs) { const float a = y0 * cs.x - y1 * cs.y, b = y0 * cs.y + y1 * cs.x; y0 = a; y1 = b; }
__device__ __forceinline__ void unpack8(v4u w, float* x) { x[0] = bflo(w.x); x[1] = bfhi(w.x); x[2] = bflo(w.y); x[3] = bfhi(w.y); x[4] = bflo(w.z); x[5] = bfhi(w.z); x[6] = bflo(w.w); x[7] = bfhi(w.w); }
__device__ __forceinline__ void mla_down_norm_phase(Frame& F) {
    bf16* DN = (bf16*)(F.ws + WS_DOWN); const float* qa = F.in[I_MLA_QAN]; const float* kva = F.in[I_MLA_KVAN]; const float* krn = F.in[I_MLA_KRN];
    const int gw = F.vcu * NWAVES + F.wave, NGW = F.G * NWAVES, lane = F.lane;
    float g0[8], g1[8], g2[8];
#pragma unroll
    for (int e = 0; e < 8; ++e) { g0[e] = qa[lane * 8 + e]; g1[e] = kva[(lane & 31) * 8 + e]; g2[e] = krn[(lane & 7) * 8 + e]; }
    for (int row = gw; row < M; row += NGW) {
        const int t = pos_of_row(row), ri = t >> 6, ci = 128 + (t & 63);
        bf16* rp = DN + (size_t)row * 1024;
        const v4u w0 = *(const GAS v4u*)(rp + lane * 8), w1 = *(const GAS v4u*)(rp + 512 + (lane & 31) * 8), w2 = *(const GAS v4u*)(rp + 768 + (lane & 7) * 8);
        float x[8], ss;
        unpack8(w0, x); ss = 0.f;
#pragma unroll
        for (int e = 0; e < 8; ++e) ss += x[e] * x[e];
        ss = wave_sum(ss); { const float rs = 1.0f / sqrtf(ss * (1.f / 512.f) + NORM_EPS);
#pragma unroll
            for (int e = 0; e < 8; ++e) x[e] = x[e] * rs * g0[e]; }
        *(GAS v4u*)(rp + lane * 8) = (v4u){pk2(x[0], x[1]), pk2(x[2], x[3]), pk2(x[4], x[5]), pk2(x[6], x[7])};
        unpack8(w1, x); ss = 0.f;
#pragma unroll
        for (int e = 0; e < 8; ++e) ss += x[e] * x[e];
        ss += __shfl_xor(ss, 1); ss += __shfl_xor(ss, 2); ss += __shfl_xor(ss, 4); ss += __shfl_xor(ss, 8); ss += __shfl_xor(ss, 16);
        { const float rs = 1.0f / sqrtf(ss * (1.f / 256.f) + NORM_EPS);
#pragma unroll
            for (int e = 0; e < 8; ++e) x[e] = x[e] * rs * g1[e]; }
        if (lane < 32) *(GAS v4u*)(rp + 512 + lane * 8) = (v4u){pk2(x[0], x[1]), pk2(x[2], x[3]), pk2(x[4], x[5]), pk2(x[6], x[7])};
        unpack8(w2, x); ss = 0.f;
#pragma unroll
        for (int e = 0; e < 8; ++e) ss += x[e] * x[e];
        ss += __shfl_xor(ss, 1); ss += __shfl_xor(ss, 2); ss += __shfl_xor(ss, 4);
        { const float rs = 1.0f / sqrtf(ss * (1.f / 64.f) + NORM_EPS);
#pragma unroll
            for (int e = 0; e < 8; ++e) x[e] = x[e] * rs * g2[e]; }
#pragma unroll
        for (int p = 0; p < 4; ++p) { const int i = (lane & 7) * 4 + p; rot(x[2 * p], x[2 * p + 1], F.ropeC[(i < 16 ? ri : ci) * 16 + (i & 15)]); }
        if (lane < 8) *(GAS v4u*)(rp + 768 + lane * 8) = (v4u){pk2(x[0], x[1]), pk2(x[2], x[3]), pk2(x[4], x[5]), pk2(x[6], x[7])};
    }
}
__device__ __forceinline__ void mla_knope_norm_phase(Frame& F) {
    bf16* KV = (bf16*)(F.ws + WS_KV); const float* knn = F.in[I_MLA_KNN];
    const int gw = F.vcu * NWAVES + F.wave, NGW = F.G * NWAVES, lane = F.lane, sub = lane & 15, hh = lane >> 4;
    float gk[8];
#pragma unroll
    for (int e = 0; e < 8; ++e) gk[e] = knn[sub * 8 + e];
    for (int row = gw; row < M; row += NGW) {
        v4u w[4];
#pragma unroll
        for (int ps = 0; ps < 4; ++ps) w[ps] = *(const GAS v4u*)(KV + (size_t)row * 4096 + (ps * 4 + hh) * 256 + sub * 8);
#pragma unroll
        for (int ps = 0; ps < 4; ++ps) {
            float x[8]; unpack8(w[ps], x); float ss = 0.f;
#pragma unroll
            for (int e = 0; e < 8; ++e) ss += x[e] * x[e];
            ss += __shfl_xor(ss, 1); ss += __shfl_xor(ss, 2); ss += __shfl_xor(ss, 4); ss += __shfl_xor(ss, 8);
            const float rs = 1.0f / sqrtf(ss * (1.f / 128.f) + NORM_EPS);
#pragma unroll
            for (int e = 0; e < 8; ++e) x[e] = x[e] * rs * gk[e];
            *(GAS v4u*)(KV + (size_t)row * 4096 + (ps * 4 + hh) * 256 + sub * 8) = (v4u){pk2(x[0], x[1]), pk2(x[2], x[3]), pk2(x[4], x[5]), pk2(x[6], x[7])};
        }
    }
}
__device__ __forceinline__ void gla_post_phase(Frame& F) {
    bf16* OB = (bf16*)(F.ws + WS_OB); const bf16* PROJ = (const bf16*)(F.ws + WS_PROJ); const float* on = F.in[I_GLA_ON];
    const int gw = F.vcu * NWAVES + F.wave, NGW = F.G * NWAVES, lane = F.lane;
    float g[8];
#pragma unroll
    for (int e = 0; e < 8; ++e) g[e] = on[lane * 8 + e];
    for (int row = gw; row < M; row += NGW) {
        v4u wf[4], wb[4], wr[4];
#pragma unroll
        for (int h = 0; h < 4; ++h) { wf[h] = *(const GAS v4u*)(F.H + (size_t)row * D + h * 512 + lane * 8); wb[h] = *(const GAS v4u*)(OB + (size_t)row * D + h * 512 + lane * 8);
            wr[h] = *(const GAS v4u*)(PROJ + (size_t)row * 6400 + 4096 + h * 512 + lane * 8); }
#pragma unroll
        for (int h = 0; h < 4; ++h) {
            float a[8], b[8], r[8]; unpack8(wf[h], a); unpack8(wb[h], b); unpack8(wr[h], r); float ss = 0.f;
#pragma unroll
            for (int e = 0; e < 8; ++e) { a[e] += b[e]; ss += a[e] * a[e]; }
            ss = wave_sum(ss); const float rs = 1.0f / sqrtf(ss * (1.f / 512.f) + NORM_EPS);
#pragma unroll
            for (int e = 0; e < 8; ++e) a[e] = a[e] * rs * g[e] * (r[e] / (1.f + __expf(-r[e])));
            *(GAS v4u*)(OB + (size_t)row * D + h * 512 + lane * 8) = (v4u){pk2(a[0], a[1]), pk2(a[2], a[3]), pk2(a[4], a[5]), pk2(a[6], a[7])};
        }
    }
}

namespace gla {
typedef float f32x4 __attribute__((ext_vector_type(4)));
typedef short bf16x8 __attribute__((ext_vector_type(8)));
constexpr int CL = 32;
constexpr int QD_ROW = 528, KET_ROW = 80, V_ROW = 272, P_ROW = 80;
constexpr int OFF_QD = 0, OFF_KD = OFF_QD + CL * QD_ROW, OFF_KET = OFF_KD + CL * QD_ROW, OFF_V = OFF_KET + 256 * KET_ROW, OFF_DE = OFF_V + CL * V_ROW, BUF_BYTES = OFF_DE + 1024;
constexpr int OFF_LOW = 2 * BUF_BYTES, OFF_PW = OFF_LOW + 2 * CL * 64, OFF_END = OFF_PW + 4 * CL * P_ROW;
static_assert(OFF_END <= LDSCTL_OFF, "gla LDS map");
__device__ __forceinline__ float log_sigmoid(float z) { return fminf(z, 0.f) - __logf(1.f + __expf(-fabsf(z))); }
__device__ __forceinline__ void rd_p(bf16x8 (&fa)[2][2], bf16x8 (&fb)[2][2], int aq, int ak) {
#pragma unroll
    for (int mi = 0; mi < 2; ++mi)
#pragma unroll
        for (int kk = 0; kk < 2; ++kk) { fa[mi][kk] = *(const LAS bf16x8*)(uintptr_t)(unsigned)(aq + mi * 8448 + kk * 64); fb[mi][kk] = *(const LAS bf16x8*)(uintptr_t)(unsigned)(ak + mi * 8448 + kk * 64); }
}
__device__ __forceinline__ void rd_v(unsigned (&vu)[8], int av) {
#pragma unroll
    for (int q = 0; q < 8; ++q) vu[q] = *(const LAS unsigned short*)(uintptr_t)(unsigned)(av + q * 272);
}
__device__ __forceinline__ void rd_pw(bf16x8 (&fp)[2], int ap) { fp[0] = *(const LAS bf16x8*)(uintptr_t)(unsigned)ap; fp[1] = *(const LAS bf16x8*)(uintptr_t)(unsigned)(ap + 1280); }
__device__ __forceinline__ void rd_q(v2u (&q0)[2][2], v2u (&q1)[2][2], int aq) {
#pragma unroll
    for (int mi = 0; mi < 2; ++mi)
#pragma unroll
        for (int kk = 0; kk < 2; ++kk) { q0[mi][kk] = *(const LAS v2u*)(uintptr_t)(unsigned)(aq + mi * 8448 + kk * 64); q1[mi][kk] = *(const LAS v2u*)(uintptr_t)(unsigned)(aq + mi * 8448 + kk * 64 + 32); }
}
__device__ __forceinline__ void rd_s(bf16x8 (&fk)[4], f32x4 (&fd)[4], int ak, int ad) {
#pragma unroll
    for (int t = 0; t < 4; ++t) { fk[t] = *(const LAS bf16x8*)(uintptr_t)(unsigned)(ak + t * 1280); fd[t] = *(const LAS f32x4*)(uintptr_t)(unsigned)(ad + t * 64); }
}
static_assert(16 * QD_ROW == 8448 && V_ROW == 272 && 16 * P_ROW == 1280 && 16 * KET_ROW == 1280, "asm offsets");
#define GLA_BAR() do { asm volatile("s_waitcnt lgkmcnt(0)" ::: "memory"); __builtin_amdgcn_s_barrier(); asm volatile("" ::: "memory"); } while (0)

__device__ __forceinline__ void chain(LAS unsigned char* lds, const bf16* PROJ, bf16* OF, bf16* OB, const float* wg2, const float* bgv, int c) {
    const int tid = threadIdx.x, wave = __builtin_amdgcn_readfirstlane(tid >> 6), lane = tid & 63;
    const int sl = c & 3, dir = (c >> 2) & 1, h = (c >> 3) & 3, s = c >> 5;
    int T, rowbase;
    if (c < 128) { T = 8192; rowbase = MP + s * 8192; } else { T = 2048; rowbase = (s - 4) * 2048; }
    const int nch = T / CL;
    GLA_BAR();
    if (wave < 4) {
        const int ptid = tid, l16 = lane & 15, g = lane >> 4, dbase = 64 * wave + 2 * l16;
        bf16x8 wB[4]; float bias[4];
#pragma unroll
        for (int nj = 0; nj < 4; ++nj) { const int d = dbase + 32 * (nj >> 1) + (nj & 1); float w[8];
#pragma unroll
            for (int jx = 0; jx < 8; ++jx) w[jx] = g < 2 ? wg2[((size_t)dir * 16 + 8 * g + jx) * 1024 + h * 256 + d] : 0.f;
            wB[nj] = __builtin_bit_cast(bf16x8, (v4u){pk2c(w[0], w[1]), pk2c(w[2], w[3]), pk2c(w[4], w[5]), pk2c(w[6], w[7])});
            bias[nj] = bgv[dir * 1024 + h * 256 + d]; }
        unsigned qv[2][2][4], kv[2][2][4]; v4u vv[2]; unsigned lw;
#define GLA_ROW0(J) ((size_t)rowbase + (size_t)(dir ? nch - 1 - (J) : (J)) * CL)
#define GLA_LOAD_QKV(J) do { const size_t r0_ = GLA_ROW0(J); const char* qp_ = (const char*)PROJ + (r0_ * 6400 + h * 256 + 64 * wave) * 2; const unsigned voff_ = (unsigned)(4 * g * 6400 + 2 * l16) * 2u;     \
        _Pragma("unroll") for (int pp = 0; pp < 2; ++pp) _Pragma("unroll") for (int mi = 0; mi < 2; ++mi) _Pragma("unroll") for (int r = 0; r < 4; ++r) { \
            qv[pp][mi][r] = *(const GAS unsigned*)(qp_ + (size_t)(16 * mi + r) * 12800 + pp * 64 + voff_); kv[pp][mi][r] = *(const GAS unsigned*)(qp_ + (size_t)(16 * mi + r) * 12800 + pp * 64 + 2048 + voff_); } \
        _Pragma("unroll") for (int jj = 0; jj < 2; ++jj) { const int idx = ptid + 256 * jj, pos = idx >> 4, e8 = (idx & 15) * 8; vv[jj] = *(const GAS v4u*)(PROJ + (r0_ + pos) * 6400 + 2048 + h * 512 + sl * 128 + e8); } } while (0)
#define GLA_LOAD_LOW(J) do { lw = *(const GAS unsigned*)(PROJ + (GLA_ROW0(J) + (ptid >> 3)) * 6400 + 6144 + dir * 16 + (ptid & 7) * 2); } while (0)
#define GLA_PUT_LOW(J) do { *(LAS unsigned*)(lds + OFF_LOW + ((J) & 1) * (CL * 64) + (ptid >> 3) * 64 + (ptid & 7) * 4) = lw; } while (0)
        { const int b_ = ptid >> 7, pos_ = (ptid >> 2) & 31, part_ = ptid & 3; *(LAS v2u*)(lds + OFF_LOW + b_ * (CL * 64) + pos_ * 64 + 32 + part_ * 8) = (v2u){0u, 0u}; }
        GLA_LOAD_LOW(0); GLA_PUT_LOW(0);
        if (nch > 1) GLA_LOAD_LOW(1);
        GLA_LOAD_QKV(0);
        GLA_BAR();
        for (int j = 0; j < nch; ++j) {
            LAS unsigned char* B = lds + (j & 1) * BUF_BYTES;
            if (j + 1 < nch) GLA_PUT_LOW(j + 1);
            f32x4 z[2][4];
            { bf16x8 fA[2];
#pragma unroll
              for (int mi = 0; mi < 2; ++mi) fA[mi] = *(const LAS bf16x8*)(lds + OFF_LOW + (j & 1) * (CL * 64) + (16 * mi + l16) * 64 + g * 16);
#pragma unroll
              for (int mi = 0; mi < 2; ++mi)
#pragma unroll
                  for (int nj = 0; nj < 4; ++nj) z[mi][nj] = __builtin_amdgcn_mfma_f32_16x16x32_bf16(fA[mi], wB[nj], (f32x4){bias[nj], bias[nj], bias[nj], bias[nj]}, 0, 0, 0); }
            float tot[4];
#pragma unroll
            for (int nj = 0; nj < 4; ++nj) {
                float s[2];
#pragma unroll
                for (int mi = 0; mi < 2; ++mi) {
#pragma unroll
                    for (int r = 0; r < 4; ++r) { const float zz = z[mi][nj][r]; const float t = __builtin_amdgcn_exp2f(-1.4426950408889634f * __builtin_fabsf(zz));
                        z[mi][nj][r] = __builtin_fmaf(__builtin_amdgcn_logf(1.0f + t), -0.0625f, __builtin_fminf(zz * 0.09016844005556021f, 0.f)); }
                    if (dir == 0) { z[mi][nj][1] += z[mi][nj][0]; z[mi][nj][2] += z[mi][nj][1]; z[mi][nj][3] += z[mi][nj][2]; s[mi] = z[mi][nj][3]; }
                    else          { z[mi][nj][2] += z[mi][nj][3]; z[mi][nj][1] += z[mi][nj][2]; z[mi][nj][0] += z[mi][nj][1]; s[mi] = z[mi][nj][0]; }
                }
                float e[2], t2[2];
#pragma unroll
                for (int mi = 0; mi < 2; ++mi) { const float s1 = __shfl_xor(s[mi], 16), ps = s[mi] + s1, p2 = __shfl_xor(ps, 32); t2[mi] = ps + p2;
                    e[mi] = dir == 0 ? (((g & 1) ? s1 : 0.f) + ((g & 2) ? p2 : 0.f)) : (((g & 1) ? 0.f : s1) + ((g & 2) ? 0.f : p2)); }
                const float o0 = e[0] + (dir == 0 ? 0.f : t2[1]), o1 = e[1] + (dir == 0 ? t2[0] : 0.f);
#pragma unroll
                for (int r = 0; r < 4; ++r) { z[0][nj][r] += o0; z[1][nj][r] += o1; }
                tot[nj] = t2[0] + t2[1];
            }
#pragma unroll
            for (int jj = 0; jj < 2; ++jj) { const int idx = ptid + 256 * jj, pos = idx >> 4, e8 = (idx & 15) * 8; *(LAS v4u*)(B + OFF_V + pos * V_ROW + e8 * 2) = vv[jj]; }
#pragma unroll
            for (int pp = 0; pp < 2; ++pp) { const int da = dbase + 32 * pp;
                const float dea = __builtin_amdgcn_exp2f(tot[2 * pp]), deb = __builtin_amdgcn_exp2f(tot[2 * pp + 1]);
                if (g == 0) *(LAS f32x2*)(B + OFF_DE + da * 4) = (f32x2){dea, deb};
#pragma unroll
                for (int mi = 0; mi < 2; ++mi) { float ea[4], eb[4];
#pragma unroll
                    for (int r = 0; r < 4; ++r) { const float b_a = z[mi][2 * pp][r], b_b = z[mi][2 * pp + 1][r];
                        const float xa = __builtin_amdgcn_exp2f(b_a), xb = __builtin_amdgcn_exp2f(b_b), ia = __builtin_amdgcn_exp2f(-b_a), ib = __builtin_amdgcn_exp2f(-b_b);
                        const unsigned qw = qv[pp][mi][r], kw = kv[pp][mi][r];
                        const float ka = bflo(kw) * ia, kb = bfhi(kw) * ib; ea[r] = ka * dea; eb[r] = kb * deb;
                        const int pos = 16 * mi + 4 * g + r;
                        *(LAS unsigned*)(B + OFF_QD + pos * QD_ROW + da * 2) = pk2c(bflo(qw) * xa, bfhi(qw) * xb);
                        *(LAS unsigned*)(B + OFF_KD + pos * QD_ROW + da * 2) = pk2c(ka, kb); }
                    *(LAS v2u*)(B + OFF_KET + da * KET_ROW + (16 * mi + 4 * g) * 2) = (v2u){pk2c(ea[0], ea[1]), pk2c(ea[2], ea[3])};
                    *(LAS v2u*)(B + OFF_KET + (da + 1) * KET_ROW + (16 * mi + 4 * g) * 2) = (v2u){pk2c(eb[0], eb[1]), pk2c(eb[2], eb[3])};
                }
            }
            if (j + 1 < nch) GLA_LOAD_QKV(j + 1);
            if (j + 2 < nch) GLA_LOAD_LOW(j + 2);
            GLA_BAR();
        }
        GLA_BAR();
#undef GLA_ROW0
#undef GLA_LOAD_QKV
#undef GLA_LOAD_LOW
#undef GLA_PUT_LOW
    } else {
        const int cw = wave - 4, l16 = lane & 15, g = lane >> 4;
        bf16* OD = dir ? OB : OF;
        LAS unsigned char* PW = lds + OFF_PW + cw * (CL * P_ROW);
        f32x4 S[2][16];
#pragma unroll
        for (int cb = 0; cb < 2; ++cb)
#pragma unroll
            for (int t = 0; t < 16; ++t) S[cb][t] = (f32x4){0.f, 0.f, 0.f, 0.f};
        GLA_BAR();
        GLA_BAR();
#define GLA_WAIT() do { asm volatile("s_waitcnt lgkmcnt(0)" ::: "memory"); __builtin_amdgcn_sched_barrier(0); } while (0)
        const int lbase = (int)(uintptr_t)lds;
        const int a_qd = lbase + OFF_QD + l16 * QD_ROW + g * 16;
        const int a_kd = lbase + OFF_KD + l16 * QD_ROW + g * 16;
        const int a_qp = lbase + OFF_QD + l16 * QD_ROW + g * 8;
        const int a_ke = lbase + OFF_KET + l16 * KET_ROW + g * 16;
        const int a_de = lbase + OFF_DE + g * 16;
        const int a_v = lbase + OFF_V + (8 * g) * V_ROW + (32 * cw + l16) * 2;
        const int a_pw = (int)(uintptr_t)PW + l16 * P_ROW + g * 16;
        for (int j = 0; j < nch; ++j) {
            const int bo = (j & 1) * BUF_BYTES;
            const size_t r0 = (size_t)rowbase + (size_t)(dir ? nch - 1 - j : j) * CL;
            f32x4 pacc[2][2];
#pragma unroll
            for (int mi = 0; mi < 2; ++mi)
#pragma unroll
                for (int ni = 0; ni < 2; ++ni) pacc[mi][ni] = (f32x4){0.f, 0.f, 0.f, 0.f};
#pragma unroll
            for (int hb = 0; hb < 4; ++hb) {
                bf16x8 fa[2][2], fb[2][2];
                rd_p(fa, fb, a_qd + bo + hb * 128, a_kd + bo + hb * 128);
#pragma unroll
                for (int kk = 0; kk < 2; ++kk)
#pragma unroll
                    for (int mi = 0; mi < 2; ++mi)
#pragma unroll
                        for (int ni = 0; ni < 2; ++ni) pacc[mi][ni] = __builtin_amdgcn_mfma_f32_16x16x32_bf16(fa[mi][kk], fb[ni][kk], pacc[mi][ni], 0, 0, 0);
            }
#pragma unroll
            for (int mi = 0; mi < 2; ++mi)
#pragma unroll
                for (int ni = 0; ni < 2; ++ni)
#pragma unroll
                    for (int r = 0; r < 4; ++r) { const int pos = 16 * mi + 4 * g + r, pk = 16 * ni + l16; const bool keep = dir ? (pk >= pos) : (pk <= pos);
                        *(LAS unsigned short*)(PW + pos * P_ROW + pk * 2) = (unsigned short)(pk2c(keep ? pacc[mi][ni][r] : 0.f, 0.f) & 0xffffu); }
            unsigned vu[2][8]; bf16x8 fp[2];
            asm volatile("s_waitcnt lgkmcnt(0)" ::: "memory");
            rd_v(vu[0], a_v + bo); rd_v(vu[1], a_v + bo + 32);
            rd_pw(fp, a_pw);
            bf16x8 Bv[2];
#pragma unroll
            for (int cb = 0; cb < 2; ++cb) Bv[cb] = __builtin_bit_cast(bf16x8, (v4u){vu[cb][0] | (vu[cb][1] << 16), vu[cb][2] | (vu[cb][3] << 16), vu[cb][4] | (vu[cb][5] << 16), vu[cb][6] | (vu[cb][7] << 16)});
            f32x4 oacc[2][2];
#pragma unroll
            for (int mi = 0; mi < 2; ++mi)
#pragma unroll
                for (int cb = 0; cb < 2; ++cb) oacc[mi][cb] = __builtin_amdgcn_mfma_f32_16x16x32_bf16(fp[mi], Bv[cb], (f32x4){0.f, 0.f, 0.f, 0.f}, 0, 0, 0);
#pragma unroll
            for (int hb = 0; hb < 4; ++hb) {
                v2u q0[2][2], q1[2][2];
                rd_q(q0, q1, a_qp + bo + hb * 128);
#pragma unroll
                for (int kk = 0; kk < 2; ++kk) { const int k2 = 2 * (hb * 2 + kk);
                    bf16x8 Bs[2];
#pragma unroll
                    for (int cb = 0; cb < 2; ++cb) Bs[cb] = __builtin_bit_cast(bf16x8, (v4u){pk2c(S[cb][k2][0], S[cb][k2][1]), pk2c(S[cb][k2][2], S[cb][k2][3]), pk2c(S[cb][k2 + 1][0], S[cb][k2 + 1][1]), pk2c(S[cb][k2 + 1][2], S[cb][k2 + 1][3])});
#pragma unroll
                    for (int mi = 0; mi < 2; ++mi) { const bf16x8 a = __builtin_bit_cast(bf16x8, (v4u){q0[mi][kk].x, q0[mi][kk].y, q1[mi][kk].x, q1[mi][kk].y});
#pragma unroll
                        for (int cb = 0; cb < 2; ++cb) oacc[mi][cb] = __builtin_amdgcn_mfma_f32_16x16x32_bf16(a, Bs[cb], oacc[mi][cb], 0, 0, 0); }
                }
            }
            { bf16* op = OD + r0 * 2048 + h * 512 + sl * 128 + 32 * cw + l16;
#pragma unroll
              for (int mi = 0; mi < 2; ++mi)
#pragma unroll
                  for (int cb = 0; cb < 2; ++cb)
#pragma unroll
                      for (int r = 0; r < 4; ++r) op[(size_t)(16 * mi + 4 * g + r) * 2048 + 16 * cb] = (bf16)(pk2c(oacc[mi][cb][r], 0.f) & 0xffffu); }
#pragma unroll
            for (int hb = 0; hb < 4; ++hb) {
                bf16x8 fk[4]; f32x4 fd[4];
                rd_s(fk, fd, a_ke + bo + hb * 5120, a_de + bo + hb * 256);
#pragma unroll
                for (int t = 0; t < 4; ++t)
#pragma unroll
                    for (int cb = 0; cb < 2; ++cb) S[cb][hb * 4 + t] = __builtin_amdgcn_mfma_f32_16x16x32_bf16(fk[t], Bv[cb], S[cb][hb * 4 + t] * fd[t], 0, 0, 0);
            }
            GLA_BAR();
        }
#undef GLA_WAIT
    }
}
}

constexpr int N_PHASE_IDS = 2 + 10 * DEPTH;
__host__ __device__ constexpr bool phase_exists(int ph) {
    if (ph < 2) return true;
    const int l = (ph - 2) / 10, s = (ph - 2) % 10, kind = l % 3;
    if (s == 5) return kind == 2;
    if (s == 7) return false;
    if (s == 4) return false;
    if (s == 0 && l > 0) return false;
    if (s == 2 && kind == 0) return false;
    return true;
}
#define IN(k) (lo <= (k) && (k) < hi)
#ifndef SITE_MASK
#define SITE_MASK 0xffffu
#endif
#ifndef WGM_RES
#define WGM_RES 4
#endif
#ifndef REPS_G1
#define REPS_G1 1
#endif
#ifndef REPS_G3
#define REPS_G3 1
#endif
#ifndef REPS_SCAN
#define REPS_SCAN 1
#endif
#ifndef REPS_ATT
#define REPS_ATT 1
#endif
#define SITE(n) ((((unsigned)(SITE_MASK)) >> (n)) & 1u)
#define SEAM(k) do { if ((k) + 1 < hi) xcd_barrier(bar); } while (0)
template <int layer> __device__ __forceinline__ void layer_body(Frame& F, const XcdBarrier& bar, const int lo, const int hi, unsigned char* lds_raw) {
    constexpr size_t wreg = (layer & 1) ? WS_WB : WS_W, bw1o = (layer & 1) ? WS_BW1B : WS_BW1, bw2o = (layer & 1) ? WS_BW2B : WS_BW2;
    bf16* const w1t = (bf16*)(F.ws + wreg); bf16* const w2t = (bf16*)(F.ws + wreg + 32 * MiB); bf16* const wmix = (bf16*)(F.ws + wreg + 64 * MiB); bf16* const wot = (bf16*)(F.ws + wreg + 90 * MiB);
#define PREP_NEXT() do { if constexpr (layer + 1 < DEPTH) { __syncthreads(); bw_phase(F, layer + 1); prep_weights(F, layer + 1, (unsigned*)(F.ws + WS_CTL) + CW_PREP + 64 * (layer + 1)); } } while (0)

        constexpr int pb = 2 + 10 * layer, kind = layer % 3, jj = layer / 3;
        const float* modl = F.mod + (size_t)layer * NSEQ * 12288;
        if (SITE(2) && layer == 0 && IN(pb + 0)) { norm0_phase(F); bw_phase(F, 0); SEAM(pb + 0); }
        if (SITE(3) && IN(pb + 1)) {
            const int N1 = kind == 0 ? 3072 : (kind == 1 ? 6400 : 1024);
            pg8::Gemm g{F.H, wmix, M, N1, D, D, 256}; pg8::StaticOrder S; S.init(M, N1, F.G, (int)blockIdx.x, REPS_G1);
            if constexpr (kind == 0) {
                pg8::EpiBf16NRope E{(bf16*)(F.ws + WS_S), N1, (const float*)(F.ws + WS_SSQB), (const float*)(F.ws + bw1o), 6400,
                                    F.in[I_GQA_QN] + jj * 128, F.in[I_GQA_KN] + jj * 128, (const float*)F.ropeA, (PG8_LAS float*)(F.lds + RING_BYTES + 4096)};
                pg8::gemm_phase<pg8::EpiBf16NRope, pg8::StaticOrder, true, true>(F.lds, g, S, E);
            } else {
                pg8::EpiBf16N<0> E{(bf16*)(F.ws + WS_S), N1, (const float*)(F.ws + WS_SSQB), (const float*)(F.ws + bw1o), 6400};
                pg8::gemm_phase<pg8::EpiBf16N<0>, pg8::StaticOrder, true, true>(F.lds, g, S, E);
            }
            SEAM(pb + 1);
        }
        if (kind == 0) {
            if (SITE(5) && IN(pb + 3)) {
                const bf16* QKV = (const bf16*)(F.ws + WS_QKV);
                const float shiftC = __int_as_float(__builtin_amdgcn_readfirstlane(__float_as_int(((const float*)(F.ws + WS_BND))[jj])));
                if (shiftC < 60.f) {
                for (int u_ = F.vcu; u_ < 4096 * REPS_ATT; u_ += F.G) { const int u = u_ & 4095;
                    int rowq, rowk, T, head;
                    if (u < 2048) { const int sq = u >> 9, r = u & 511; head = r >> 5; T = 8192; rowk = MP + sq * 8192; rowq = rowk + (r & 31) * 256; }
                    else { const int v = u - 2048, sq = v >> 7, r = v & 127; head = r >> 3; T = 2048; rowk = sq * 2048; rowq = rowk + (r & 7) * 256; }
                    const int kvh = head >> 2;
                    attn::attn_dense_body<128, 3072, 3072, 3072, 3072, 3072, 2, false, true>(QKV + (size_t)rowq * 3072 + head * 128, QKV + (size_t)rowk * 3072 + 2048 + kvh * 128, nullptr,
                        QKV + (size_t)rowk * 3072 + 2560 + kvh * 128, (bf16*)QKV + (size_t)rowq * 3072 + head * 128, T, (char*)lds_raw, nullptr, nullptr, 0, shiftC);
                }
                } else {
                for (int u_ = F.vcu; u_ < 4096 * REPS_ATT; u_ += F.G) { const int u = u_ & 4095;
                    int rowq, rowk, T, head;
                    if (u < 2048) { const int sq = u >> 9, r = u & 511; head = r >> 5; T = 8192; rowk = MP + sq * 8192; rowq = rowk + (r & 31) * 256; }
                    else { const int v = u - 2048, sq = v >> 7, r = v & 127; head = r >> 3; T = 2048; rowk = sq * 2048; rowq = rowk + (r & 7) * 256; }
                    const int kvh = head >> 2;
                    attn::attn_dense_body<128, 3072, 3072, 3072, 3072, 3072, 2>(QKV + (size_t)rowq * 3072 + head * 128, QKV + (size_t)rowk * 3072 + 2048 + kvh * 128, nullptr,
                        QKV + (size_t)rowk * 3072 + 2560 + kvh * 128, (bf16*)QKV + (size_t)rowq * 3072 + head * 128, T, (char*)lds_raw);
                }
                }
                PREP_NEXT();
                SEAM(pb + 3);
            }
        } else if (kind == 1) {
            if (SITE(6) && IN(pb + 2)) {
                const bf16* PROJ = (const bf16*)(F.ws + WS_PROJ); bf16* OB = (bf16*)(F.ws + WS_OB);
                const int nrep = REPS_SCAN + (F.G >> 24);
                for (int rp = 0; rp < nrep; ++rp) {
                    const int nmine = F.G == 256 ? (F.vcu < 128 ? 1 : 4) : (640 - F.vcu + F.G - 1) / F.G;
                    for (int q = 0; q < nmine; ++q) { const int c = F.G == 256 ? (F.vcu < 128 ? F.vcu : 128 + (F.vcu - 128) * 4 + q) : F.vcu + q * F.G;
                        gla::chain(F.lds, PROJ, F.H, OB, F.in[I_GLA_WG2], F.in[I_GLA_BG], c); } }
                PREP_NEXT();
                SEAM(pb + 2);
            }
            if (SITE(7) && IN(pb + 3)) { gla_post_phase(F); SEAM(pb + 3); }
        } else {
            if (SITE(8) && IN(pb + 2)) { mla_down_norm_phase(F); SEAM(pb + 2); }
            if (SITE(9) && IN(pb + 3)) {
                const bf16* DN = (const bf16*)(F.ws + WS_DOWN);
                { pg8::Gemm g{DN, wmix + (size_t)4 * MiB / 2, M, 3072, 512, 1024, 256}; pg8::StaticOrder S; S.init(M, 3072, F.G, (int)blockIdx.x);
                  pg8::EpiBf16P E{(bf16*)(F.ws + WS_Q), 3072};
                  pg8::gemm_phase<pg8::EpiBf16P, pg8::StaticOrder, true, true>(F.lds, g, S, E); }
                __syncthreads();
                { int K2 = 256, lda2 = 1024; asm volatile("" : "+s"(K2), "+s"(lda2));
                  pg8::Gemm g{DN + 512, wmix + (size_t)8 * MiB / 2, M, 4096, K2, lda2, 256}; pg8::StaticOrder S; S.init(M, 4096, F.G, (int)blockIdx.x);
                  pg8::EpiBf16KV E{(bf16*)(F.ws + WS_KV), 4096, F.in[I_MLA_KNN], (PG8_LAS float*)(F.lds + RING_BYTES + 4096)};
                  pg8::gemm_phase<pg8::EpiBf16KV, pg8::StaticOrder, true, true>(F.lds, g, S, E); }
                SEAM(pb + 3);
            }
            if (SITE(11) && IN(pb + 5)) {
                const bf16* Q = (const bf16*)(F.ws + WS_Q); const bf16* KV = (const bf16*)(F.ws + WS_KV); const bf16* DN = (const bf16*)(F.ws + WS_DOWN);
                const float shiftC = __int_as_float(__builtin_amdgcn_readfirstlane(__float_as_int(((const float*)(F.ws + WS_BND))[2])));
                if (shiftC < 60.f) {
                for (int u_ = F.vcu; u_ < 4096 * REPS_ATT; u_ += F.G) { const int u = u_ & 4095;
                    int rowq, rowk, T, head;
                    if (u < 2048) { const int sq = u >> 9, r = u & 511; head = r >> 5; T = 8192; rowk = MP + sq * 8192; rowq = rowk + (r & 31) * 256; }
                    else { const int v = u - 2048, sq = v >> 7, r = v & 127; head = r >> 3; T = 2048; rowk = sq * 2048; rowq = rowk + (r & 7) * 256; }
                    attn::attn_dense_body<192, 3072, 4096, 1024, 4096, 3072, 1, true, true>(Q + (size_t)rowq * 3072 + head * 192, KV + (size_t)rowk * 4096 + head * 256, DN + (size_t)rowk * 1024 + 768,
                        KV + (size_t)rowk * 4096 + head * 256 + 128, (bf16*)Q + (size_t)rowq * 3072 + head * 192, T, (char*)lds_raw, F.in[I_MLA_QN], (const float*)F.ropeC, rowq - rowk, shiftC);
                }
                } else {
                for (int u_ = F.vcu; u_ < 4096 * REPS_ATT; u_ += F.G) { const int u = u_ & 4095;
                    int rowq, rowk, T, head;
                    if (u < 2048) { const int sq = u >> 9, r = u & 511; head = r >> 5; T = 8192; rowk = MP + sq * 8192; rowq = rowk + (r & 31) * 256; }
                    else { const int v = u - 2048, sq = v >> 7, r = v & 127; head = r >> 3; T = 2048; rowk = sq * 2048; rowq = rowk + (r & 7) * 256; }
                    attn::attn_dense_body<192, 3072, 4096, 1024, 4096, 3072, 1, true>(Q + (size_t)rowq * 3072 + head * 192, KV + (size_t)rowk * 4096 + head * 256, DN + (size_t)rowk * 1024 + 768,
                        KV + (size_t)rowk * 4096 + head * 256 + 128, (bf16*)Q + (size_t)rowq * 3072 + head * 192, T, (char*)lds_raw, F.in[I_MLA_QN], (const float*)F.ropeC, rowq - rowk);
                }
                }
                PREP_NEXT();
                SEAM(pb + 5);
            }
        }
        if (SITE(12) && IN(pb + 6)) {
            const bf16* A2 = kind == 0 ? (const bf16*)(F.ws + WS_QKV) : (kind == 1 ? (const bf16*)(F.ws + WS_OB) : (const bf16*)(F.ws + WS_Q));
            pg8::Gemm g{A2, wot, M, D, D, kind == 1 ? D : 3072, kind == 2 ? 384 : 256}; pg8::StaticOrder S; S.init(M, D, F.G, (int)blockIdx.x, 1, WGM_RES);
            typedef pg8::EpiResGateNormB<layer == 0 ? 0 : 1> EpiT;
            EpiT E{F.in[I_XP], F.in[I_XS], F.out, modl + 2 * D, F.H, F.in[I_N2G] + layer * D, modl + 4 * D, (float*)(F.ws + WS_SSQA), (PG8_LAS float*)(F.lds + RING_BYTES)};
            pg8::gemm_phase<EpiT, pg8::StaticOrder, true, true>(F.lds, g, S, E);
            SEAM(pb + 6);
        }
        if (SITE(14) && IN(pb + 8)) {
            pg8::Gemm g{F.H, w1t, M, FF, D, D, 256}; pg8::StaticOrder S; S.init(M, FF, F.G, (int)blockIdx.x, REPS_G3);
            pg8::EpiBf16N<1> E{(bf16*)(F.ws + WS_HID), FF, (const float*)(F.ws + WS_SSQA), (const float*)(F.ws + bw2o), FF};
            pg8::gemm_phase<pg8::EpiBf16N<1>, pg8::StaticOrder, true, true>(F.lds, g, S, E);
            SEAM(pb + 8);
        }
        if (SITE(15) && IN(pb + 9)) {
            pg8::Gemm g{(const bf16*)(F.ws + WS_HID), w2t, M, D, FF, FF, 256}; pg8::StaticOrder S; S.init(M, D, F.G, (int)blockIdx.x, 1, WGM_RES);
            typedef pg8::EpiResGateNormB<layer + 1 < DEPTH ? 1 : 2> EpiT;
            EpiT E{nullptr, F.in[I_XS], F.out, modl + 5 * D, layer + 1 < DEPTH ? F.H : nullptr, F.in[I_N1G] + (layer + 1 < DEPTH ? layer + 1 : 0) * D,
                   modl + (layer + 1 < DEPTH ? NSEQ * 12288 + D : 0), (float*)(F.ws + WS_SSQB), (PG8_LAS float*)(F.lds + RING_BYTES)};
            pg8::gemm_phase<EpiT, pg8::StaticOrder, true, true>(F.lds, g, S, E);
            SEAM(pb + 9);
        }
    }
#undef PREP_NEXT
__global__ void __launch_bounds__(NWAVES * 64, 2) trunk_fwd(Args args) {
    extern __shared__ __attribute__((aligned(16))) unsigned char lds_raw[];
    Frame F;
    F.lds = (LAS unsigned char*)lds_raw;
    F.tid = threadIdx.x; F.lane = F.tid & 63; F.wave = __builtin_amdgcn_readfirstlane(F.tid >> 6);
    F.G = gridDim.x; { const int bx = blockIdx.x; F.vcu = (F.G % 8 == 0) ? (bx % 8) * (F.G / 8) + bx / 8 : bx; }
    F.in = args.in; F.out = args.out; F.ws = args.ws;
    F.mod = (float*)(args.ws + WS_MOD); F.ropeA = (const f32x2*)(args.ws + WS_ROPE); F.ropeC = F.ropeA + 192 * 32;
    F.H = (bf16*)(args.ws + WS_H);
    for (int u = F.tid; u < (LDS_BYTES - LDSCTL_OFF) / 4; u += NWAVES * 64) ((LAS unsigned*)(F.lds + LDSCTL_OFF))[u] = 0u;
    __syncthreads();
    XcdBarrier bar; bar.bar = (unsigned*)(args.ws + WS_CTL) + CW_BAR; bar.x = 0; bar.st = nullptr;
    if (args.one_launch) bar = xcd_barrier_post((unsigned*)(args.ws + WS_CTL) + CW_BAR, (volatile LAS unsigned*)(F.lds + LDSCTL_OFF));
    const int lo = args.ph_lo, hi = args.ph_hi;

    if (SITE(0) && IN(0)) { ada_phase(F); rope_tables(F); prep_weights(F, 0, (unsigned*)(F.ws + WS_CTL) + CW_PREP); SEAM(0); }
    if (SITE(1) && IN(1)) { mod_finalize(F); score_bounds(F); SEAM(1); }

    layer_body<0>(F, bar, lo, hi, lds_raw); layer_body<1>(F, bar, lo, hi, lds_raw); layer_body<2>(F, bar, lo, hi, lds_raw); layer_body<3>(F, bar, lo, hi, lds_raw);
#undef IN
#undef SEAM
}

extern "C" void kernel_launch(void* const* d_in, const int* in_sizes, int n_in, void* d_out, int out_size, void* d_ws, size_t ws_size, hipStream_t stream) {
    static int grid = 0;
    if (grid == 0) {
        if (n_in != N_IN || out_size != M * D || ws_size < WS_END) { fprintf(stderr, "kernel_launch: unexpected shapes (n_in %d out %d ws %zu, need %zu)\n", n_in, out_size, ws_size, (size_t)WS_END); grid = -1; return; }
        int dev = 0, cus = 0, per_cu = 0;
        if (hipGetDevice(&dev) != hipSuccess || hipDeviceGetAttribute(&cus, hipDeviceAttributeMultiprocessorCount, dev) != hipSuccess) { grid = -1; return; }
        if (hipFuncSetAttribute((const void*)trunk_fwd, hipFuncAttributeMaxDynamicSharedMemorySize, LDS_BYTES) != hipSuccess) { fprintf(stderr, "kernel_launch: hipFuncSetAttribute failed\n"); grid = -1; return; }
        if (hipOccupancyMaxActiveBlocksPerMultiprocessor(&per_cu, (const void*)trunk_fwd, NWAVES * 64, LDS_BYTES) != hipSuccess || per_cu < 1) { fprintf(stderr, "kernel_launch: occupancy query says %d blocks per CU\n", per_cu); }
        (void)hipGetLastError();
        grid = cus;
    }
    if (grid < 0) return;
    (void)hipMemsetAsync((char*)d_ws + WS_CTL, 0, CTL_ZERO_BYTES, stream);
    Args a{};
    for (int i = 0; i < N_IN; ++i) a.in[i] = (const float*)d_in[i];
    a.out = (float*)d_out; a.ws = (unsigned char*)d_ws; a.pad = 0;
#if MK_ONE_LAUNCH
    a.ph_lo = 0; a.ph_hi = N_PHASE_IDS; a.one_launch = 1;
    hipLaunchKernelGGL(trunk_fwd, dim3(grid), dim3(NWAVES * 64), LDS_BYTES, stream, a);
#else
    for (int ph = 0; ph < N_PHASE_IDS; ++ph) { if (!phase_exists(ph)) continue;
        a.ph_lo = ph; a.ph_hi = ph + 1; a.one_launch = 0;
        hipLaunchKernelGGL(trunk_fwd, dim3(grid), dim3(NWAVES * 64), LDS_BYTES, stream, a); }
#endif
    const hipError_t le = hipPeekAtLastError();
    if (le != hipSuccess) fprintf(stderr, "kernel_launch: launch failed: %s\n", hipGetErrorName(le));
}
```

```cpp
#include <hip/hip_runtime.h>
#include <cstdio>
#include <cstdint>

#define GAS __attribute__((address_space(1)))
#define LAS __attribute__((address_space(3)))
#define PG8_LAS __attribute__((address_space(3)))

#ifndef MK_ONE_LAUNCH
#define MK_ONE_LAUNCH 1
#endif

constexpr int D = 2048, M = 65536, MP = 32768, NSEQ = 20, FF = 8192, DEPTH = 4;
constexpr float NORM_EPS = 1e-6f;
enum { I_XP = 0, I_XS, I_CP, I_CS, I_N1G, I_N2G, I_ADAW, I_ADAB, I_GQA_WQKV, I_GQA_QN, I_GQA_KN, I_GQA_WO, I_GLA_WIN, I_GLA_WG1, I_GLA_WG2, I_GLA_BG, I_GLA_ON, I_GLA_WO,
       I_MLA_WDOWN, I_MLA_QAN, I_MLA_KVAN, I_MLA_WUQ, I_MLA_WUKV, I_MLA_QN, I_MLA_KNN, I_MLA_KRN, I_MLA_WO, I_W1, I_W2, N_IN };

constexpr size_t MiB = 1u << 20;
constexpr size_t WS_CTL = 0, CTL_ZERO_BYTES = 1 * MiB;
constexpr size_t WS_MODP = 384 * MiB;
constexpr size_t WS_MOD = 16 * MiB;
constexpr size_t WS_BND = 20 * MiB - 4096;
constexpr size_t WS_ROPE = 20 * MiB;
constexpr size_t WS_BW1 = 20 * MiB + 256 * 1024, WS_BW2 = 21 * MiB;
constexpr size_t WS_BW1B = 26 * MiB, WS_BW2B = 26 * MiB + 768 * 1024;
constexpr size_t WS_SSQA = 22 * MiB, WS_SSQB = 24 * MiB;
constexpr size_t WS_W = 28 * MiB;
constexpr size_t WS_W1T = WS_W, WS_W2T = WS_W + 32 * MiB, WS_WMIX = WS_W + 64 * MiB;
constexpr size_t WS_WO_T = WS_WMIX + 26 * MiB;
constexpr size_t WS_H = 128 * MiB;
constexpr size_t WS_S = 384 * MiB;
constexpr size_t WS_QKV = WS_S;
constexpr size_t WS_PROJ = WS_S, WS_OB = WS_S + 800 * MiB;
constexpr size_t WS_DOWN = WS_S, WS_Q = WS_S + 128 * MiB, WS_KV = WS_S + 512 * MiB;
constexpr size_t WS_HID = WS_S;
constexpr size_t WS_WB = WS_S + 1056 * MiB;
constexpr size_t WS_END = WS_WB + 100 * MiB;
static_assert(WS_WO_T + 8 * MiB <= WS_H && WS_OB + 256 * MiB <= WS_END && WS_KV + 512 * MiB <= WS_END && WS_HID + 1024 * MiB <= WS_END, "ws map");
constexpr int CW_BAR = 4096;
constexpr int CW_PREP = 8192;

constexpr int RING_BYTES = 131072;
constexpr int LDSCTL_OFF = 144 * 1024 - 512;
constexpr int LDS_BYTES = 147456;

typedef unsigned short bf16;
typedef unsigned v4u __attribute__((ext_vector_type(4)));
typedef unsigned v2u __attribute__((ext_vector_type(2)));
typedef unsigned v3u __attribute__((ext_vector_type(3)));
typedef float f32x4 __attribute__((ext_vector_type(4)));
typedef float f32x2 __attribute__((ext_vector_type(2)));
typedef short bf16x8 __attribute__((ext_vector_type(8)));
typedef GAS unsigned gu32;
#define RLX_AGENT __ATOMIC_RELAXED, __HIP_MEMORY_SCOPE_AGENT
#define LDS_WAIT() asm volatile("s_waitcnt lgkmcnt(0)" ::: "memory")
#define VM_WAIT() asm volatile("s_waitcnt vmcnt(0)" ::: "memory")
__device__ __forceinline__ unsigned f2bf(float f) { unsigned u = __builtin_bit_cast(unsigned, f); return (u + 0x7fffu + ((u >> 16) & 1u)) >> 16; }
typedef __bf16 bf16x2_t __attribute__((ext_vector_type(2)));
__device__ __forceinline__ unsigned pk2c(float lo, float hi) { const f32x2 v = {lo, hi}; const bf16x2_t b = __builtin_convertvector(v, bf16x2_t); return __builtin_bit_cast(unsigned, b); }
__device__ __forceinline__ unsigned pk2(float lo, float hi) { unsigned r; asm volatile("v_cvt_pk_bf16_f32 %0, %1, %2" : "=v"(r) : "v"(lo), "v"(hi)); return r; }
__device__ __forceinline__ float bflo(unsigned u) { return __uint_as_float(u << 16); }
__device__ __forceinline__ float bfhi(unsigned u) { return __uint_as_float(u & 0xffff0000u); }
__device__ __forceinline__ int seq_of_row(int row) { return row < MP ? (row >> 11) : 16 + ((row - MP) >> 13); }
__device__ __forceinline__ int pos_of_row(int row) { return row < MP ? (row & 2047) : (row & 8191); }
__device__ __forceinline__ float wave_sum(float v) {
#pragma unroll
    for (int o = 1; o < 64; o <<= 1) v += __shfl_xor(v, o);
    return v;
}
namespace pg8 {
typedef unsigned short bf16_t;
typedef short bf16x8 __attribute__((ext_vector_type(8)));
typedef float f32x4 __attribute__((ext_vector_type(4)));
typedef unsigned u32x4 __attribute__((ext_vector_type(4)));
constexpr int BM = 256, BK = 64, HALF = 128, HTB = HALF * BK * 2  , STAGE_BYTES = 8 * HTB, NXCD = 8, WGM = 8;

__host__ __device__ __forceinline__ int lds_byte(int r, int c) { const int st = (r >> 4) * 2 + (c >> 5), rr = r & 15, cc = c & 31, ob = rr * 64 + cc * 2; return st * 1024 + (ob ^ (((ob >> 9) & 1) << 5)); }
__host__ __device__ __forceinline__ void stage_rc(int b, int& R, int& C) { const int st = b / 1024, sb = b % 1024, swz = sb ^ (((sb >> 9) & 1) << 5); R = (st >> 1) * 16 + swz / 64; C = (st & 1) * 32 + (swz % 64) / 2; }
__host__ __device__ __forceinline__ int perm32(int rho) { const int n = rho >> 4, i = rho & 15; return 8 * (i >> 2) + 4 * n + (i & 3); }

struct Unit { int pm, pn; };
struct Gemm { const bf16_t* A; const bf16_t* Bt; int M, N, K, lda, pairA; };

struct StaticOrder {
    int nM, nN, nwg, G, c, reps, wgm;
    __host__ __device__ void init(int M, int N, int G_, int c_, int reps_ = 1, int wgm_ = 4) { nM = M / BM; nN = N / BM; nwg = nM * nN; G = G_; c = c_; reps = reps_; wgm = wgm_; }
    __host__ __device__ bool next(int i, Unit& u) const {
        long L = (long)i * G + c; if (L >= (long)nwg * reps) return false;
        L %= nwg;
        int wgid = (int)L; { const int q = nwg / NXCD, r = nwg % NXCD, xcd = wgid % NXCD, off = wgid / NXCD; wgid = (xcd < r ? xcd * (q + 1) : r * (q + 1) + (xcd - r) * q) + off; }
        const int nig = wgm * nN, gid = wgid / nig, fm = gid * wgm, gsz = (nM - fm) < wgm ? (nM - fm) : wgm;
        u.pm = fm + ((wgid % nig) % gsz); u.pn = (wgid % nig) / gsz; return true;
    }
    __device__ __forceinline__ void a_ready(const Unit&) const {}
    __device__ __forceinline__ void done(const Unit&) const {}
};


__device__ __forceinline__ unsigned cvt_pk_bf16(float lo, float hi) { return ::pk2(lo, hi); }
template <int ACT> struct EpiBf16N {
    static constexpr bool PERM = true, AFTER_DRAIN = false, OWN_ALIGN = true;
    bf16_t* O; int ldc; const float* ssq; const float* bw; int ldbw;
    __device__ __forceinline__ void operator()(const f32x4 (&acc)[2][2][4][2], const Unit& u, int wr, int wc, int fr, int fq) const {
        const int rowt = u.pm * BM, row0 = rowt + wr * 64 + fr, col0 = u.pn * BM + wc * 32 + 8 * fq;
        const int seq = rowt < 32768 ? (rowt >> 11) : 16 + ((rowt - 32768) >> 13);
        typedef float f32x2v __attribute__((ext_vector_type(2)));
        f32x2v pv[8]; f32x4 bv[2][2];
#pragma unroll
        for (int i = 0; i < 8; ++i) pv[i] = *(const f32x2v*)(ssq + (size_t)(row0 + (i >> 2) * HALF + (i & 3) * 16) * 8 + 2 * fq);
#pragma unroll
        for (int bj = 0; bj < 2; ++bj)
#pragma unroll
            for (int n = 0; n < 2; ++n) bv[bj][n] = *(const f32x4*)(bw + (size_t)seq * ldbw + col0 + bj * HALF + 4 * n);
        asm volatile("" ::: "memory"); if (wr == 0) __builtin_amdgcn_s_barrier(); asm volatile("" ::: "memory");
        float rs[8];
#pragma unroll
        for (int i = 0; i < 8; ++i) { float s = pv[i].x + pv[i].y; s += __shfl_xor(s, 16); s += __shfl_xor(s, 32); rs[i] = __builtin_amdgcn_rsqf(s * (1.f / 2048.f) + 1e-6f); }
#pragma unroll
        for (int ai = 0; ai < 2; ++ai)
#pragma unroll
            for (int m = 0; m < 4; ++m) { const int r = row0 + ai * HALF + m * 16; const float rsr = rs[ai * 4 + m];
                bf16_t* rowp = O + (size_t)r * ldc + col0;
#pragma unroll
                for (int bj = 0; bj < 2; ++bj) { f32x4 v0 = acc[ai][bj][m][0] * rsr + bv[bj][0], v1 = acc[ai][bj][m][1] * rsr + bv[bj][1];
                    if (ACT == 1) {
#pragma unroll
                        for (int j = 0; j < 4; ++j) { const float a = fmaxf(v0[j], 0.f), b = fmaxf(v1[j], 0.f); v0[j] = a * a; v1[j] = b * b; } }
                    u32x4 w; w.x = cvt_pk_bf16(v0[0], v0[1]); w.y = cvt_pk_bf16(v0[2], v0[3]); w.z = cvt_pk_bf16(v1[0], v1[1]); w.w = cvt_pk_bf16(v1[2], v1[3]);
                    *(u32x4*)(rowp + bj * HALF) = w; } }
    }
};
struct EpiResGateNorm {
    static constexpr bool PERM = false, AFTER_DRAIN = false, OWN_ALIGN = false;
    const float* in0; const float* in1; float* out; const float* gate;
    bf16_t* xa; const float* gn; const float* sc; float* ssq; PG8_LAS float* xl;
    __device__ __forceinline__ void operator()(const f32x4 (&acc)[2][2][4][2], const Unit& u, int wr, int wc, int fr, int fq) const {
        const int rowt = u.pm * BM, row0 = rowt + wr * 64 + fr, col0 = u.pn * BM + wc * 32 + 4 * fq;
        const int seq = rowt < 32768 ? (rowt >> 11) : 16 + ((rowt - 32768) >> 13);
        const float* gp = gate + (size_t)seq * 12288 + col0;
        typedef unsigned u32x2 __attribute__((ext_vector_type(2)));
        u32x2 dp[2][2][4][2];
        {
            f32x4 gv[2][2];
#pragma unroll
            for (int bj = 0; bj < 2; ++bj)
#pragma unroll
                for (int n = 0; n < 2; ++n) gv[bj][n] = *(const f32x4*)(gp + bj * HALF + n * 16);
#pragma unroll
            for (int ai = 0; ai < 2; ++ai)
#pragma unroll
                for (int bj = 0; bj < 2; ++bj)
#pragma unroll
                    for (int m = 0; m < 4; ++m)
#pragma unroll
                        for (int n = 0; n < 2; ++n) { const f32x4 d = gv[bj][n] * acc[ai][bj][m][n]; dp[ai][bj][m][n] = (u32x2){cvt_pk_bf16(d[0], d[1]), cvt_pk_bf16(d[2], d[3])}; }
        }
        asm volatile("" ::: "memory");
        const float* base = in0 ? (rowt < 32768 ? in0 : in1 - (size_t)32768 * 2048) : out;
        f32x4 av[2][2];
#pragma unroll
        for (int bj = 0; bj < 2; ++bj)
#pragma unroll
            for (int n = 0; n < 2; ++n) { if (xa) av[bj][n] = *(const f32x4*)(gn + col0 + bj * HALF + n * 16) * (*(const f32x4*)(sc + (size_t)seq * 12288 + col0 + bj * HALF + n * 16) + 1.0f); else av[bj][n] = (f32x4){0.f, 0.f, 0.f, 0.f}; }
#pragma unroll
        for (int ai = 0; ai < 2; ++ai) {
            f32x4 bsv[4][2][2];
#pragma unroll
            for (int m = 0; m < 4; ++m)
#pragma unroll
                for (int bj = 0; bj < 2; ++bj)
#pragma unroll
                    for (int n = 0; n < 2; ++n) bsv[m][bj][n] = *(const f32x4*)(base + (size_t)(row0 + ai * HALF + m * 16) * 2048 + col0 + bj * HALF + n * 16);
            asm volatile("" ::: "memory");
#pragma unroll
            for (int m = 0; m < 4; ++m) { const size_t off = (size_t)(row0 + ai * HALF + m * 16) * 2048 + col0; float ss = 0.f;
#pragma unroll
                for (int bj = 0; bj < 2; ++bj)
#pragma unroll
                    for (int n = 0; n < 2; ++n) { const u32x2 dq = dp[ai][bj][m][n];
                        const f32x4 d = {__uint_as_float(dq.x << 16), __uint_as_float(dq.x & 0xffff0000u), __uint_as_float(dq.y << 16), __uint_as_float(dq.y & 0xffff0000u)};
                        const f32x4 o = bsv[m][bj][n] + d;
                        *(f32x4*)(out + off + bj * HALF + n * 16) = o;
                        if (xa) { const f32x4 y = o * av[bj][n]; ss += (o[0] * o[0] + o[1] * o[1]) + (o[2] * o[2] + o[3] * o[3]);
                            *(u32x2*)(xa + off + bj * HALF + n * 16) = (u32x2){cvt_pk_bf16(y[0], y[1]), cvt_pk_bf16(y[2], y[3])}; } }
                if (xa) { ss += __shfl_xor(ss, 16); ss += __shfl_xor(ss, 32);
                    if (fq == 0) xl[(ai * HALF + wr * 64 + m * 16 + fr) * 4 + wc] = ss; } }
            asm volatile("" ::: "memory");
        }
        if (xa) {
            asm volatile("s_waitcnt lgkmcnt(0)" ::: "memory"); __builtin_amdgcn_s_barrier(); asm volatile("" ::: "memory");
            const int t = threadIdx.x;
            if (t < 256) { const f32x4 p = *(const PG8_LAS f32x4*)(xl + t * 4); ssq[(size_t)(rowt + t) * 8 + u.pn] = (p[0] + p[1]) + (p[2] + p[3]); }
        }
    }
};
template <int MODE>
struct EpiResGateNormB {
    static constexpr bool PERM = true, AFTER_DRAIN = false, OWN_ALIGN = true;
    const float* in0; const float* in1; float* out; const float* gate;
    bf16_t* xa; const float* gn; const float* sc; float* ssq; PG8_LAS float* xl;
    static __device__ __forceinline__ void unpack(u32x4 w, f32x4& lo, f32x4& hi) {
        lo = (f32x4){__uint_as_float(w.x << 16), __uint_as_float(w.x & 0xffff0000u), __uint_as_float(w.y << 16), __uint_as_float(w.y & 0xffff0000u)};
        hi = (f32x4){__uint_as_float(w.z << 16), __uint_as_float(w.z & 0xffff0000u), __uint_as_float(w.w << 16), __uint_as_float(w.w & 0xffff0000u)};
    }
    static __device__ __forceinline__ u32x4 pack(f32x4 lo, f32x4 hi) { u32x4 w; w.x = cvt_pk_bf16(lo[0], lo[1]); w.y = cvt_pk_bf16(lo[2], lo[3]); w.z = cvt_pk_bf16(hi[0], hi[1]); w.w = cvt_pk_bf16(hi[2], hi[3]); return w; }
    __device__ __forceinline__ void operator()(const f32x4 (&acc)[2][2][4][2], const Unit& u, int wr, int wc, int fr, int fq) const {
        const int rowt = u.pm * BM, row0 = rowt + wr * 64 + fr, col0 = u.pn * BM + wc * 32 + 8 * fq;
        const int seq = rowt < 32768 ? (rowt >> 11) : 16 + ((rowt - 32768) >> 13);
        const float* gp = gate + (size_t)seq * 12288 + col0;
        bf16_t* const xb = (bf16_t*)out + (size_t)row0 * 4096 + u.pn * 512 + wc * 32 + 8 * fq;
        f32x4 gv[2][2], av[2][2];
        if constexpr (MODE == 0) {
            typedef unsigned u32x2 __attribute__((ext_vector_type(2)));
            u32x2 dp[2][2][4][2];
#pragma unroll
            for (int bj = 0; bj < 2; ++bj)
#pragma unroll
                for (int n = 0; n < 2; ++n) gv[bj][n] = *(const f32x4*)(gp + bj * HALF + 4 * n);
            asm volatile("" ::: "memory"); if (wr == 0) __builtin_amdgcn_s_barrier(); asm volatile("" ::: "memory");
#pragma unroll
            for (int ai = 0; ai < 2; ++ai)
#pragma unroll
                for (int bj = 0; bj < 2; ++bj)
#pragma unroll
                    for (int m = 0; m < 4; ++m)
#pragma unroll
                        for (int n = 0; n < 2; ++n) { const f32x4 d = gv[bj][n] * acc[ai][bj][m][n]; dp[ai][bj][m][n] = (u32x2){cvt_pk_bf16(d[0], d[1]), cvt_pk_bf16(d[2], d[3])}; }
            asm volatile("" ::: "memory");
#pragma unroll
            for (int bj = 0; bj < 2; ++bj)
#pragma unroll
                for (int n = 0; n < 2; ++n) av[bj][n] = *(const f32x4*)(sc + (size_t)seq * 12288 + col0 + bj * HALF + 4 * n);
            const float* base = rowt < 32768 ? in0 : in1 - (size_t)32768 * 2048;
#pragma unroll
            for (int ai = 0; ai < 2; ++ai) {
                f32x4 bsv[4][2][2];
#pragma unroll
                for (int m = 0; m < 4; ++m)
#pragma unroll
                    for (int bj = 0; bj < 2; ++bj)
#pragma unroll
                        for (int n = 0; n < 2; ++n) bsv[m][bj][n] = *(const f32x4*)(base + (size_t)(row0 + ai * HALF + m * 16) * 2048 + col0 + bj * HALF + 4 * n);
                asm volatile("" ::: "memory");
#pragma unroll
                for (int m = 0; m < 4; ++m) { const size_t off = (size_t)(row0 + ai * HALF + m * 16) * 2048 + col0; float ss = 0.f;
#pragma unroll
                    for (int bj = 0; bj < 2; ++bj) { f32x4 o[2];
#pragma unroll
                        for (int n = 0; n < 2; ++n) { const u32x2 dq = dp[ai][bj][m][n];
                            const f32x4 d = {__uint_as_float(dq.x << 16), __uint_as_float(dq.x & 0xffff0000u), __uint_as_float(dq.y << 16), __uint_as_float(dq.y & 0xffff0000u)};
                            o[n] = bsv[m][bj][n] + d; ss += (o[n][0] * o[n][0] + o[n][1] * o[n][1]) + (o[n][2] * o[n][2] + o[n][3] * o[n][3]); }
                        *(u32x4*)(xb + (size_t)(ai * HALF + m * 16) * 4096 + bj * HALF) = pack(o[0], o[1]);
                        *(u32x4*)(xa + off + bj * HALF) = pack(o[0] * av[bj][0], o[1] * av[bj][1]); }
                    ss += __shfl_xor(ss, 16); ss += __shfl_xor(ss, 32);
                    if (fq == 0) xl[(ai * HALF + wr * 64 + m * 16 + fr) * 4 + wc] = ss; }
                asm volatile("" ::: "memory");
            }
        } else {
            u32x4 xv[2][4][2], dpk[2][4][2];
#pragma unroll
            for (int bj = 0; bj < 2; ++bj)
#pragma unroll
                for (int n = 0; n < 2; ++n) gv[bj][n] = *(const f32x4*)(gp + bj * HALF + 4 * n);
#pragma unroll
            for (int m = 0; m < 4; ++m)
#pragma unroll
                for (int bj = 0; bj < 2; ++bj) xv[0][m][bj] = *(const u32x4*)(xb + (size_t)(m * 16) * 4096 + bj * HALF);
            asm volatile("" ::: "memory"); if (wr == 0) __builtin_amdgcn_s_barrier(); asm volatile("" ::: "memory");
#pragma unroll
            for (int ai = 0; ai < 2; ++ai)
#pragma unroll
                for (int m = 0; m < 4; ++m)
#pragma unroll
                    for (int bj = 0; bj < 2; ++bj) dpk[ai][m][bj] = pack(gv[bj][0] * acc[ai][bj][m][0], gv[bj][1] * acc[ai][bj][m][1]);
            asm volatile("" ::: "memory");
#pragma unroll
            for (int bj = 0; bj < 2; ++bj)
#pragma unroll
                for (int n = 0; n < 2; ++n) { if constexpr (MODE == 1) av[bj][n] = *(const f32x4*)(sc + (size_t)seq * 12288 + col0 + bj * HALF + 4 * n); else av[bj][n] = (f32x4){0.f, 0.f, 0.f, 0.f}; }
#pragma unroll
            for (int m = 0; m < 4; ++m)
#pragma unroll
                for (int bj = 0; bj < 2; ++bj) xv[1][m][bj] = *(const u32x4*)(xb + (size_t)(HALF + m * 16) * 4096 + bj * HALF);
            if constexpr (MODE == 2) { asm volatile("s_waitcnt vmcnt(0)" ::: "memory"); __builtin_amdgcn_s_barrier(); }
            asm volatile("" ::: "memory");
#pragma unroll
            for (int ai = 0; ai < 2; ++ai) {
#pragma unroll
                for (int m = 0; m < 4; ++m) { const size_t off = (size_t)(row0 + ai * HALF + m * 16) * 2048 + col0; float ss = 0.f;
#pragma unroll
                    for (int bj = 0; bj < 2; ++bj) { f32x4 o[2], d[2]; unpack(xv[ai][m][bj], o[0], o[1]); unpack(dpk[ai][m][bj], d[0], d[1]); o[0] += d[0]; o[1] += d[1];
                        if constexpr (MODE == 2) { *(f32x4*)(out + off + bj * HALF) = o[0]; *(f32x4*)(out + off + bj * HALF + 4) = o[1]; }
                        else {
#pragma unroll
                            for (int n = 0; n < 2; ++n) ss += (o[n][0] * o[n][0] + o[n][1] * o[n][1]) + (o[n][2] * o[n][2] + o[n][3] * o[n][3]);
                            *(u32x4*)(xb + (size_t)(ai * HALF + m * 16) * 4096 + bj * HALF) = pack(o[0], o[1]);
                            *(u32x4*)(xa + off + bj * HALF) = pack(o[0] * av[bj][0], o[1] * av[bj][1]); } }
                    if constexpr (MODE != 2) { ss += __shfl_xor(ss, 16); ss += __shfl_xor(ss, 32);
                        if (fq == 0) xl[(ai * HALF + wr * 64 + m * 16 + fr) * 4 + wc] = ss; } }
                asm volatile("" ::: "memory");
            }
        }
        if constexpr (MODE != 2) {
            asm volatile("s_waitcnt lgkmcnt(0)" ::: "memory"); __builtin_amdgcn_s_barrier(); asm volatile("" ::: "memory");
            const int t = threadIdx.x;
            if (t < 256) { const f32x4 p = *(const PG8_LAS f32x4*)(xl + t * 4); ssq[(size_t)(rowt + t) * 8 + u.pn] = (p[0] + p[1]) + (p[2] + p[3]); }
        }
    }
};
constexpr float QSCALE = 0.088388347648318440f * 1.4426950408889634f;
struct EpiBf16NRope {
    static constexpr bool PERM = true, AFTER_DRAIN = false, OWN_ALIGN = true;
    bf16_t* O; int ldc; const float* ssq; const float* bw; int ldbw;
    const float* qg; const float* kg; const float* rope; PG8_LAS float* hs;
    __device__ __forceinline__ void operator()(f32x4 (&acc)[2][2][4][2], const Unit& u, int wr, int wc, int fr, int fq) const {
        const int rowt = u.pm * BM, row0 = rowt + wr * 64 + fr, col0 = u.pn * BM + wc * 32 + 8 * fq;
        const int seq = rowt < 32768 ? (rowt >> 11) : 16 + ((rowt - 32768) >> 13);
        const bool roped = u.pn < 10;
        typedef float f32x2v __attribute__((ext_vector_type(2)));
        f32x2v pv[8]; f32x4 bv[2][2], gv[2];
#pragma unroll
        for (int i = 0; i < 8; ++i) pv[i] = *(const f32x2v*)(ssq + (size_t)(row0 + (i >> 2) * HALF + (i & 3) * 16) * 8 + 2 * fq);
#pragma unroll
        for (int bj = 0; bj < 2; ++bj)
#pragma unroll
            for (int n = 0; n < 2; ++n) bv[bj][n] = *(const f32x4*)(bw + (size_t)seq * ldbw + col0 + bj * HALF + 4 * n);
        { const float* g = (u.pn < 8 ? qg : kg) + wc * 32 + 8 * fq; gv[0] = *(const f32x4*)g; gv[1] = *(const f32x4*)(g + 4);
          if (u.pn < 8) { gv[0] *= QSCALE; gv[1] *= QSCALE; } }
        asm volatile("" ::: "memory"); if (wr == 0) __builtin_amdgcn_s_barrier(); asm volatile("" ::: "memory");
        float rs[8];
#pragma unroll
        for (int i = 0; i < 8; ++i) { float s = pv[i].x + pv[i].y; s += __shfl_xor(s, 16); s += __shfl_xor(s, 32); rs[i] = __builtin_amdgcn_rsqf(s * (1.f / 2048.f) + 1e-6f); }
#pragma unroll
        for (int ai = 0; ai < 2; ++ai)
#pragma unroll
            for (int m = 0; m < 4; ++m)
#pragma unroll
                for (int bj = 0; bj < 2; ++bj) { const float rsr = rs[ai * 4 + m];
                    acc[ai][bj][m][0] = acc[ai][bj][m][0] * rsr + bv[bj][0]; acc[ai][bj][m][1] = acc[ai][bj][m][1] * rsr + bv[bj][1];
                    if (roped) { const f32x4 a = acc[ai][bj][m][0], b = acc[ai][bj][m][1];
                        float s = ((a[0] * a[0] + a[1] * a[1]) + (a[2] * a[2] + a[3] * a[3])) + ((b[0] * b[0] + b[1] * b[1]) + (b[2] * b[2] + b[3] * b[3]));
                        s += __shfl_xor(s, 16); s += __shfl_xor(s, 32);
                        if (fq == 0) hs[((ai * HALF + wr * 64 + m * 16 + fr) * 2 + bj) * 4 + wc] = s; } }
        if (roped) { asm volatile("s_waitcnt lgkmcnt(0)" ::: "memory"); __builtin_amdgcn_s_barrier(); asm volatile("" ::: "memory"); }
#pragma unroll
        for (int ai = 0; ai < 2; ++ai) {
            f32x4 cs[4][2];
            if (roped) {
#pragma unroll
                for (int m = 0; m < 4; ++m) { const int r = row0 + ai * HALF + m * 16, t = r < 32768 ? (r & 2047) : (r & 8191);
                    const float* rp = rope + (size_t)((wc < 2 ? (t >> 6) : 128 + (t & 63)) * 32 + (wc & 1) * 16 + 4 * fq) * 2;
                    cs[m][0] = *(const f32x4*)rp; cs[m][1] = *(const f32x4*)(rp + 4); }
            }
#pragma unroll
            for (int m = 0; m < 4; ++m) { const int r = row0 + ai * HALF + m * 16; bf16_t* rowp = O + (size_t)r * ldc + col0;
#pragma unroll
                for (int bj = 0; bj < 2; ++bj) { f32x4 v0 = acc[ai][bj][m][0], v1 = acc[ai][bj][m][1];
                    if (roped) { const f32x4 hp = *(const PG8_LAS f32x4*)(hs + ((ai * HALF + wr * 64 + m * 16 + fr) * 2 + bj) * 4);
                        const float hr = __builtin_amdgcn_rsqf(((hp[0] + hp[1]) + (hp[2] + hp[3])) * (1.f / 128.f) + 1e-6f);
                        v0 = v0 * hr * gv[0]; v1 = v1 * hr * gv[1];
                        const f32x4 c0 = cs[m][0], c1 = cs[m][1];
                        const float a0 = v0[0] * c0[0] - v0[1] * c0[1], a1 = v0[0] * c0[1] + v0[1] * c0[0], a2 = v0[2] * c0[2] - v0[3] * c0[3], a3 = v0[2] * c0[3] + v0[3] * c0[2];
                        const float b0 = v1[0] * c1[0] - v1[1] * c1[1], b1 = v1[0] * c1[1] + v1[1] * c1[0], b2 = v1[2] * c1[2] - v1[3] * c1[3], b3 = v1[2] * c1[3] + v1[3] * c1[2];
                        v0 = (f32x4){a0, a1, a2, a3}; v1 = (f32x4){b0, b1, b2, b3}; }
                    u32x4 w; w.x = cvt_pk_bf16(v0[0], v0[1]); w.y = cvt_pk_bf16(v0[2], v0[3]); w.z = cvt_pk_bf16(v1[0], v1[1]); w.w = cvt_pk_bf16(v1[2], v1[3]);
                    *(u32x4*)(rowp + bj * HALF) = w; } }
        }
    }
};
struct EpiBf16KV {
    static constexpr bool PERM = true, AFTER_DRAIN = false, OWN_ALIGN = false;
    bf16_t* O; int ldc; const float* kg; PG8_LAS float* hs;
    __device__ __forceinline__ void operator()(const f32x4 (&acc)[2][2][4][2], const Unit& u, int wr, int wc, int fr, int fq) const {
        const int row0 = u.pm * BM + wr * 64 + fr, col0 = u.pn * BM + wc * 32 + 8 * fq;
        const f32x4 g0 = *(const f32x4*)(kg + wc * 32 + 8 * fq), g1 = *(const f32x4*)(kg + wc * 32 + 8 * fq + 4);
#pragma unroll
        for (int ai = 0; ai < 2; ++ai)
#pragma unroll
            for (int m = 0; m < 4; ++m) { const f32x4 a = acc[ai][0][m][0], b = acc[ai][0][m][1];
                float s = ((a[0] * a[0] + a[1] * a[1]) + (a[2] * a[2] + a[3] * a[3])) + ((b[0] * b[0] + b[1] * b[1]) + (b[2] * b[2] + b[3] * b[3]));
                s += __shfl_xor(s, 16); s += __shfl_xor(s, 32);
                if (fq == 0) hs[(ai * HALF + wr * 64 + m * 16 + fr) * 4 + wc] = s; }
#pragma unroll
        for (int ai = 0; ai < 2; ++ai)
#pragma unroll
            for (int m = 0; m < 4; ++m) { bf16_t* rowp = O + (size_t)(row0 + ai * HALF + m * 16) * ldc + col0 + HALF;
                const f32x4 v0 = acc[ai][1][m][0], v1 = acc[ai][1][m][1];
                u32x4 w; w.x = cvt_pk_bf16(v0[0], v0[1]); w.y = cvt_pk_bf16(v0[2], v0[3]); w.z = cvt_pk_bf16(v1[0], v1[1]); w.w = cvt_pk_bf16(v1[2], v1[3]); *(u32x4*)rowp = w; }
        asm volatile("s_waitcnt lgkmcnt(0)" ::: "memory"); __builtin_amdgcn_s_barrier(); asm volatile("" ::: "memory");
#pragma unroll
        for (int ai = 0; ai < 2; ++ai)
#pragma unroll
            for (int m = 0; m < 4; ++m) { bf16_t* rowp = O + (size_t)(row0 + ai * HALF + m * 16) * ldc + col0;
                const f32x4 hp = *(const PG8_LAS f32x4*)(hs + (ai * HALF + wr * 64 + m * 16 + fr) * 4);
                const float hr = __builtin_amdgcn_rsqf(((hp[0] + hp[1]) + (hp[2] + hp[3])) * (1.f / 128.f) + 1e-6f);
                const f32x4 v0 = acc[ai][0][m][0] * hr * g0, v1 = acc[ai][0][m][1] * hr * g1;
                u32x4 w; w.x = cvt_pk_bf16(v0[0], v0[1]); w.y = cvt_pk_bf16(v0[2], v0[3]); w.z = cvt_pk_bf16(v1[0], v1[1]); w.w = cvt_pk_bf16(v1[2], v1[3]); *(u32x4*)rowp = w; }
    }
};
struct EpiBf16P {
    static constexpr bool PERM = true, AFTER_DRAIN = false, OWN_ALIGN = false;
    bf16_t* O; int ldc;
    __device__ __forceinline__ void operator()(const f32x4 (&acc)[2][2][4][2], const Unit& u, int wr, int wc, int fr, int fq) const {
        const int row0 = u.pm * BM + wr * 64 + fr, col0 = u.pn * BM + wc * 32 + 8 * fq;
#pragma unroll
        for (int ai = 0; ai < 2; ++ai)
#pragma unroll
            for (int m = 0; m < 4; ++m) { bf16_t* rowp = O + (size_t)(row0 + ai * HALF + m * 16) * ldc + col0;
#pragma unroll
                for (int bj = 0; bj < 2; ++bj) { const f32x4 v0 = acc[ai][bj][m][0], v1 = acc[ai][bj][m][1];
                    u32x4 w; w.x = cvt_pk_bf16(v0[0], v0[1]); w.y = cvt_pk_bf16(v0[2], v0[3]); w.z = cvt_pk_bf16(v1[0], v1[1]); w.w = cvt_pk_bf16(v1[2], v1[3]);
                    *(u32x4*)(rowp + bj * HALF) = w; } }
    }
};
template <class Epi, class Sched, bool ALIGN_EPI = false, bool SP2 = false>
__device__ __forceinline__ void gemm_phase(PG8_LAS unsigned char* lds, const Gemm g, const Sched& S, const Epi& E) {
    const int tid = threadIdx.x, wid = __builtin_amdgcn_readfirstlane(tid >> 6), lane = tid & 63, wr = wid >> 2, wc = wid & 3, fr = lane & 15, fq = lane >> 4;
    const int K = g.K, nt = K / BK;
    unsigned voffA[2], voffB[2];
#pragma unroll
    for (int i = 0; i < 2; ++i) { int R, C; stage_rc(tid * 16 + i * 8192, R, C); const int Rb = Epi::PERM ? ((R & ~31) + perm32(R & 31)) : R;
        voffA[i] = (unsigned)(R * g.lda + C) * 2u; voffB[i] = (unsigned)(Rb * K + C) * 2u; }
    const size_t kstep = (size_t)(BK * 2);
    const size_t hstepB = (size_t)HALF * K * 2, hstepA = (size_t)HALF * g.lda * 2;
    const size_t tstepA = 2 * hstepA, tstepB = 2 * hstepB;
    const unsigned ldsw = (unsigned)wid * 1024u;
    const int aoff = lds_byte(wr * 64 + fr, fq * 8), boff = lds_byte(wc * 32 + fr, fq * 8);
#define PG8_SA(b, h) (((b) * 2 + (h)) * HTB)
#define PG8_SB(b, h) ((4 + (b) * 2 + (h)) * HTB)
#define PG8_STAGE(bufoff, gbase, voff) do { _Pragma("unroll") for (int _i = 0; _i < 2; ++_i) \
        __builtin_amdgcn_global_load_lds((const unsigned*)((const char*)(gbase) + (voff)[_i]), (PG8_LAS unsigned*)(lds + (bufoff) + ldsw + _i * 8192), 16, 0, 0); } while (0)
#define PG8_LDA(dst, b, h) do { _Pragma("unroll") for (int m = 0; m < 4; ++m) _Pragma("unroll") for (int k = 0; k < 2; ++k) dst[m][k] = *(const PG8_LAS bf16x8*)(lds + PG8_SA(b, h) + aoff + m * 2048 + k * 1024); } while (0)
#define PG8_LDB(dst, b, h) do { _Pragma("unroll") for (int n = 0; n < 2; ++n) _Pragma("unroll") for (int k = 0; k < 2; ++k) dst[n][k] = *(const PG8_LAS bf16x8*)(lds + PG8_SB(b, h) + boff + n * 2048 + k * 1024); } while (0)
#define PG8_MMA(ai, bj, At, Bt) do { __builtin_amdgcn_s_setprio(1); _Pragma("unroll") for (int m = 0; m < 4; ++m) _Pragma("unroll") for (int n = 0; n < 2; ++n) _Pragma("unroll") for (int k = 0; k < 2; ++k) \
        acc[ai][bj][m][n] = __builtin_amdgcn_mfma_f32_16x16x32_bf16(Bt[n][k], At[m][k], acc[ai][bj][m][n], 0, 0, 0); __builtin_amdgcn_s_setprio(0); } while (0)
#define PG8_WAIT_V(n) asm volatile("s_waitcnt vmcnt(" #n ")" ::: "memory")
#define PG8_WAIT_L(n) asm volatile("s_waitcnt lgkmcnt(" #n ")" ::: "memory")
#define PG8_BAR __builtin_amdgcn_s_barrier()
#define PG8_SCHED __builtin_amdgcn_sched_barrier(0)
    Unit cur, nxt; int ui = 0;
    if (!S.next(0, cur)) return;
    f32x4 acc[2][2][4][2];
#pragma unroll
    for (int a = 0; a < 2; ++a)
#pragma unroll
        for (int b = 0; b < 2; ++b)
#pragma unroll
            for (int m = 0; m < 4; ++m)
#pragma unroll
                for (int n = 0; n < 2; ++n) acc[a][b][m][n] = (f32x4){0.f, 0.f, 0.f, 0.f};
    bf16x8 At[4][2], B0[2][2], B1[2][2];
    const char* cA = (const char*)g.A + (size_t)cur.pm * tstepA; const char* cB = (const char*)g.Bt + (size_t)cur.pn * tstepB;
    S.a_ready(cur);
    if constexpr (SP2) {
        PG8_STAGE(PG8_SB(0, 0), cB, voffB); PG8_STAGE(PG8_SB(0, 1), cB + hstepB, voffB); PG8_STAGE(PG8_SA(0, 0), cA, voffA); PG8_STAGE(PG8_SA(0, 1), cA + hstepA, voffA);
        if (wr == 1) PG8_BAR;
        PG8_WAIT_V(2); PG8_BAR;
        PG8_STAGE(PG8_SB(1, 0), cB + kstep, voffB); PG8_STAGE(PG8_SA(1, 0), cA + kstep, voffA); PG8_STAGE(PG8_SB(1, 1), cB + hstepB + kstep, voffB);
        PG8_WAIT_V(6); PG8_BAR;
    } else {
        PG8_STAGE(PG8_SB(0, 0), cB, voffB); PG8_STAGE(PG8_SA(0, 0), cA, voffA); PG8_STAGE(PG8_SB(0, 1), cB + hstepB, voffB); PG8_STAGE(PG8_SA(0, 1), cA + hstepA, voffA);
        if (wr == 1) PG8_BAR;
        PG8_WAIT_V(4); PG8_BAR;
        PG8_STAGE(PG8_SB(1, 0), cB + kstep, voffB); PG8_STAGE(PG8_SA(1, 0), cA + kstep, voffA); PG8_STAGE(PG8_SB(1, 1), cB + hstepB + kstep, voffB);
        PG8_WAIT_V(6); PG8_BAR;
    }
    for (;;) {
        const bool has_next = S.next(ui + 1, nxt);
        const char* nA = has_next ? (const char*)g.A + (size_t)nxt.pm * tstepA : cA; const char* nB = has_next ? (const char*)g.Bt + (size_t)nxt.pn * tstepB : cB;
        for (int t = 0; t < nt; t += 2) {
            const bool last = (t == nt - 2);
            const char* a1 = cA + (size_t)(t >> 1) * g.pairA + kstep;
            const char* a2 = last ? nA : cA + (size_t)((t >> 1) + 1) * g.pairA; const char* b2 = last ? nB : cB + (size_t)(t + 2) * kstep;
            const char* a3 = a2 + kstep; const char* b3 = b2 + kstep;
            if (last && has_next) S.a_ready(nxt);
            if constexpr (SP2) {
            PG8_LDB(B0, 0, 0); PG8_LDB(B1, 0, 1); PG8_SCHED; PG8_LDA(At, 0, 0); PG8_STAGE(PG8_SA(1, 1), a1 + hstepA, voffA);
            PG8_WAIT_V(8); PG8_WAIT_L(0); PG8_BAR; PG8_MMA(0, 0, At, B0); PG8_MMA(0, 1, At, B1); PG8_BAR; PG8_SCHED;
            PG8_LDA(At, 0, 1); PG8_STAGE(PG8_SB(0, 0), b2, voffB); PG8_STAGE(PG8_SB(0, 1), b2 + hstepB, voffB); PG8_STAGE(PG8_SA(0, 0), a2, voffA);
            PG8_WAIT_V(8); PG8_WAIT_L(0); PG8_BAR; PG8_MMA(1, 0, At, B0); PG8_MMA(1, 1, At, B1); PG8_BAR; PG8_SCHED;
            PG8_LDB(B0, 1, 0); PG8_LDB(B1, 1, 1); PG8_SCHED; PG8_LDA(At, 1, 0); PG8_STAGE(PG8_SA(0, 1), a2 + hstepA, voffA);
            PG8_WAIT_V(8); PG8_WAIT_L(0); PG8_BAR; PG8_MMA(0, 0, At, B0); PG8_MMA(0, 1, At, B1); PG8_BAR; PG8_SCHED;
            PG8_LDA(At, 1, 1); PG8_STAGE(PG8_SB(1, 0), b3, voffB); PG8_STAGE(PG8_SB(1, 1), b3 + hstepB, voffB); PG8_STAGE(PG8_SA(1, 0), a3, voffA);
            PG8_WAIT_V(8); PG8_WAIT_L(0); PG8_BAR; PG8_MMA(1, 0, At, B0); PG8_MMA(1, 1, At, B1); PG8_BAR; PG8_SCHED;
            } else {
            PG8_LDB(B0, 0, 0); PG8_SCHED; PG8_LDA(At, 0, 0); PG8_STAGE(PG8_SA(1, 1), a1 + hstepA, voffA);
            PG8_WAIT_L(8); PG8_BAR; PG8_WAIT_L(0); PG8_MMA(0, 0, At, B0); PG8_BAR; PG8_SCHED;
            PG8_LDB(B1, 0, 1); PG8_STAGE(PG8_SB(0, 0), b2, voffB);
            PG8_BAR; PG8_WAIT_L(0); PG8_MMA(0, 1, At, B1); PG8_BAR;
            PG8_LDA(At, 0, 1); PG8_STAGE(PG8_SA(0, 0), a2, voffA);
            PG8_BAR; PG8_WAIT_L(0); PG8_MMA(1, 0, At, B0); PG8_BAR; PG8_SCHED;
            PG8_STAGE(PG8_SB(0, 1), b2 + hstepB, voffB);
            PG8_WAIT_V(6); PG8_BAR; PG8_MMA(1, 1, At, B1); PG8_BAR;
            PG8_LDB(B0, 1, 0); PG8_SCHED; PG8_LDA(At, 1, 0); PG8_STAGE(PG8_SA(0, 1), a2 + hstepA, voffA);
            PG8_WAIT_L(8); PG8_BAR; PG8_WAIT_L(0); PG8_MMA(0, 0, At, B0); PG8_BAR; PG8_SCHED;
            PG8_LDB(B1, 1, 1); PG8_STAGE(PG8_SB(1, 0), b3, voffB);
            PG8_BAR; PG8_WAIT_L(0); PG8_MMA(0, 1, At, B1); PG8_BAR;
            PG8_LDA(At, 1, 1); PG8_STAGE(PG8_SA(1, 0), a3, voffA);
            PG8_BAR; PG8_WAIT_L(0); PG8_MMA(1, 0, At, B0); PG8_BAR; PG8_SCHED;
            PG8_STAGE(PG8_SB(1, 1), b3 + hstepB, voffB);
            PG8_WAIT_V(6); PG8_BAR; PG8_MMA(1, 1, At, B1); PG8_BAR;
            }
        }
        if constexpr (ALIGN_EPI && !Epi::OWN_ALIGN) { if (wr == 0) PG8_BAR; }
        if constexpr (!Epi::AFTER_DRAIN) { E(acc, cur, wr, wc, fr, fq); S.done(cur); }
        if (!has_next) break;
#pragma unroll
        for (int a = 0; a < 2; ++a)
#pragma unroll
            for (int b = 0; b < 2; ++b)
#pragma unroll
                for (int m = 0; m < 4; ++m)
#pragma unroll
                    for (int n = 0; n < 2; ++n) acc[a][b][m][n] = (f32x4){0.f, 0.f, 0.f, 0.f};
        cur = nxt; cA = nA; cB = nB; ++ui;
        if constexpr (ALIGN_EPI) { if (wr == 1) PG8_BAR; }
    }
    PG8_WAIT_V(0);
    if constexpr (!ALIGN_EPI) { if (wr == 0) PG8_BAR; }
    PG8_BAR;
    if constexpr (Epi::AFTER_DRAIN) { E.fused(acc, cur, wr, wc, fr, fq, lds, wid, lane); S.done(cur); }
#undef PG8_SA
#undef PG8_SB
#undef PG8_STAGE
#undef PG8_LDA
#undef PG8_LDB
#undef PG8_MMA
#undef PG8_WAIT_V
#undef PG8_WAIT_L
#undef PG8_BAR
#undef PG8_SCHED
}
}

namespace attn {
using bf16x8 = __attribute__((ext_vector_type(8))) short;
using s16x4  = __attribute__((ext_vector_type(4))) short;
using f32x16 = __attribute__((ext_vector_type(16))) float;
using u32x4  = __attribute__((ext_vector_type(4))) unsigned;
using f32x4  = __attribute__((ext_vector_type(4))) float;
constexpr int NW = 8, QBLK = 32, KVBLK = 64;
constexpr float THR = 8.f;
#define SBAR() __builtin_amdgcn_sched_barrier(0)
__device__ __forceinline__ int crow(int r, int hi) { return (r & 3) + 8 * (r >> 2) + 4 * hi; }
__device__ __forceinline__ unsigned cvtpk(float lo, float hi) { unsigned r; asm volatile("v_cvt_pk_bf16_f32 %0, %1, %2\n\ts_nop 1" : "=v"(r) : "v"(lo), "v"(hi)); return r; }
template <bool VIS> __device__ __forceinline__ unsigned cvtpk_t(float lo, float hi) { if constexpr (VIS) return ::pk2c(lo, hi); else return cvtpk(lo, hi); }

template <int DQK> struct Cfg {
    static constexpr int KROW = DQK * 2;
    static constexpr int SHM_K = KVBLK * KROW, SHM_V = KVBLK * 128 * 2;
    static constexpr int NQR = DQK == 128 ? 8 : 6;
    static constexpr int QX_WAVE = (DQK / 16 - NQR) * 1024;
    static constexpr int SHM = 2 * SHM_V + 2 * SHM_K + NW * 64 * 4 + NW * QX_WAVE;
    static constexpr float SCALE = DQK == 128 ? 0.088388347648318440f : 0.072168783648703220f;
    static constexpr float C = SCALE * 1.4426950408889634f;
};
template <int DQK> __device__ __forceinline__ int kswz(int row, int colB) { return row * (DQK * 2) + (colB ^ ((row & 7) << 4)); }

template <int DQK, bool NOMAX = false> __device__ __forceinline__ void partialSM(f32x16& p0, f32x16& p1, float& m_reg, float& mn, float& alpha, float shiftC = 0.f) {
  constexpr float THRS = THR * 1.4426950408889634f;
  if constexpr (NOMAX) {
    alpha = 1.f; mn = 0.f;
#pragma unroll
    for (int r = 0; r < 16; ++r) p0[r] = __builtin_amdgcn_exp2f(p0[r]);
    return;
  }
  float pmax = p0[0];
#pragma unroll
  for (int r = 1; r < 16; ++r) pmax = fmaxf(pmax, p0[r]);
#pragma unroll
  for (int r = 0; r < 16; ++r) pmax = fmaxf(pmax, p1[r]);
  { auto rr = __builtin_amdgcn_permlane32_swap(__float_as_uint(pmax), __float_as_uint(pmax), false, false);
    pmax = fmaxf(__uint_as_float(rr[0]), __uint_as_float(rr[1])); }
  if (__builtin_expect(__all(pmax - m_reg <= THRS), 1)) { mn = m_reg; alpha = 1.f; }
  else { mn = fmaxf(m_reg, pmax); alpha = __builtin_amdgcn_exp2f(m_reg - mn); m_reg = mn; }
#pragma unroll
  for (int r = 0; r < 16; ++r) p0[r] = p0[r] - mn;
#pragma unroll
  for (int r = 0; r < 16; ++r) p1[r] = p1[r] - mn;
#pragma unroll
  for (int r = 0; r < 16; ++r) p0[r] = __builtin_amdgcn_exp2f(p0[r]);
}
template <bool VIS> __device__ __forceinline__ void finishSM(f32x16& p0, f32x16& p1, float alpha, float& l_reg, bf16x8& pa0, bf16x8& pa1, bf16x8& pa2, bf16x8& pa3) {
#pragma unroll
  for (int r = 0; r < 16; ++r) p1[r] = __builtin_amdgcn_exp2f(p1[r]);
  float ps = 0;
#pragma unroll
  for (int r = 0; r < 16; ++r) ps += p0[r];
#pragma unroll
  for (int r = 0; r < 16; ++r) ps += p1[r];
  { auto rr = __builtin_amdgcn_permlane32_swap(__float_as_uint(ps), __float_as_uint(ps), false, false);
    ps = __uint_as_float(rr[0]) + __uint_as_float(rr[1]); }
  l_reg = l_reg * alpha + ps;
#define PK4(P, BASE, OUT) do { unsigned a0 = cvtpk_t<VIS>(P[BASE + 0], P[BASE + 1]), a1 = cvtpk_t<VIS>(P[BASE + 2], P[BASE + 3]);   \
    unsigned b0 = cvtpk_t<VIS>(P[BASE + 4], P[BASE + 5]), b1 = cvtpk_t<VIS>(P[BASE + 6], P[BASE + 7]);                              \
    auto r0 = __builtin_amdgcn_permlane32_swap(a0, b0, false, false); auto r1 = __builtin_amdgcn_permlane32_swap(a1, b1, false, false); \
    u32x4 w = {r0[0], r1[0], r0[1], r1[1]}; OUT = *reinterpret_cast<bf16x8*>(&w); } while (0)
  PK4(p0, 0, pa0); PK4(p0, 8, pa1); PK4(p1, 0, pa2); PK4(p1, 8, pa3);
#undef PK4
}
template <int DQK, int NQR> __device__ __forceinline__ void qkt(f32x16& p0, f32x16& p1, const char* Ks, const bf16x8* qr, const char* qx, int r32, int hi) {
  p0 = f32x16{}; p1 = f32x16{};
#pragma unroll
  for (int d0 = 0; d0 < DQK / 16; ++d0) { const int cb = (d0 * 16 + hi * 8) * 2;
    bf16x8 b0 = *reinterpret_cast<const bf16x8*>(Ks + kswz<DQK>(r32, cb));
    bf16x8 b1 = *reinterpret_cast<const bf16x8*>(Ks + kswz<DQK>(32 + r32, cb));
    bf16x8 q; if (d0 < NQR) q = qr[d0]; else q = *reinterpret_cast<const bf16x8*>(qx + (d0 - NQR) * 1024);
    p0 = __builtin_amdgcn_mfma_f32_32x32x16_bf16(b0, q, p0, 0, 0, 0);
    p1 = __builtin_amdgcn_mfma_f32_32x32x16_bf16(b1, q, p1, 0, 0, 0);
    if (DQK > 128 && (d0 & 3) == 3 && d0 + 1 < DQK / 16) SBAR(); }
}
__device__ __forceinline__ int v_st(int k, int c) { const int kk = (k & ~0xC) | ((k & 4) << 1) | ((k & 8) >> 1); return ((kk >> 3) * 4 + (c >> 5)) * 512 + ((kk & 7) * 32 + (c & 31)) * 2; }
__device__ __forceinline__ int v_rd_base(int lane) { return ((lane & 3) << 3) | (((lane >> 2) & 3) << 6) | (((lane >> 4) & 1) << 5) | (((lane >> 5) & 1) << 8); }
constexpr int v_rd_off(int d0, int ks, int half) { return d0 * 512 + ks * 4096 + half * 2048; }
template <int OFF> __device__ __forceinline__ s16x4 tr_read(int vb) {
  s16x4 r; asm volatile("ds_read_b64_tr_b16 %0, %1 offset:%2" : "=&v"(r) : "v"(vb), "i"(OFF) : "memory"); return r;
}
template <int D0> __device__ __forceinline__ void pv_one(f32x16& od, int vb, bf16x8 pa0, bf16x8 pa1, bf16x8 pa2, bf16x8 pa3) {
  const s16x4 l0 = tr_read<v_rd_off(D0, 0, 0)>(vb), h0 = tr_read<v_rd_off(D0, 0, 1)>(vb), l1 = tr_read<v_rd_off(D0, 1, 0)>(vb), h1 = tr_read<v_rd_off(D0, 1, 1)>(vb);
  const s16x4 l2 = tr_read<v_rd_off(D0, 2, 0)>(vb), h2 = tr_read<v_rd_off(D0, 2, 1)>(vb), l3 = tr_read<v_rd_off(D0, 3, 0)>(vb), h3 = tr_read<v_rd_off(D0, 3, 1)>(vb);
  asm volatile("s_waitcnt lgkmcnt(0)" ::: "memory"); SBAR();
#define PK(L, H) (bf16x8){L[0], L[1], L[2], L[3], H[0], H[1], H[2], H[3]}
  od = __builtin_amdgcn_mfma_f32_32x32x16_bf16(pa0, PK(l0, h0), od, 0, 0, 0);
  od = __builtin_amdgcn_mfma_f32_32x32x16_bf16(pa1, PK(l1, h1), od, 0, 0, 0);
  od = __builtin_amdgcn_mfma_f32_32x32x16_bf16(pa2, PK(l2, h2), od, 0, 0, 0);
  od = __builtin_amdgcn_mfma_f32_32x32x16_bf16(pa3, PK(l3, h3), od, 0, 0, 0);
#undef PK
}
__device__ __forceinline__ void pv_d0(f32x16* o, int vb, bf16x8 pa0, bf16x8 pa1, bf16x8 pa2, bf16x8 pa3) {
  pv_one<0>(o[0], vb, pa0, pa1, pa2, pa3); pv_one<1>(o[1], vb, pa0, pa1, pa2, pa3); pv_one<2>(o[2], vb, pa0, pa1, pa2, pa3); pv_one<3>(o[3], vb, pa0, pa1, pa2, pa3);
}

template <int DQK, int LDQ, int LDK, int LDKR, int LDV, int LDO, int SDEPTH, bool QNORM = false, bool NOMAX = false>
__device__ __forceinline__ void attn_dense_body(const bf16* __restrict__ Qb, const bf16* __restrict__ Kh, const bf16* __restrict__ KRh, const bf16* __restrict__ Vh,
                                                bf16* __restrict__ Ob, int seq, char* lds, const float* qgain = nullptr, const float* ropetab = nullptr, int tq0 = 0, float shiftC = 0.f) {
  constexpr int SHM_V = Cfg<DQK>::SHM_V, SHM_K = Cfg<DQK>::SHM_K; constexpr float SCALE = Cfg<DQK>::SCALE;
  constexpr bool ROPE = (DQK == 192);
  const int tid = threadIdx.x, wid = tid >> 6, lane = tid & 63, r32 = lane & 31, hi = lane >> 5;
  char* V_lds = lds; char* K_lds = lds + 2 * SHM_V;
  float* ws = (float*)(lds + 2 * SHM_V + 2 * SHM_K) + wid * 64; float* li_l = ws; float* al_l = ws + 32;
  constexpr int NQR = Cfg<DQK>::NQR;
  float m_reg = -1e30f, l_reg = 0; f32x16 o[4] = {}; bf16x8 qr[NQR];
  const bf16* Qw = Qb + (long)(wid * QBLK + r32) * LDQ + hi * 8;
  char* qx = lds + 2 * SHM_V + 2 * SHM_K + NW * 64 * 4 + wid * Cfg<DQK>::QX_WAVE + lane * 16;
  if constexpr (!QNORM) {
#pragma unroll
    for (int d0 = 0; d0 < NQR; ++d0) qr[d0] = *reinterpret_cast<const bf16x8*>(Qw + d0 * 16);
#pragma unroll
    for (int d0 = NQR; d0 < DQK / 16; ++d0) *reinterpret_cast<bf16x8*>(qx + (d0 - NQR) * 1024) = *reinterpret_cast<const bf16x8*>(Qw + d0 * 16);
  } else {
    float ss = 0.f;
#pragma unroll
    for (int d0 = 0; d0 < DQK / 16; ++d0) { const u32x4 rw = *reinterpret_cast<const u32x4*>(Qw + d0 * 16);
#pragma unroll
      for (int w = 0; w < 4; ++w) { const float a = __uint_as_float(rw[w] << 16), b = __uint_as_float(rw[w] & 0xffff0000u); ss += a * a + b * b; } }
    asm volatile("" ::: "memory");
    { auto rr = __builtin_amdgcn_permlane32_swap(__float_as_uint(ss), __float_as_uint(ss), false, false); ss = __uint_as_float(rr[0]) + __uint_as_float(rr[1]); }
    const float rsn = __builtin_amdgcn_rsqf(ss * (1.f / DQK) + 1e-6f) * Cfg<DQK>::C;
    const int tpos = tq0 + wid * QBLK + r32, eri = tpos >> 6, eci = 128 + (tpos & 63);
#pragma unroll
    for (int d0 = 0; d0 < DQK / 16; ++d0) {
      const f32x4 g0 = *reinterpret_cast<const f32x4*>(qgain + d0 * 16 + hi * 8), g1 = *reinterpret_cast<const f32x4*>(qgain + d0 * 16 + hi * 8 + 4);
      const u32x4 rw = *reinterpret_cast<const u32x4*>(Qw + d0 * 16);
      float x[8];
#pragma unroll
      for (int w = 0; w < 4; ++w) { x[2 * w] = __uint_as_float(rw[w] << 16) * rsn; x[2 * w + 1] = __uint_as_float(rw[w] & 0xffff0000u) * rsn; }
      x[0] *= g0[0]; x[1] *= g0[1]; x[2] *= g0[2]; x[3] *= g0[3]; x[4] *= g1[0]; x[5] *= g1[1]; x[6] *= g1[2]; x[7] *= g1[3];
      if (d0 >= 8) {
        const float* rp = ropetab + (size_t)((d0 < 10 ? eri : eci) * 16 + ((d0 - 8) & 1) * 8 + hi * 4) * 2;
        const f32x4 c0 = *reinterpret_cast<const f32x4*>(rp), c1 = *reinterpret_cast<const f32x4*>(rp + 4);
        const float a0 = x[0] * c0[0] - x[1] * c0[1], a1 = x[0] * c0[1] + x[1] * c0[0], a2 = x[2] * c0[2] - x[3] * c0[3], a3 = x[2] * c0[3] + x[3] * c0[2];
        const float a4 = x[4] * c1[0] - x[5] * c1[1], a5 = x[4] * c1[1] + x[5] * c1[0], a6 = x[6] * c1[2] - x[7] * c1[3], a7 = x[6] * c1[3] + x[7] * c1[2];
        x[0] = a0; x[1] = a1; x[2] = a2; x[3] = a3; x[4] = a4; x[5] = a5; x[6] = a6; x[7] = a7;
      }
      u32x4 w4 = {cvtpk(x[0], x[1]), cvtpk(x[2], x[3]), cvtpk(x[4], x[5]), cvtpk(x[6], x[7])};
      if (d0 < NQR) qr[d0 < NQR ? d0 : 0] = *reinterpret_cast<bf16x8*>(&w4); else *reinterpret_cast<bf16x8*>(qx + (d0 - NQR) * 1024) = *reinterpret_cast<bf16x8*>(&w4);
    }
  }
  const int sr = tid >> 4, sc = (tid & 15) * 8, vst0 = v_st(sr, sc), vst1 = v_st(32 + sr, sc);
  const int rr = tid >> 3, rc = (tid & 7) * 8;
  const int vb0 = (int)(uintptr_t)V_lds + v_rd_base(lane);
  struct { bf16x8 vs0, vs1, ks0, ks1, kr; } sr_[SDEPTH];
  const unsigned offV = (unsigned)(sr * LDV + sc) * 2u, offK = (unsigned)(sr * LDK + sc) * 2u, offR = (unsigned)(rr * LDKR + rc) * 2u;
#define SLOAD(i, k0) do { const char* vb_ = (const char*)Vh + (size_t)(k0) * (LDV * 2); const char* kb_ = (const char*)Kh + (size_t)(k0) * (LDK * 2); \
    sr_[i].vs0 = *reinterpret_cast<const bf16x8*>(vb_ + offV); sr_[i].vs1 = *reinterpret_cast<const bf16x8*>(vb_ + (size_t)32 * LDV * 2 + offV); \
    sr_[i].ks0 = *reinterpret_cast<const bf16x8*>(kb_ + offK); sr_[i].ks1 = *reinterpret_cast<const bf16x8*>(kb_ + (size_t)32 * LDK * 2 + offK); \
    if constexpr (ROPE) sr_[i].kr = *reinterpret_cast<const bf16x8*>((const char*)KRh + (size_t)(k0) * (LDKR * 2) + offR); } while (0)
#define SWRITE(b, i) do { *(bf16x8*)(V_lds + (b) * SHM_V + vst0) = sr_[i].vs0;          \
    *(bf16x8*)(V_lds + (b) * SHM_V + vst1) = sr_[i].vs1; const int kc = sc * 2;               \
    *(bf16x8*)(K_lds + (b) * SHM_K + kswz<DQK>(sr, kc)) = sr_[i].ks0;                       \
    *(bf16x8*)(K_lds + (b) * SHM_K + kswz<DQK>(32 + sr, kc)) = sr_[i].ks1;                   \
    if constexpr (ROPE) *(bf16x8*)(K_lds + (b) * SHM_K + kswz<DQK>(rr, 256 + rc * 2)) = sr_[i].kr; } while (0)
#define SWAIT() do { if constexpr (SDEPTH == 2) { if constexpr (ROPE) asm volatile("s_waitcnt vmcnt(5)" ::: "memory"); else asm volatile("s_waitcnt vmcnt(4)" ::: "memory"); } else asm volatile("s_waitcnt vmcnt(0)" ::: "memory"); } while (0)
#define RESC(a) do { if constexpr (!NOMAX) if (__any((a) < 1.f)) { if (hi == 0) al_l[r32] = (a); asm volatile("s_waitcnt lgkmcnt(0)" ::: "memory"); \
    _Pragma("unroll") for (int d = 0; d < 4; ++d) _Pragma("unroll") for (int r = 0; r < 16; ++r) o[d][r] *= al_l[crow(r, hi)]; } } while (0)
  f32x16 pA0, pA1, pB0, pB1; float mnA, mnB, alA, alB; bf16x8 pa0, pa1, pa2, pa3; const int NT = seq / KVBLK;
  constexpr int SE = 0, SO = SDEPTH - 1;
  SLOAD(SE, 0); asm volatile("s_waitcnt vmcnt(0)" ::: "memory"); SWRITE(0, SE); __syncthreads();
  qkt<DQK, NQR>(pA0, pA1, K_lds, qr, qx, r32, hi); partialSM<DQK, NOMAX>(pA0, pA1, m_reg, mnA, alA, shiftC);
  SLOAD(SO, KVBLK); if constexpr (SDEPTH == 2) { if (2 < NT) SLOAD(SE, 2 * KVBLK); }
  SWAIT(); SWRITE(1, SO); __syncthreads();
  for (int j = 1; j + 1 < NT; j += 2) {
    SBAR(); qkt<DQK, NQR>(pB0, pB1, K_lds + SHM_K, qr, qx, r32, hi);
    finishSM<true>(pA0, pA1, alA, l_reg, pa0, pa1, pa2, pa3); SBAR();
    SLOAD(SO, (j + SDEPTH) * KVBLK); SBAR();
    pv_d0(o, vb0, pa0, pa1, pa2, pa3); partialSM<DQK, NOMAX>(pB0, pB1, m_reg, mnB, alB, shiftC);
    __syncthreads(); SWAIT(); SWRITE(0, SE);
    RESC(alB); __syncthreads();
    SBAR(); qkt<DQK, NQR>(pA0, pA1, K_lds, qr, qx, r32, hi);
    finishSM<true>(pB0, pB1, alB, l_reg, pa0, pa1, pa2, pa3); SBAR();
    if (SDEPTH == 1 || j + 3 < NT) SLOAD(SE, (j + 1 + SDEPTH) * KVBLK); SBAR();
    pv_d0(o, vb0 + SHM_V, pa0, pa1, pa2, pa3); partialSM<DQK, NOMAX>(pA0, pA1, m_reg, mnA, alA, shiftC);
    __syncthreads(); SWAIT(); SWRITE(1, SO);
    RESC(alA); __syncthreads();
  }
  SBAR(); qkt<DQK, NQR>(pB0, pB1, K_lds + SHM_K, qr, qx, r32, hi);
  finishSM<true>(pA0, pA1, alA, l_reg, pa0, pa1, pa2, pa3); SBAR();
  pv_d0(o, vb0, pa0, pa1, pa2, pa3); partialSM<DQK, NOMAX>(pB0, pB1, m_reg, mnB, alB, shiftC);
  __syncthreads(); RESC(alB);
  finishSM<true>(pB0, pB1, alB, l_reg, pa0, pa1, pa2, pa3); SBAR();
  pv_d0(o, vb0 + SHM_V, pa0, pa1, pa2, pa3);
  { int w2 = tid; asm volatile("" : "+v"(w2)); li_l = (float*)(lds + 2 * SHM_V + 2 * SHM_K) + (w2 >> 6) * 64; }
  if (hi == 0) li_l[r32] = l_reg; asm volatile("s_waitcnt lgkmcnt(0)" ::: "memory");
  float rli[16];
#pragma unroll
  for (int r = 0; r < 16; ++r) rli[r] = __builtin_amdgcn_rcpf(li_l[crow(r, hi)]);
  bf16* Ow = Ob + (long)(wid * QBLK) * LDO;
#pragma unroll
  for (int r = 0; r < 16; ++r) { const int orow = crow(r, hi);
#pragma unroll
    for (int d0 = 0; d0 < 4; ++d0) Ow[(long)orow * LDO + d0 * 32 + r32] = (bf16)(cvtpk(o[d0][r] * rli[r], 0.f) & 0xffffu); }
  __syncthreads();
#undef SLOAD
#undef SWRITE
#undef SWAIT
#undef RESC
}
}
#define XB_TMO      128
#define XB_XCNT(j)  (256  + 64 * (j))
#define XB_XSUB(j)  (1280 + 64 * (j))
#define XB_XGEN(j)  (2304 + 64 * (j))
#define XB_TOP      3328
#define XB_TOPGEN   3392
#define XCD_BAR_WORDS 3456
#define XB_SPIN_CAP (1u << 18)

__device__ __forceinline__ unsigned xb_ld(unsigned* p)              { return __hip_atomic_load(p, __ATOMIC_RELAXED, __HIP_MEMORY_SCOPE_AGENT); }
__device__ __forceinline__ unsigned xb_add(unsigned* p, unsigned v) { return __hip_atomic_fetch_add(p, v, __ATOMIC_RELAXED, __HIP_MEMORY_SCOPE_AGENT); }
__device__ __forceinline__ unsigned xb_xcc_id() { return (unsigned)__builtin_amdgcn_s_getreg((3 << 11) | 20) & 0xFu; }
#define XB_SPIN(cond, bar) do { unsigned _sp = 0; while (cond) { __builtin_amdgcn_s_sleep(1); \
    if ((++_sp & 255u) == 0u) { if (xb_ld(&(bar)[XB_TMO])) break; if (_sp > XB_SPIN_CAP) { atomicAdd(&(bar)[XB_TMO], 1u); break; } } } } while (0)

struct XcdBarrier {
    unsigned* bar; unsigned x;
    volatile LAS unsigned* st;
};

__device__ __forceinline__ XcdBarrier xcd_barrier_post(unsigned* bar, volatile LAS unsigned* st) {
    XcdBarrier b; b.bar = bar; b.x = xb_xcc_id(); b.st = st;
    if (threadIdx.x == 0) (void)xb_add(&bar[XB_XCNT(b.x)], 1u);
    return b;
}
__device__ __forceinline__ void xcd_barrier_complete(unsigned* bar, unsigned x, unsigned& nloc, unsigned& nx) {
    const unsigned G = gridDim.x * gridDim.y * gridDim.z;
    unsigned sum, cnt, mine, sp = 0u;
    for (;;) {
        sum = 0u; cnt = 0u; mine = 0u;
#pragma unroll
        for (unsigned j = 0; j < 16; ++j) { const unsigned c = xb_ld(&bar[XB_XCNT(j)]); sum += c; cnt += (c > 0u) ? 1u : 0u; mine = (j == x) ? c : mine; }
        if (sum == G) break;
        __builtin_amdgcn_s_sleep(1);
        if ((++sp & 255u) == 0u) { if (xb_ld(&bar[XB_TMO])) break; if (sp > XB_SPIN_CAP) { atomicAdd(&bar[XB_TMO], 1u); break; } }
    }
    nloc = mine > 0u ? mine : 1u; nx = cnt > 0u ? cnt : 1u;
}

__device__ __forceinline__ void xcd_barrier(const XcdBarrier& b) {
    asm volatile("s_waitcnt vmcnt(0)" ::: "memory");
    __syncthreads();
    if (threadIdx.x == 0) {
        unsigned* bar = b.bar; asm volatile("" : "+s"(bar));
        __builtin_amdgcn_s_waitcnt(0);
        unsigned nloc = b.st[0], nx = b.st[1];
        if (nloc == 0u) { xcd_barrier_complete(bar, b.x, nloc, nx); b.st[0] = nloc; b.st[1] = nx; }
        const unsigned old = xb_add(&bar[XB_XSUB(b.x)], 1u);
        const unsigned gen = old / nloc;
        if (old + 1u == (gen + 1u) * nloc) {
            __builtin_amdgcn_fence(__ATOMIC_RELEASE, "agent");
            asm volatile("s_waitcnt vmcnt(0)" ::: "memory");
            const unsigned og = xb_add(&bar[XB_TOP], 1u);
            const unsigned tg = og / nx;
            if (og + 1u == (tg + 1u) * nx) xb_add(&bar[XB_TOPGEN], 1u);
            else XB_SPIN(xb_ld(&bar[XB_TOPGEN]) == tg, bar);
            __builtin_amdgcn_fence(__ATOMIC_ACQUIRE, "agent");
            xb_add(&bar[XB_XGEN(b.x)], 1u);
            asm volatile("s_waitcnt vmcnt(0)" ::: "memory");
        } else {
            XB_SPIN(xb_ld(&bar[XB_XGEN(b.x)]) == gen, bar);
            __builtin_amdgcn_fence(__ATOMIC_ACQUIRE, "agent");
            asm volatile("s_waitcnt vmcnt(0)" ::: "memory");
        }
    }
    __syncthreads();
}

struct Args { const float* in[N_IN]; float* out; unsigned char* ws; int ph_lo, ph_hi, one_launch, pad; };
struct Frame {
    LAS unsigned char* lds;
    int tid, lane, wave, vcu, G;
    const float* const* in;
    float* out; unsigned char* ws;
    float* mod; const f32x2* ropeA; const f32x2* ropeC;
    bf16* H;
};
constexpr int NWAVES = 8;
__device__ __forceinline__ int fresh_lane() { int l; asm volatile("v_mbcnt_lo_u32_b32 %0, -1, 0\n\tv_mbcnt_hi_u32_b32 %0, -1, %0" : "=v"(l)); return l; }

__device__ __forceinline__ void transpose_item(const float* W, int ldw, int K, int N, bf16* WT, int row_off, float scale, LAS float* scr, int item, int lane) {
    const int nblk = N / 32, kb = item / nblk, nb = item % nblk, k0 = 64 * kb, n0 = 32 * nb;
#pragma unroll 8
    for (int i = 0; i < 32; ++i) { const int kk = 2 * i + (lane >> 5); scr[kk * 33 + (lane & 31)] = W[(size_t)(k0 + kk) * ldw + n0 + (lane & 31)] * scale; }
    LDS_WAIT(); asm volatile("" ::: "memory");
    const int c = lane & 7;
#pragma unroll
    for (int j = 0; j < 4; ++j) { const int n = (lane >> 3) + 8 * j; const LAS float* s = scr + (8 * c) * 33 + n;
        v4u o; o.x = pk2(s[0 * 33], s[1 * 33]); o.y = pk2(s[2 * 33], s[3 * 33]); o.z = pk2(s[4 * 33], s[5 * 33]); o.w = pk2(s[6 * 33], s[7 * 33]);
        *(GAS v4u*)(WT + (size_t)(row_off + n0 + n) * K + k0 + 8 * c) = o; }
    LDS_WAIT(); asm volatile("" ::: "memory");
}
struct ItemSrc { unsigned* head; int cur, step; };
__device__ __forceinline__ void item_next(ItemSrc& S) {
    if (S.head) { unsigned v = 0; if ((threadIdx.x & 63) == 0) v = __hip_atomic_fetch_add(S.head, 1u, __ATOMIC_RELAXED, __HIP_MEMORY_SCOPE_AGENT); S.cur = (int)__builtin_amdgcn_readfirstlane(v); }
    else S.cur += S.step;
}
__device__ __forceinline__ int transpose_matrix(Frame& F, ItemSrc& S, int base, const float* W, int ldw, int K, int N, bf16* WT, int row_off, float scale) {
    LAS float* scr = (LAS float*)(F.lds + F.wave * 16384);
    const int nit = (K / 64) * (N / 32), nb = (nit + 7) / 8;
    while (S.cur < base + nb) { const int i0 = (S.cur - base) * 8, i1 = i0 + 8 < nit ? i0 + 8 : nit;
        for (int it = i0; it < i1; ++it) transpose_item(W, ldw, K, N, WT, row_off, scale, scr, it, F.lane);
        item_next(S); }
    return base + nb;
}
__device__ __forceinline__ void zero_rows(Frame& F, bf16* WT, int row0, int nrows, int K) {
    const size_t n16 = (size_t)nrows * K / 8; GAS v4u* p = (GAS v4u*)(WT + (size_t)row0 * K);
    for (size_t i = (size_t)(F.vcu * NWAVES + F.wave) * 64 + F.lane; i < n16; i += (size_t)F.G * NWAVES * 64) p[i] = (v4u){0u, 0u, 0u, 0u};
}
__device__ __forceinline__ void prep_weights(Frame& F, int layer, unsigned* head) {
    F.lane = fresh_lane();
    const int kind = layer % 3, j = layer / 3;
    unsigned char* wr = F.ws + ((layer & 1) ? WS_WB : WS_W);
    bf16* w1t = (bf16*)wr; bf16* w2t = (bf16*)(wr + 32 * MiB); bf16* wmix = (bf16*)(wr + 64 * MiB); bf16* wot = (bf16*)(wr + 90 * MiB);
    if (kind == 1) {
        const float* g1 = F.in[I_GLA_WG1];
        for (int i = (F.vcu * NWAVES + F.wave) * 64 + F.lane; i < 2 * 16 * D; i += F.G * NWAVES * 64) { const int k = i % D, nr = i / D, n = nr >> 4, r = nr & 15;
            wmix[(size_t)(6144 + nr) * D + k] = (bf16)f2bf(g1[((size_t)n * D + k) * 16 + r]); }
        zero_rows(F, wmix, 6176, 224, D);
    } else if (kind == 2) zero_rows(F, wmix, 832, 192, D);
    ItemSrc S; S.head = head; S.step = F.G * NWAVES; S.cur = F.vcu * NWAVES + F.wave;
    if (head) item_next(S);
    int b = 0;
    b = transpose_matrix(F, S, b, F.in[I_W1] + (size_t)layer * D * FF, FF, D, FF, w1t, 0, 1.f);
    b = transpose_matrix(F, S, b, F.in[I_W2] + (size_t)layer * FF * D, D, FF, D, w2t, 0, 1.f);
    if (kind == 0) {
        b = transpose_matrix(F, S, b, F.in[I_GQA_WQKV] + (size_t)j * D * 3072, 3072, D, 3072, wmix, 0, 1.f);
        b = transpose_matrix(F, S, b, F.in[I_GQA_WO] + (size_t)j * D * D, D, D, D, wot, 0, 1.f);
    } else if (kind == 1) {
        const float* win = F.in[I_GLA_WIN];
        b = transpose_matrix(F, S, b, win, 6144, D, 1024, wmix, 0, 0.0625f);
        b = transpose_matrix(F, S, b, win + 1024, 6144, D, 5120, wmix, 1024, 1.f);
        b = transpose_matrix(F, S, b, F.in[I_GLA_WO], D, D, D, wot, 0, 1.f);
    } else {
        b = transpose_matrix(F, S, b, F.in[I_MLA_WDOWN], 832, D, 832, wmix, 0, 1.f);
        b = transpose_matrix(F, S, b, F.in[I_MLA_WUQ], 3072, 512, 3072, wmix + (size_t)4 * MiB / 2, 0, 1.f);
        b = transpose_matrix(F, S, b, F.in[I_MLA_WUKV], 4096, 256, 4096, wmix + (size_t)8 * MiB / 2, 0, 1.f);
        b = transpose_matrix(F, S, b, F.in[I_MLA_WO], D, D, D, wot, 0, 1.f);
    }
    (void)b;
}
__device__ __forceinline__ void ada_phase(Frame& F) {
    F.lane = fresh_lane();
    LAS float* cond = (LAS float*)(F.lds);
    float* modp = (float*)(F.ws + WS_MODP);
    const float* cp = F.in[I_CP]; const float* cs = F.in[I_CS]; const float* aw = F.in[I_ADAW];
    for (int item = F.vcu; item < 4 * 24 * 4; item += F.G) {
        const int kq = item & 3, cg = (item >> 2) % 24, l = item / 96;
        __syncthreads();
        for (int i = F.tid; i < 512 * NSEQ; i += 512) { const int k = i / NSEQ, s = i % NSEQ; const float c = s < 16 ? cp[s * D + kq * 512 + k] : cs[(s - 16) * D + kq * 512 + k];
            cond[i] = c / (1.f + __expf(-c)); }
        __syncthreads();
        const int col = cg * 512 + F.wave * 64 + F.lane;
        const float* wp = aw + ((size_t)l * D + kq * 512) * 12288 + col;
        float acc[NSEQ];
#pragma unroll
        for (int s = 0; s < NSEQ; ++s) acc[s] = 0.f;
        for (int k0 = 0; k0 < 512; k0 += 8) {
            float wv[8];
#pragma unroll
            for (int u = 0; u < 8; ++u) wv[u] = wp[(size_t)(k0 + u) * 12288];
#pragma unroll
            for (int u = 0; u < 8; ++u) { const LAS f32x4* cr = (const LAS f32x4*)(cond + (k0 + u) * NSEQ);
#pragma unroll
                for (int q = 0; q < 5; ++q) { const f32x4 cv = cr[q]; acc[4 * q] += cv.x * wv[u]; acc[4 * q + 1] += cv.y * wv[u]; acc[4 * q + 2] += cv.z * wv[u]; acc[4 * q + 3] += cv.w * wv[u]; } }
        }
#pragma unroll
        for (int s = 0; s < NSEQ; ++s) modp[(((size_t)kq * DEPTH + l) * NSEQ + s) * 12288 + col] = acc[s];
    }
    __syncthreads();
}
__device__ __forceinline__ void rope_tables(Frame& F) {
    F.lane = fresh_lane();
    f32x2* ra = (f32x2*)(F.ws + WS_ROPE); f32x2* rc = ra + 192 * 32;
    for (int i = (F.vcu * NWAVES + F.wave) * 64 + F.lane; i < 192 * 48; i += F.G * NWAVES * 64) {
        const int e = i / 48, f = i % 48; const double idx = (double)(e < 128 ? e : e - 128);
        const double inv = f < 32 ? pow(10000.0, -(double)f / 32.0) : pow(10000.0, -(double)(f - 32) / 16.0);
        const double a = idx * inv; const f32x2 v = {(float)cos(a), (float)sin(a)};
        if (f < 32) ra[e * 32 + f] = v; else rc[e * 16 + (f - 32)] = v;
    }
}
__device__ __forceinline__ void score_bounds(Frame& F) {
    if (F.vcu != 0 || F.wave != 0) return;
    const int l = F.tid & 63; float* bnd = (float*)(F.ws + WS_BND);
    auto wmax = [](float v) { for (int o = 1; o < 64; o <<= 1) v = fmaxf(v, __shfl_xor(v, o)); return v; };
    for (int j = 0; j < 2; ++j) {
        const float gq = wmax(fmaxf(fabsf(F.in[I_GQA_QN][j * 128 + l]), fabsf(F.in[I_GQA_QN][j * 128 + 64 + l]))), gk = wmax(fmaxf(fabsf(F.in[I_GQA_KN][j * 128 + l]), fabsf(F.in[I_GQA_KN][j * 128 + 64 + l])));
        if (l == 0) bnd[j] = 11.313708499f * gq * gk * (1.02f * 1.4426950408889634f); }
    const float gq = wmax(fmaxf(fmaxf(fabsf(F.in[I_MLA_QN][l]), fabsf(F.in[I_MLA_QN][64 + l])), fabsf(F.in[I_MLA_QN][128 + l])));
    const float gkn = wmax(fmaxf(fabsf(F.in[I_MLA_KNN][l]), fabsf(F.in[I_MLA_KNN][64 + l]))), gkr = wmax(fabsf(F.in[I_MLA_KRN][l]));
    if (l == 0) bnd[2] = gq * sqrtf(128.f * gkn * gkn + 64.f * gkr * gkr) * (1.02f * 1.4426950408889634f);
}
__device__ __forceinline__ void mod_finalize(Frame& F) {
    F.lane = fresh_lane();
    const float* modp = (const float*)(F.ws + WS_MODP); const float* ab = F.in[I_ADAB];
    constexpr int NTOT = DEPTH * NSEQ * 12288, Q = NTOT;
    for (int i = (F.vcu * NWAVES + F.wave) * 64 + F.lane; i < NTOT; i += F.G * NWAVES * 64) { const int l = i / (NSEQ * 12288), n = i % 12288;
        float v = ab[l * 12288 + n] + ((modp[i] + modp[i + Q]) + (modp[i + 2 * Q] + modp[i + 3 * Q]));
        const int slot = n >> 11; if (slot == 1) v = F.in[I_N1G][l * D + (n & 2047)] * (1.0f + v); else if (slot == 4) v = F.in[I_N2G][l * D + (n & 2047)] * (1.0f + v);
        F.mod[i] = v; }
}
__device__ __forceinline__ void norm0_phase(Frame& F) {
    F.lane = fresh_lane();
    const int gw = F.vcu * NWAVES + F.wave, NGW = F.G * NWAVES;
    float* ssq = (float*)(F.ws + WS_SSQB);
    for (int item = gw; item < M / 32; item += NGW) {
        const int row0 = item * 32, seq = seq_of_row(row0);
        const float* mp = F.mod + (size_t)seq * 12288;
        f32x4 A[8];
#pragma unroll
        for (int j = 0; j < 8; ++j) { const int c = j * 256 + F.lane * 4; A[j] = *(const f32x4*)(mp + D + c); }
        const float* xb = row0 < MP ? F.in[I_XP] + (size_t)row0 * D : F.in[I_XS] + (size_t)(row0 - MP) * D;
        bf16* hb = F.H + (size_t)row0 * D;
        for (int r = 0; r < 32; r += 2) {
            f32x4 v0[8], v1[8]; float s0 = 0.f, s1 = 0.f;
#pragma unroll
            for (int j = 0; j < 8; ++j) { v0[j] = *(const GAS f32x4*)(xb + (size_t)r * D + j * 256 + F.lane * 4); v1[j] = *(const GAS f32x4*)(xb + (size_t)(r + 1) * D + j * 256 + F.lane * 4); }
#pragma unroll
            for (int j = 0; j < 8; ++j) { s0 += (v0[j].x * v0[j].x + v0[j].y * v0[j].y) + (v0[j].z * v0[j].z + v0[j].w * v0[j].w); s1 += (v1[j].x * v1[j].x + v1[j].y * v1[j].y) + (v1[j].z * v1[j].z + v1[j].w * v1[j].w); }
            s0 = wave_sum(s0); s1 = wave_sum(s1);
            if (F.lane < 16) { const int rr = row0 + r + (F.lane >> 3), sl = F.lane & 7; ssq[(size_t)rr * 8 + sl] = sl == 0 ? ((F.lane >> 3) ? s1 : s0) : 0.f; }
#pragma unroll
            for (int j = 0; j < 8; ++j) { const f32x4 a = v0[j] * A[j], b = v1[j] * A[j];
                *(GAS v2u*)(hb + (size_t)r * D + j * 256 + F.lane * 4) = (v2u){pk2(a.x, a.y), pk2(a.z, a.w)};
                *(GAS v2u*)(hb + (size_t)(r + 1) * D + j * 256 + F.lane * 4) = (v2u){pk2(b.x, b.y), pk2(b.z, b.w)}; }
        }
    }
}
__device__ __forceinline__ void gemv20_item(Frame& F, const float* shift  , const float* W, int ldw, int ncols, float scale, float* out, int ldo, int c0) {
    LAS float* cond = (LAS float*)(F.lds);
    LAS float* red = (LAS float*)(F.lds + 98304);
    const int c = c0 + F.lane; const bool ok = c < ncols;
    for (int pass = 0; pass < 2; ++pass) {
        __syncthreads();
        for (int i = F.tid; i < 2048 * 10; i += 512) { const int k = i / 10, s = i % 10; cond[k * 12 + s] = shift[(size_t)(pass * 10 + s) * 12288 + k]; }
        __syncthreads();
        float acc[10];
#pragma unroll
        for (int s = 0; s < 10; ++s) acc[s] = 0.f;
        const float* wp = W + (size_t)(F.wave * 256) * ldw + (ok ? c : 0);
        const LAS float* cb = cond + F.wave * 256 * 12;
        for (int k0 = 0; k0 < 256; k0 += 16) {
            float wv[16];
#pragma unroll
            for (int u = 0; u < 16; ++u) { wv[u] = *wp; wp += ldw; }
#pragma unroll
            for (int u = 0; u < 16; ++u) { const LAS f32x4* cr = (const LAS f32x4*)(cb + (k0 + u) * 12); const f32x4 c0v = cr[0], c1v = cr[1], c2v = cr[2];
                acc[0] += c0v.x * wv[u]; acc[1] += c0v.y * wv[u]; acc[2] += c0v.z * wv[u]; acc[3] += c0v.w * wv[u]; acc[4] += c1v.x * wv[u]; acc[5] += c1v.y * wv[u];
                acc[6] += c1v.z * wv[u]; acc[7] += c1v.w * wv[u]; acc[8] += c2v.x * wv[u]; acc[9] += c2v.y * wv[u]; }
        }
#pragma unroll
        for (int s = 0; s < 10; ++s) red[(F.wave * 10 + s) * 64 + F.lane] = acc[s];
        __syncthreads();
        for (int i = F.tid; i < 640; i += 512) { const int s = i >> 6, l = i & 63; float t = 0.f;
#pragma unroll
            for (int w = 0; w < 8; ++w) t += red[(w * 10 + s) * 64 + l];
            if (c0 + l < ncols) out[(size_t)(pass * 10 + s) * ldo + c0 + l] = t * scale; }
    }
    __syncthreads();
}
__device__ __forceinline__ void bw_phase(Frame& F, int layer) {
    F.lane = fresh_lane();
    const int kind = layer % 3, j = layer / 3;
    const float* sh1 = F.mod + (size_t)layer * NSEQ * 12288; const float* sh2 = sh1 + 3 * D;
    float* bw1 = (float*)(F.ws + ((layer & 1) ? WS_BW1B : WS_BW1)); float* bw2 = (float*)(F.ws + ((layer & 1) ? WS_BW2B : WS_BW2));
    const int n1 = kind == 0 ? 48 : (kind == 1 ? 98 : 13);
    for (int it = F.G - 1 - F.vcu; it < n1 + 128; it += F.G) {
        if (it >= n1) { gemv20_item(F, sh2, F.in[I_W1] + (size_t)layer * D * FF, FF, FF, 1.f, bw2, FF, (it - n1) * 64); continue; }
        if (kind == 0) gemv20_item(F, sh1, F.in[I_GQA_WQKV] + (size_t)j * D * 3072, 3072, 3072, 1.f, bw1, 6400, it * 64);
        else if (kind == 1) {
            if (it < 16) gemv20_item(F, sh1, F.in[I_GLA_WIN], 6144, 1024, 0.0625f, bw1, 6400, it * 64);
            else if (it < 96) gemv20_item(F, sh1, F.in[I_GLA_WIN], 6144, 6144, 1.f, bw1, 6400, it * 64);
            else gemv20_item(F, sh1, F.in[I_GLA_WG1] + (size_t)(it - 96) * D * 16, 16, 16, 1.f, bw1 + 6144 + (it - 96) * 16, 6400, 0);
        } else gemv20_item(F, sh1, F.in[I_MLA_WDOWN], 832, 832, 1.f, bw1, 6400, it * 64);
    }
}
__device__ __forceinline__ void rot(float& y0, float& y1, f32x2 cs) { const float a = y0 * cs.x - y1 * cs.y, b = y0 * cs.y + y1 * cs.x; y0 = a; y1 = b; }
__device__ __forceinline__ void unpack8(v4u w, float* x) { x[0] = bflo(w.x); x[1] = bfhi(w.x); x[2] = bflo(w.y); x[3] = bfhi(w.y); x[4] = bflo(w.z); x[5] = bfhi(w.z); x[6] = bflo(w.w); x[7] = bfhi(w.w); }
__device__ __forceinline__ void mla_down_norm_phase(Frame& F) {
    F.lane = fresh_lane();
    bf16* DN = (bf16*)(F.ws + WS_DOWN); const float* qa = F.in[I_MLA_QAN]; const float* kva = F.in[I_MLA_KVAN]; const float* krn = F.in[I_MLA_KRN];
    const int gw = F.vcu * NWAVES + F.wave, NGW = F.G * NWAVES, lane = F.lane;
    float g0[8], g1[8], g2[8];
#pragma unroll
    for (int e = 0; e < 8; ++e) { g0[e] = qa[lane * 8 + e]; g1[e] = kva[(lane & 31) * 8 + e]; g2[e] = krn[(lane & 7) * 8 + e]; }
    for (int row = gw; row < M; row += NGW) {
        const int t = pos_of_row(row), ri = t >> 6, ci = 128 + (t & 63);
        bf16* rp = DN + (size_t)row * 1024;
        const v4u w0 = *(const GAS v4u*)(rp + lane * 8), w1 = *(const GAS v4u*)(rp + 512 + (lane & 31) * 8), w2 = *(const GAS v4u*)(rp + 768 + (lane & 7) * 8);
        float x[8], ss;
        unpack8(w0, x); ss = 0.f;
#pragma unroll
        for (int e = 0; e < 8; ++e) ss += x[e] * x[e];
        ss = wave_sum(ss); { const float rs = 1.0f / sqrtf(ss * (1.f / 512.f) + NORM_EPS);
#pragma unroll
            for (int e = 0; e < 8; ++e) x[e] = x[e] * rs * g0[e]; }
        *(GAS v4u*)(rp + lane * 8) = (v4u){pk2(x[0], x[1]), pk2(x[2], x[3]), pk2(x[4], x[5]), pk2(x[6], x[7])};
        unpack8(w1, x); ss = 0.f;
#pragma unroll
        for (int e = 0; e < 8; ++e) ss += x[e] * x[e];
        ss += __shfl_xor(ss, 1); ss += __shfl_xor(ss, 2); ss += __shfl_xor(ss, 4); ss += __shfl_xor(ss, 8); ss += __shfl_xor(ss, 16);
        { const float rs = 1.0f / sqrtf(ss * (1.f / 256.f) + NORM_EPS);
#pragma unroll
            for (int e = 0; e < 8; ++e) x[e] = x[e] * rs * g1[e]; }
        if (lane < 32) *(GAS v4u*)(rp + 512 + lane * 8) = (v4u){pk2(x[0], x[1]), pk2(x[2], x[3]), pk2(x[4], x[5]), pk2(x[6], x[7])};
        unpack8(w2, x); ss = 0.f;
#pragma unroll
        for (int e = 0; e < 8; ++e) ss += x[e] * x[e];
        ss += __shfl_xor(ss, 1); ss += __shfl_xor(ss, 2); ss += __shfl_xor(ss, 4);
        { const float rs = 1.0f / sqrtf(ss * (1.f / 64.f) + NORM_EPS);
#pragma unroll
            for (int e = 0; e < 8; ++e) x[e] = x[e] * rs * g2[e]; }
#pragma unroll
        for (int p = 0; p < 4; ++p) { const int i = (lane & 7) * 4 + p; rot(x[2 * p], x[2 * p + 1], F.ropeC[(i < 16 ? ri : ci) * 16 + (i & 15)]); }
        if (lane < 8) *(GAS v4u*)(rp + 768 + lane * 8) = (v4u){pk2(x[0], x[1]), pk2(x[2], x[3]), pk2(x[4], x[5]), pk2(x[6], x[7])};
    }
}
__device__ __forceinline__ void mla_knope_norm_phase(Frame& F) {
    F.lane = fresh_lane();
    bf16* KV = (bf16*)(F.ws + WS_KV); const float* knn = F.in[I_MLA_KNN];
    const int gw = F.vcu * NWAVES + F.wave, NGW = F.G * NWAVES, lane = F.lane, sub = lane & 15, hh = lane >> 4;
    float gk[8];
#pragma unroll
    for (int e = 0; e < 8; ++e) gk[e] = knn[sub * 8 + e];
    for (int row = gw; row < M; row += NGW) {
        v4u w[4];
#pragma unroll
        for (int ps = 0; ps < 4; ++ps) w[ps] = *(const GAS v4u*)(KV + (size_t)row * 4096 + (ps * 4 + hh) * 256 + sub * 8);
#pragma unroll
        for (int ps = 0; ps < 4; ++ps) {
            float x[8]; unpack8(w[ps], x); float ss = 0.f;
#pragma unroll
            for (int e = 0; e < 8; ++e) ss += x[e] * x[e];
            ss += __shfl_xor(ss, 1); ss += __shfl_xor(ss, 2); ss += __shfl_xor(ss, 4); ss += __shfl_xor(ss, 8);
            const float rs = 1.0f / sqrtf(ss * (1.f / 128.f) + NORM_EPS);
#pragma unroll
            for (int e = 0; e < 8; ++e) x[e] = x[e] * rs * gk[e];
            *(GAS v4u*)(KV + (size_t)row * 4096 + (ps * 4 + hh) * 256 + sub * 8) = (v4u){pk2(x[0], x[1]), pk2(x[2], x[3]), pk2(x[4], x[5]), pk2(x[6], x[7])};
        }
    }
}
__device__ __forceinline__ void gla_post_phase(Frame& F) {
    F.lane = fresh_lane();
    bf16* OB = (bf16*)(F.ws + WS_OB); const bf16* PROJ = (const bf16*)(F.ws + WS_PROJ); const float* on = F.in[I_GLA_ON];
    const int gw = F.vcu * NWAVES + F.wave, NGW = F.G * NWAVES, lane = F.lane;
    float g[8];
#pragma unroll
    for (int e = 0; e < 8; ++e) g[e] = on[lane * 8 + e];
    for (int row = gw; row < M; row += NGW) {
        v4u wf[4], wb[4], wr[4];
#pragma unroll
        for (int h = 0; h < 4; ++h) { wf[h] = *(const GAS v4u*)(F.H + (size_t)row * D + h * 512 + lane * 8); wb[h] = *(const GAS v4u*)(OB + (size_t)row * D + h * 512 + lane * 8);
            wr[h] = *(const GAS v4u*)(PROJ + (size_t)row * 6400 + 4096 + h * 512 + lane * 8); }
#pragma unroll
        for (int h = 0; h < 4; ++h) {
            float a[8], b[8], r[8]; unpack8(wf[h], a); unpack8(wb[h], b); unpack8(wr[h], r); float ss = 0.f;
#pragma unroll
            for (int e = 0; e < 8; ++e) { a[e] += b[e]; ss += a[e] * a[e]; }
            ss = wave_sum(ss); const float rs = 1.0f / sqrtf(ss * (1.f / 512.f) + NORM_EPS);
#pragma unroll
            for (int e = 0; e < 8; ++e) a[e] = a[e] * rs * g[e] * (r[e] / (1.f + __expf(-r[e])));
            *(GAS v4u*)(OB + (size_t)row * D + h * 512 + lane * 8) = (v4u){pk2(a[0], a[1]), pk2(a[2], a[3]), pk2(a[4], a[5]), pk2(a[6], a[7])};
        }
    }
}

namespace gla {
typedef float f32x4 __attribute__((ext_vector_type(4)));
typedef short bf16x8 __attribute__((ext_vector_type(8)));
constexpr int CL = 32;
constexpr int QD_ROW = 528, KET_ROW = 80, V_ROW = 272, P_ROW = 80;
constexpr int OFF_QD = 0, OFF_KD = OFF_QD + CL * QD_ROW, OFF_KET = OFF_KD + CL * QD_ROW, OFF_V = OFF_KET + 256 * KET_ROW, OFF_DE = OFF_V + CL * V_ROW, BUF_BYTES = OFF_DE + 1024;
constexpr int OFF_LOW = 2 * BUF_BYTES, OFF_PW = OFF_LOW + 2 * CL * 64, OFF_END = OFF_PW + 4 * CL * P_ROW;
static_assert(OFF_END <= LDSCTL_OFF, "gla LDS map");
__device__ __forceinline__ float log_sigmoid(float z) { return fminf(z, 0.f) - __logf(1.f + __expf(-fabsf(z))); }
__device__ __forceinline__ void rd_p(bf16x8 (&fa)[2][2], bf16x8 (&fb)[2][2], int aq, int ak) {
#pragma unroll
    for (int mi = 0; mi < 2; ++mi)
#pragma unroll
        for (int kk = 0; kk < 2; ++kk) { fa[mi][kk] = *(const LAS bf16x8*)(uintptr_t)(unsigned)(aq + mi * 8448 + kk * 64); fb[mi][kk] = *(const LAS bf16x8*)(uintptr_t)(unsigned)(ak + mi * 8448 + kk * 64); }
}
__device__ __forceinline__ void rd_v(unsigned (&vu)[8], int av) {
#pragma unroll
    for (int q = 0; q < 8; ++q) vu[q] = *(const LAS unsigned short*)(uintptr_t)(unsigned)(av + q * 272);
}
__device__ __forceinline__ void rd_pw(bf16x8 (&fp)[2], int ap) { fp[0] = *(const LAS bf16x8*)(uintptr_t)(unsigned)ap; fp[1] = *(const LAS bf16x8*)(uintptr_t)(unsigned)(ap + 1280); }
__device__ __forceinline__ void rd_q(v2u (&q0)[2][2], v2u (&q1)[2][2], int aq) {
#pragma unroll
    for (int mi = 0; mi < 2; ++mi)
#pragma unroll
        for (int kk = 0; kk < 2; ++kk) { q0[mi][kk] = *(const LAS v2u*)(uintptr_t)(unsigned)(aq + mi * 8448 + kk * 64); q1[mi][kk] = *(const LAS v2u*)(uintptr_t)(unsigned)(aq + mi * 8448 + kk * 64 + 32); }
}
__device__ __forceinline__ void rd_s(bf16x8 (&fk)[4], f32x4 (&fd)[4], int ak, int ad) {
#pragma unroll
    for (int t = 0; t < 4; ++t) { fk[t] = *(const LAS bf16x8*)(uintptr_t)(unsigned)(ak + t * 1280); fd[t] = *(const LAS f32x4*)(uintptr_t)(unsigned)(ad + t * 64); }
}
static_assert(16 * QD_ROW == 8448 && V_ROW == 272 && 16 * P_ROW == 1280 && 16 * KET_ROW == 1280, "asm offsets");
#define GLA_BAR() do { asm volatile("s_waitcnt lgkmcnt(0)" ::: "memory"); __builtin_amdgcn_s_barrier(); asm volatile("" ::: "memory"); } while (0)

__device__ __forceinline__ void chain(LAS unsigned char* lds, const bf16* PROJ, bf16* OF, bf16* OB, const float* wg2, const float* bgv, int c) {
    const int tid = threadIdx.x, wave = __builtin_amdgcn_readfirstlane(tid >> 6), lane = tid & 63;
    const int sl = c & 3, dir = (c >> 2) & 1, h = (c >> 3) & 3, s = c >> 5;
    int T, rowbase;
    if (c < 128) { T = 8192; rowbase = MP + s * 8192; } else { T = 2048; rowbase = (s - 4) * 2048; }
    const int nch = T / CL;
    GLA_BAR();
    if (wave < 4) {
        const int ptid = tid, l16 = lane & 15, g = lane >> 4, dbase = 64 * wave + 2 * l16;
        bf16x8 wB[4]; float bias[4];
#pragma unroll
        for (int nj = 0; nj < 4; ++nj) { const int d = dbase + 32 * (nj >> 1) + (nj & 1); float w[8];
#pragma unroll
            for (int jx = 0; jx < 8; ++jx) w[jx] = g < 2 ? wg2[((size_t)dir * 16 + 8 * g + jx) * 1024 + h * 256 + d] : 0.f;
            wB[nj] = __builtin_bit_cast(bf16x8, (v4u){pk2c(w[0], w[1]), pk2c(w[2], w[3]), pk2c(w[4], w[5]), pk2c(w[6], w[7])});
            bias[nj] = bgv[dir * 1024 + h * 256 + d]; }
        unsigned qv[2][2][4], kv[2][2][4]; v4u vv[2]; unsigned lw;
#define GLA_ROW0(J) ((size_t)rowbase + (size_t)(dir ? nch - 1 - (J) : (J)) * CL)
#define GLA_LOAD_QKV(J) do { const size_t r0_ = GLA_ROW0(J); const char* qp_ = (const char*)PROJ + (r0_ * 6400 + h * 256 + 64 * wave) * 2; const unsigned voff_ = (unsigned)(4 * g * 6400 + 2 * l16) * 2u;     \
        _Pragma("unroll") for (int pp = 0; pp < 2; ++pp) _Pragma("unroll") for (int mi = 0; mi < 2; ++mi) _Pragma("unroll") for (int r = 0; r < 4; ++r) { \
            qv[pp][mi][r] = *(const GAS unsigned*)(qp_ + (size_t)(16 * mi + r) * 12800 + pp * 64 + voff_); kv[pp][mi][r] = *(const GAS unsigned*)(qp_ + (size_t)(16 * mi + r) * 12800 + pp * 64 + 2048 + voff_); } \
        _Pragma("unroll") for (int jj = 0; jj < 2; ++jj) { const int idx = ptid + 256 * jj, pos = idx >> 4, e8 = (idx & 15) * 8; vv[jj] = *(const GAS v4u*)(PROJ + (r0_ + pos) * 6400 + 2048 + h * 512 + sl * 128 + e8); } } while (0)
#define GLA_LOAD_LOW(J) do { lw = *(const GAS unsigned*)(PROJ + (GLA_ROW0(J) + (ptid >> 3)) * 6400 + 6144 + dir * 16 + (ptid & 7) * 2); } while (0)
#define GLA_PUT_LOW(J) do { *(LAS unsigned*)(lds + OFF_LOW + ((J) & 1) * (CL * 64) + (ptid >> 3) * 64 + (ptid & 7) * 4) = lw; } while (0)
        { const int b_ = ptid >> 7, pos_ = (ptid >> 2) & 31, part_ = ptid & 3; *(LAS v2u*)(lds + OFF_LOW + b_ * (CL * 64) + pos_ * 64 + 32 + part_ * 8) = (v2u){0u, 0u}; }
        GLA_LOAD_LOW(0); GLA_PUT_LOW(0);
        if (nch > 1) GLA_LOAD_LOW(1);
        GLA_LOAD_QKV(0);
        GLA_BAR();
        for (int j = 0; j < nch; ++j) {
            LAS unsigned char* B = lds + (j & 1) * BUF_BYTES;
            if (j + 1 < nch) GLA_PUT_LOW(j + 1);
            f32x4 z[2][4];
            { bf16x8 fA[2];
#pragma unroll
              for (int mi = 0; mi < 2; ++mi) fA[mi] = *(const LAS bf16x8*)(lds + OFF_LOW + (j & 1) * (CL * 64) + (16 * mi + l16) * 64 + g * 16);
#pragma unroll
              for (int mi = 0; mi < 2; ++mi)
#pragma unroll
                  for (int nj = 0; nj < 4; ++nj) z[mi][nj] = __builtin_amdgcn_mfma_f32_16x16x32_bf16(fA[mi], wB[nj], (f32x4){bias[nj], bias[nj], bias[nj], bias[nj]}, 0, 0, 0); }
            float tot[4];
#pragma unroll
            for (int nj = 0; nj < 4; ++nj) {
                float s[2];
#pragma unroll
                for (int mi = 0; mi < 2; ++mi) {
#pragma unroll
                    for (int r = 0; r < 4; ++r) { const float zz = z[mi][nj][r]; const float t = __builtin_amdgcn_exp2f(-1.4426950408889634f * __builtin_fabsf(zz));
                        z[mi][nj][r] = __builtin_fmaf(__builtin_amdgcn_logf(1.0f + t), -0.0625f, __builtin_fminf(zz * 0.09016844005556021f, 0.f)); }
                    if (dir == 0) { z[mi][nj][1] += z[mi][nj][0]; z[mi][nj][2] += z[mi][nj][1]; z[mi][nj][3] += z[mi][nj][2]; s[mi] = z[mi][nj][3]; }
                    else          { z[mi][nj][2] += z[mi][nj][3]; z[mi][nj][1] += z[mi][nj][2]; z[mi][nj][0] += z[mi][nj][1]; s[mi] = z[mi][nj][0]; }
                }
                float e[2], t2[2];
#pragma unroll
                for (int mi = 0; mi < 2; ++mi) { const float s1 = __shfl_xor(s[mi], 16), ps = s[mi] + s1, p2 = __shfl_xor(ps, 32); t2[mi] = ps + p2;
                    e[mi] = dir == 0 ? (((g & 1) ? s1 : 0.f) + ((g & 2) ? p2 : 0.f)) : (((g & 1) ? 0.f : s1) + ((g & 2) ? 0.f : p2)); }
                const float o0 = e[0] + (dir == 0 ? 0.f : t2[1]), o1 = e[1] + (dir == 0 ? t2[0] : 0.f);
#pragma unroll
                for (int r = 0; r < 4; ++r) { z[0][nj][r] += o0; z[1][nj][r] += o1; }
                tot[nj] = t2[0] + t2[1];
            }
#pragma unroll
            for (int jj = 0; jj < 2; ++jj) { const int idx = ptid + 256 * jj, pos = idx >> 4, e8 = (idx & 15) * 8; *(LAS v4u*)(B + OFF_V + pos * V_ROW + e8 * 2) = vv[jj]; }
#pragma unroll
            for (int pp = 0; pp < 2; ++pp) { const int da = dbase + 32 * pp;
                const float dea = __builtin_amdgcn_exp2f(tot[2 * pp]), deb = __builtin_amdgcn_exp2f(tot[2 * pp + 1]);
                if (g == 0) *(LAS f32x2*)(B + OFF_DE + da * 4) = (f32x2){dea, deb};
#pragma unroll
                for (int mi = 0; mi < 2; ++mi) { float ea[4], eb[4];
#pragma unroll
                    for (int r = 0; r < 4; ++r) { const float b_a = z[mi][2 * pp][r], b_b = z[mi][2 * pp + 1][r];
                        const float xa = __builtin_amdgcn_exp2f(b_a), xb = __builtin_amdgcn_exp2f(b_b), ia = __builtin_amdgcn_exp2f(-b_a), ib = __builtin_amdgcn_exp2f(-b_b);
                        const unsigned qw = qv[pp][mi][r], kw = kv[pp][mi][r];
                        const float ka = bflo(kw) * ia, kb = bfhi(kw) * ib; ea[r] = ka * dea; eb[r] = kb * deb;
                        const int pos = 16 * mi + 4 * g + r;
                        *(LAS unsigned*)(B + OFF_QD + pos * QD_ROW + da * 2) = pk2c(bflo(qw) * xa, bfhi(qw) * xb);
                        *(LAS unsigned*)(B + OFF_KD + pos * QD_ROW + da * 2) = pk2c(ka, kb); }
                    *(LAS v2u*)(B + OFF_KET + da * KET_ROW + (16 * mi + 4 * g) * 2) = (v2u){pk2c(ea[0], ea[1]), pk2c(ea[2], ea[3])};
                    *(LAS v2u*)(B + OFF_KET + (da + 1) * KET_ROW + (16 * mi + 4 * g) * 2) = (v2u){pk2c(eb[0], eb[1]), pk2c(eb[2], eb[3])};
                }
            }
            if (j + 1 < nch) GLA_LOAD_QKV(j + 1);
            if (j + 2 < nch) GLA_LOAD_LOW(j + 2);
            GLA_BAR();
        }
        GLA_BAR();
#undef GLA_ROW0
#undef GLA_LOAD_QKV
#undef GLA_LOAD_LOW
#undef GLA_PUT_LOW
    } else {
        const int cw = wave - 4, l16 = lane & 15, g = lane >> 4;
        bf16* OD = dir ? OB : OF;
        LAS unsigned char* PW = lds + OFF_PW + cw * (CL * P_ROW);
        f32x4 S[2][16];
#pragma unroll
        for (int cb = 0; cb < 2; ++cb)
#pragma unroll
            for (int t = 0; t < 16; ++t) S[cb][t] = (f32x4){0.f, 0.f, 0.f, 0.f};
        GLA_BAR();
        GLA_BAR();
#define GLA_WAIT() do { asm volatile("s_waitcnt lgkmcnt(0)" ::: "memory"); __builtin_amdgcn_sched_barrier(0); } while (0)
        const int lbase = (int)(uintptr_t)lds;
        const int a_qd = lbase + OFF_QD + l16 * QD_ROW + g * 16;
        const int a_kd = lbase + OFF_KD + l16 * QD_ROW + g * 16;
        const int a_qp = lbase + OFF_QD + l16 * QD_ROW + g * 8;
        const int a_ke = lbase + OFF_KET + l16 * KET_ROW + g * 16;
        const int a_de = lbase + OFF_DE + g * 16;
        const int a_v = lbase + OFF_V + (8 * g) * V_ROW + (32 * cw + l16) * 2;
        const int a_pw = (int)(uintptr_t)PW + l16 * P_ROW + g * 16;
        for (int j = 0; j < nch; ++j) {
            const int bo = (j & 1) * BUF_BYTES;
            const size_t r0 = (size_t)rowbase + (size_t)(dir ? nch - 1 - j : j) * CL;
            f32x4 pacc[2][2];
#pragma unroll
            for (int mi = 0; mi < 2; ++mi)
#pragma unroll
                for (int ni = 0; ni < 2; ++ni) pacc[mi][ni] = (f32x4){0.f, 0.f, 0.f, 0.f};
#pragma unroll
            for (int hb = 0; hb < 4; ++hb) {
                bf16x8 fa[2][2], fb[2][2];
                rd_p(fa, fb, a_qd + bo + hb * 128, a_kd + bo + hb * 128);
#pragma unroll
                for (int kk = 0; kk < 2; ++kk)
#pragma unroll
                    for (int mi = 0; mi < 2; ++mi)
#pragma unroll
                        for (int ni = 0; ni < 2; ++ni) pacc[mi][ni] = __builtin_amdgcn_mfma_f32_16x16x32_bf16(fa[mi][kk], fb[ni][kk], pacc[mi][ni], 0, 0, 0);
            }
#pragma unroll
            for (int mi = 0; mi < 2; ++mi)
#pragma unroll
                for (int ni = 0; ni < 2; ++ni)
#pragma unroll
                    for (int r = 0; r < 4; ++r) { const int pos = 16 * mi + 4 * g + r, pk = 16 * ni + l16; const bool keep = dir ? (pk >= pos) : (pk <= pos);
                        *(LAS unsigned short*)(PW + pos * P_ROW + pk * 2) = (unsigned short)(pk2c(keep ? pacc[mi][ni][r] : 0.f, 0.f) & 0xffffu); }
            unsigned vu[2][8]; bf16x8 fp[2];
            asm volatile("s_waitcnt lgkmcnt(0)" ::: "memory");
            rd_v(vu[0], a_v + bo); rd_v(vu[1], a_v + bo + 32);
            rd_pw(fp, a_pw);
            bf16x8 Bv[2];
#pragma unroll
            for (int cb = 0; cb < 2; ++cb) Bv[cb] = __builtin_bit_cast(bf16x8, (v4u){vu[cb][0] | (vu[cb][1] << 16), vu[cb][2] | (vu[cb][3] << 16), vu[cb][4] | (vu[cb][5] << 16), vu[cb][6] | (vu[cb][7] << 16)});
            f32x4 oacc[2][2];
#pragma unroll
            for (int mi = 0; mi < 2; ++mi)
#pragma unroll
                for (int cb = 0; cb < 2; ++cb) oacc[mi][cb] = __builtin_amdgcn_mfma_f32_16x16x32_bf16(fp[mi], Bv[cb], (f32x4){0.f, 0.f, 0.f, 0.f}, 0, 0, 0);
#pragma unroll
            for (int hb = 0; hb < 4; ++hb) {
                v2u q0[2][2], q1[2][2];
                rd_q(q0, q1, a_qp + bo + hb * 128);
#pragma unroll
                for (int kk = 0; kk < 2; ++kk) { const int k2 = 2 * (hb * 2 + kk);
                    bf16x8 Bs[2];
#pragma unroll
                    for (int cb = 0; cb < 2; ++cb) Bs[cb] = __builtin_bit_cast(bf16x8, (v4u){pk2c(S[cb][k2][0], S[cb][k2][1]), pk2c(S[cb][k2][2], S[cb][k2][3]), pk2c(S[cb][k2 + 1][0], S[cb][k2 + 1][1]), pk2c(S[cb][k2 + 1][2], S[cb][k2 + 1][3])});
#pragma unroll
                    for (int mi = 0; mi < 2; ++mi) { const bf16x8 a = __builtin_bit_cast(bf16x8, (v4u){q0[mi][kk].x, q0[mi][kk].y, q1[mi][kk].x, q1[mi][kk].y});
#pragma unroll
                        for (int cb = 0; cb < 2; ++cb) oacc[mi][cb] = __builtin_amdgcn_mfma_f32_16x16x32_bf16(a, Bs[cb], oacc[mi][cb], 0, 0, 0); }
                }
            }
            { bf16* op = OD + r0 * 2048 + h * 512 + sl * 128 + 32 * cw + l16;
#pragma unroll
              for (int mi = 0; mi < 2; ++mi)
#pragma unroll
                  for (int cb = 0; cb < 2; ++cb)
#pragma unroll
                      for (int r = 0; r < 4; ++r) op[(size_t)(16 * mi + 4 * g + r) * 2048 + 16 * cb] = (bf16)(pk2c(oacc[mi][cb][r], 0.f) & 0xffffu); }
#pragma unroll
            for (int hb = 0; hb < 4; ++hb) {
                bf16x8 fk[4]; f32x4 fd[4];
                rd_s(fk, fd, a_ke + bo + hb * 5120, a_de + bo + hb * 256);
#pragma unroll
                for (int t = 0; t < 4; ++t)
#pragma unroll
                    for (int cb = 0; cb < 2; ++cb) S[cb][hb * 4 + t] = __builtin_amdgcn_mfma_f32_16x16x32_bf16(fk[t], Bv[cb], S[cb][hb * 4 + t] * fd[t], 0, 0, 0);
            }
            GLA_BAR();
        }
#undef GLA_WAIT
    }
}
}

constexpr int N_PHASE_IDS = 2 + 10 * DEPTH;
__host__ __device__ constexpr bool phase_exists(int ph) {
    if (ph < 2) return true;
    const int l = (ph - 2) / 10, s = (ph - 2) % 10, kind = l % 3;
    if (s == 5) return kind == 2;
    if (s == 7) return false;
    if (s == 4) return false;
    if (s == 0 && l > 0) return false;
    if (s == 2 && kind == 0) return false;
    return true;
}
#define IN(k) (lo <= (k) && (k) < hi)
#ifndef SITE_MASK
#define SITE_MASK 0xffffu
#endif
#ifndef WGM_RES
#define WGM_RES 4
#endif
#ifndef REPS_G1
#define REPS_G1 1
#endif
#ifndef REPS_G3
#define REPS_G3 1
#endif
#ifndef REPS_SCAN
#define REPS_SCAN 1
#endif
#ifndef REPS_ATT
#define REPS_ATT 1
#endif
#define SITE(n) ((((unsigned)(SITE_MASK)) >> (n)) & 1u)
#define SEAM(k) do { if ((k) + 1 < hi) xcd_barrier(bar); } while (0)
template <int layer> __device__ __forceinline__ void layer_body(Frame& F, const XcdBarrier& bar, const int lo, const int hi, unsigned char* lds_raw) {
    constexpr size_t wreg = (layer & 1) ? WS_WB : WS_W, bw1o = (layer & 1) ? WS_BW1B : WS_BW1, bw2o = (layer & 1) ? WS_BW2B : WS_BW2;
    bf16* const w1t = (bf16*)(F.ws + wreg); bf16* const w2t = (bf16*)(F.ws + wreg + 32 * MiB); bf16* const wmix = (bf16*)(F.ws + wreg + 64 * MiB); bf16* const wot = (bf16*)(F.ws + wreg + 90 * MiB);
#define PREP_NEXT() do { if constexpr (layer + 1 < DEPTH) { __syncthreads(); bw_phase(F, layer + 1); prep_weights(F, layer + 1, (unsigned*)(F.ws + WS_CTL) + CW_PREP + 64 * (layer + 1)); } } while (0)

        constexpr int pb = 2 + 10 * layer, kind = layer % 3, jj = layer / 3;
        const float* modl = F.mod + (size_t)layer * NSEQ * 12288;
        if (SITE(2) && layer == 0 && IN(pb + 0)) { norm0_phase(F); bw_phase(F, 0); SEAM(pb + 0); }
        if (SITE(3) && IN(pb + 1)) {
            const int N1 = kind == 0 ? 3072 : (kind == 1 ? 6400 : 1024);
            pg8::Gemm g{F.H, wmix, M, N1, D, D, 256}; pg8::StaticOrder S; S.init(M, N1, F.G, (int)blockIdx.x, REPS_G1);
            if constexpr (kind == 0) {
                pg8::EpiBf16NRope E{(bf16*)(F.ws + WS_S), N1, (const float*)(F.ws + WS_SSQB), (const float*)(F.ws + bw1o), 6400,
                                    F.in[I_GQA_QN] + jj * 128, F.in[I_GQA_KN] + jj * 128, (const float*)F.ropeA, (PG8_LAS float*)(F.lds + RING_BYTES + 4096)};
                pg8::gemm_phase<pg8::EpiBf16NRope, pg8::StaticOrder, true, true>(F.lds, g, S, E);
            } else {
                pg8::EpiBf16N<0> E{(bf16*)(F.ws + WS_S), N1, (const float*)(F.ws + WS_SSQB), (const float*)(F.ws + bw1o), 6400};
                pg8::gemm_phase<pg8::EpiBf16N<0>, pg8::StaticOrder, true, true>(F.lds, g, S, E);
            }
            SEAM(pb + 1);
        }
        if (kind == 0) {
            if (SITE(5) && IN(pb + 3)) {
                const bf16* QKV = (const bf16*)(F.ws + WS_QKV);
                const float shiftC = __int_as_float(__builtin_amdgcn_readfirstlane(__float_as_int(((const float*)(F.ws + WS_BND))[jj])));
                if (shiftC < 60.f) {
                for (int u_ = F.vcu; u_ < 4096 * REPS_ATT; u_ += F.G) { const int u = u_ & 4095;
                    int rowq, rowk, T, head;
                    if (u < 2048) { const int sq = u >> 9, r = u & 511; head = r >> 5; T = 8192; rowk = MP + sq * 8192; rowq = rowk + (r & 31) * 256; }
                    else { const int v = u - 2048, sq = v >> 7, r = v & 127; head = r >> 3; T = 2048; rowk = sq * 2048; rowq = rowk + (r & 7) * 256; }
                    const int kvh = head >> 2;
                    attn::attn_dense_body<128, 3072, 3072, 3072, 3072, 3072, 2, false, true>(QKV + (size_t)rowq * 3072 + head * 128, QKV + (size_t)rowk * 3072 + 2048 + kvh * 128, nullptr,
                        QKV + (size_t)rowk * 3072 + 2560 + kvh * 128, (bf16*)QKV + (size_t)rowq * 3072 + head * 128, T, (char*)lds_raw, nullptr, nullptr, 0, shiftC);
                }
                } else {
                for (int u_ = F.vcu; u_ < 4096 * REPS_ATT; u_ += F.G) { const int u = u_ & 4095;
                    int rowq, rowk, T, head;
                    if (u < 2048) { const int sq = u >> 9, r = u & 511; head = r >> 5; T = 8192; rowk = MP + sq * 8192; rowq = rowk + (r & 31) * 256; }
                    else { const int v = u - 2048, sq = v >> 7, r = v & 127; head = r >> 3; T = 2048; rowk = sq * 2048; rowq = rowk + (r & 7) * 256; }
                    const int kvh = head >> 2;
                    attn::attn_dense_body<128, 3072, 3072, 3072, 3072, 3072, 2>(QKV + (size_t)rowq * 3072 + head * 128, QKV + (size_t)rowk * 3072 + 2048 + kvh * 128, nullptr,
                        QKV + (size_t)rowk * 3072 + 2560 + kvh * 128, (bf16*)QKV + (size_t)rowq * 3072 + head * 128, T, (char*)lds_raw);
                }
                }
                PREP_NEXT();
                SEAM(pb + 3);
            }
        } else if (kind == 1) {
            if (SITE(6) && IN(pb + 2)) {
                const bf16* PROJ = (const bf16*)(F.ws + WS_PROJ); bf16* OB = (bf16*)(F.ws + WS_OB);
                const int nrep = REPS_SCAN + (F.G >> 24);
                for (int rp = 0; rp < nrep; ++rp) {
                    const int nmine = F.G == 256 ? (F.vcu < 128 ? 1 : 4) : (640 - F.vcu + F.G - 1) / F.G;
                    for (int q = 0; q < nmine; ++q) { const int c = F.G == 256 ? (F.vcu < 128 ? F.vcu : 128 + (F.vcu - 128) * 4 + q) : F.vcu + q * F.G;
                        gla::chain(F.lds, PROJ, F.H, OB, F.in[I_GLA_WG2], F.in[I_GLA_BG], c); } }
                PREP_NEXT();
                SEAM(pb + 2);
            }
            if (SITE(7) && IN(pb + 3)) { gla_post_phase(F); SEAM(pb + 3); }
        } else {
            if (SITE(8) && IN(pb + 2)) { mla_down_norm_phase(F); SEAM(pb + 2); }
            if (SITE(9) && IN(pb + 3)) {
                const bf16* DN = (const bf16*)(F.ws + WS_DOWN);
                { pg8::Gemm g{DN, wmix + (size_t)4 * MiB / 2, M, 3072, 512, 1024, 256}; pg8::StaticOrder S; S.init(M, 3072, F.G, (int)blockIdx.x);
                  pg8::EpiBf16P E{(bf16*)(F.ws + WS_Q), 3072};
                  pg8::gemm_phase<pg8::EpiBf16P, pg8::StaticOrder, true, true>(F.lds, g, S, E); }
                __syncthreads();
                { int K2 = 256, lda2 = 1024; asm volatile("" : "+s"(K2), "+s"(lda2));
                  pg8::Gemm g{DN + 512, wmix + (size_t)8 * MiB / 2, M, 4096, K2, lda2, 256}; pg8::StaticOrder S; S.init(M, 4096, F.G, (int)blockIdx.x);
                  pg8::EpiBf16KV E{(bf16*)(F.ws + WS_KV), 4096, F.in[I_MLA_KNN], (PG8_LAS float*)(F.lds + RING_BYTES + 4096)};
                  pg8::gemm_phase<pg8::EpiBf16KV, pg8::StaticOrder, true, true>(F.lds, g, S, E); }
                SEAM(pb + 3);
            }
            if (SITE(11) && IN(pb + 5)) {
                const bf16* Q = (const bf16*)(F.ws + WS_Q); const bf16* KV = (const bf16*)(F.ws + WS_KV); const bf16* DN = (const bf16*)(F.ws + WS_DOWN);
                const float shiftC = __int_as_float(__builtin_amdgcn_readfirstlane(__float_as_int(((const float*)(F.ws + WS_BND))[2])));
                if (shiftC < 60.f) {
                for (int u_ = F.vcu; u_ < 4096 * REPS_ATT; u_ += F.G) { const int u = u_ & 4095;
                    int rowq, rowk, T, head;
                    if (u < 2048) { const int sq = u >> 9, r = u & 511; head = r >> 5; T = 8192; rowk = MP + sq * 8192; rowq = rowk + (r & 31) * 256; }
                    else { const int v = u - 2048, sq = v >> 7, r = v & 127; head = r >> 3; T = 2048; rowk = sq * 2048; rowq = rowk + (r & 7) * 256; }
                    attn::attn_dense_body<192, 3072, 4096, 1024, 4096, 3072, 1, true, true>(Q + (size_t)rowq * 3072 + head * 192, KV + (size_t)rowk * 4096 + head * 256, DN + (size_t)rowk * 1024 + 768,
                        KV + (size_t)rowk * 4096 + head * 256 + 128, (bf16*)Q + (size_t)rowq * 3072 + head * 192, T, (char*)lds_raw, F.in[I_MLA_QN], (const float*)F.ropeC, rowq - rowk, shiftC);
                }
                } else {
                for (int u_ = F.vcu; u_ < 4096 * REPS_ATT; u_ += F.G) { const int u = u_ & 4095;
                    int rowq, rowk, T, head;
                    if (u < 2048) { const int sq = u >> 9, r = u & 511; head = r >> 5; T = 8192; rowk = MP + sq * 8192; rowq = rowk + (r & 31) * 256; }
                    else { const int v = u - 2048, sq = v >> 7, r = v & 127; head = r >> 3; T = 2048; rowk = sq * 2048; rowq = rowk + (r & 7) * 256; }
                    attn::attn_dense_body<192, 3072, 4096, 1024, 4096, 3072, 1, true>(Q + (size_t)rowq * 3072 + head * 192, KV + (size_t)rowk * 4096 + head * 256, DN + (size_t)rowk * 1024 + 768,
                        KV + (size_t)rowk * 4096 + head * 256 + 128, (bf16*)Q + (size_t)rowq * 3072 + head * 192, T, (char*)lds_raw, F.in[I_MLA_QN], (const float*)F.ropeC, rowq - rowk);
                }
                }
                PREP_NEXT();
                SEAM(pb + 5);
            }
        }
        if (SITE(12) && IN(pb + 6)) {
            const bf16* A2 = kind == 0 ? (const bf16*)(F.ws + WS_QKV) : (kind == 1 ? (const bf16*)(F.ws + WS_OB) : (const bf16*)(F.ws + WS_Q));
            pg8::Gemm g{A2, wot, M, D, D, kind == 1 ? D : 3072, kind == 2 ? 384 : 256}; pg8::StaticOrder S; S.init(M, D, F.G, (int)blockIdx.x, 1, WGM_RES);
            typedef pg8::EpiResGateNormB<layer == 0 ? 0 : 1> EpiT;
            EpiT E{F.in[I_XP], F.in[I_XS], F.out, modl + 2 * D, F.H, F.in[I_N2G] + layer * D, modl + 4 * D, (float*)(F.ws + WS_SSQA), (PG8_LAS float*)(F.lds + RING_BYTES)};
            pg8::gemm_phase<EpiT, pg8::StaticOrder, true, true>(F.lds, g, S, E);
            SEAM(pb + 6);
        }
        if (SITE(14) && IN(pb + 8)) {
            pg8::Gemm g{F.H, w1t, M, FF, D, D, 256}; pg8::StaticOrder S; S.init(M, FF, F.G, (int)blockIdx.x, REPS_G3);
            pg8::EpiBf16N<1> E{(bf16*)(F.ws + WS_HID), FF, (const float*)(F.ws + WS_SSQA), (const float*)(F.ws + bw2o), FF};
            pg8::gemm_phase<pg8::EpiBf16N<1>, pg8::StaticOrder, true, true>(F.lds, g, S, E);
            SEAM(pb + 8);
        }
        if (SITE(15) && IN(pb + 9)) {
            pg8::Gemm g{(const bf16*)(F.ws + WS_HID), w2t, M, D, FF, FF, 256}; pg8::StaticOrder S; S.init(M, D, F.G, (int)blockIdx.x, 1, WGM_RES);
            typedef pg8::EpiResGateNormB<layer + 1 < DEPTH ? 1 : 2> EpiT;
            EpiT E{nullptr, F.in[I_XS], F.out, modl + 5 * D, layer + 1 < DEPTH ? F.H : nullptr, F.in[I_N1G] + (layer + 1 < DEPTH ? layer + 1 : 0) * D,
                   modl + (layer + 1 < DEPTH ? NSEQ * 12288 + D : 0), (float*)(F.ws + WS_SSQB), (PG8_LAS float*)(F.lds + RING_BYTES)};
            pg8::gemm_phase<EpiT, pg8::StaticOrder, true, true>(F.lds, g, S, E);
            SEAM(pb + 9);
        }
    }
#undef PREP_NEXT
__global__ void __launch_bounds__(NWAVES * 64, 2) trunk_fwd(Args args) {
    extern __shared__ __attribute__((aligned(16))) unsigned char lds_raw[];
    Frame F;
    F.lds = (LAS unsigned char*)lds_raw;
    F.tid = threadIdx.x; F.lane = F.tid & 63; F.wave = __builtin_amdgcn_readfirstlane(F.tid >> 6);
    F.G = gridDim.x; { const int bx = blockIdx.x; F.vcu = (F.G % 8 == 0) ? (bx % 8) * (F.G / 8) + bx / 8 : bx; }
    F.in = args.in; F.out = args.out; F.ws = args.ws;
    F.mod = (float*)(args.ws + WS_MOD); F.ropeA = (const f32x2*)(args.ws + WS_ROPE); F.ropeC = F.ropeA + 192 * 32;
    F.H = (bf16*)(args.ws + WS_H);
    for (int u = F.tid; u < (LDS_BYTES - LDSCTL_OFF) / 4; u += NWAVES * 64) ((LAS unsigned*)(F.lds + LDSCTL_OFF))[u] = 0u;
    __syncthreads();
    XcdBarrier bar; bar.bar = (unsigned*)(args.ws + WS_CTL) + CW_BAR; bar.x = 0; bar.st = nullptr;
    if (args.one_launch) bar = xcd_barrier_post((unsigned*)(args.ws + WS_CTL) + CW_BAR, (volatile LAS unsigned*)(F.lds + LDSCTL_OFF));
    const int lo = args.ph_lo, hi = args.ph_hi;

    if (SITE(0) && IN(0)) { ada_phase(F); rope_tables(F); prep_weights(F, 0, (unsigned*)(F.ws + WS_CTL) + CW_PREP); SEAM(0); }
    if (SITE(1) && IN(1)) { mod_finalize(F); score_bounds(F); SEAM(1); }

    layer_body<0>(F, bar, lo, hi, lds_raw); layer_body<1>(F, bar, lo, hi, lds_raw); layer_body<2>(F, bar, lo, hi, lds_raw); layer_body<3>(F, bar, lo, hi, lds_raw);
#undef IN
#undef SEAM
}

extern "C" void kernel_launch(void* const* d_in, const int* in_sizes, int n_in, void* d_out, int out_size, void* d_ws, size_t ws_size, hipStream_t stream) {
    static int grid = 0;
    if (grid == 0) {
        if (n_in != N_IN || out_size != M * D || ws_size < WS_END) { fprintf(stderr, "kernel_launch: unexpected shapes (n_in %d out %d ws %zu, need %zu)\n", n_in, out_size, ws_size, (size_t)WS_END); grid = -1; return; }
        int dev = 0, cus = 0, per_cu = 0;
        if (hipGetDevice(&dev) != hipSuccess || hipDeviceGetAttribute(&cus, hipDeviceAttributeMultiprocessorCount, dev) != hipSuccess) { grid = -1; return; }
        if (hipFuncSetAttribute((const void*)trunk_fwd, hipFuncAttributeMaxDynamicSharedMemorySize, LDS_BYTES) != hipSuccess) { fprintf(stderr, "kernel_launch: hipFuncSetAttribute failed\n"); grid = -1; return; }
        if (hipOccupancyMaxActiveBlocksPerMultiprocessor(&per_cu, (const void*)trunk_fwd, NWAVES * 64, LDS_BYTES) != hipSuccess || per_cu < 1) { fprintf(stderr, "kernel_launch: occupancy query says %d blocks per CU\n", per_cu); }
        (void)hipGetLastError();
        grid = cus;
    }
    if (grid < 0) return;
    (void)hipMemsetAsync((char*)d_ws + WS_CTL, 0, CTL_ZERO_BYTES, stream);
    Args a{};
    for (int i = 0; i < N_IN; ++i) a.in[i] = (const float*)d_in[i];
    a.out = (float*)d_out; a.ws = (unsigned char*)d_ws; a.pad = 0;
#if MK_ONE_LAUNCH
    a.ph_lo = 0; a.ph_hi = N_PHASE_IDS; a.one_launch = 1;
    hipLaunchKernelGGL(trunk_fwd, dim3(grid), dim3(NWAVES * 64), LDS_BYTES, stream, a);
#else
    for (int ph = 0; ph < N_PHASE_IDS; ++ph) { if (!phase_exists(ph)) continue;
        a.ph_lo = ph; a.ph_hi = ph + 1; a.one_launch = 0;
        hipLaunchKernelGGL(trunk_fwd, dim3(grid), dim3(NWAVES * 64), LDS_BYTES, stream, a); }
#endif
    const hipError_t le = hipPeekAtLastError();
    if (le != hipSuccess) fprintf(stderr, "kernel_launch: launch failed: %s\n", hipGetErrorName(le));
}
```

```cpp
#include <hip/hip_runtime.h>
#include <cstdio>
#include <cstdint>

#define GAS __attribute__((address_space(1)))
#define LAS __attribute__((address_space(3)))
#define PG8_LAS __attribute__((address_space(3)))

#ifndef MK_ONE_LAUNCH
#define MK_ONE_LAUNCH 1
#endif

constexpr int D = 2048, M = 65536, MP = 32768, NSEQ = 20, FF = 8192, DEPTH = 4;
constexpr float NORM_EPS = 1e-6f;
enum { I_XP = 0, I_XS, I_CP, I_CS, I_N1G, I_N2G, I_ADAW, I_ADAB, I_GQA_WQKV, I_GQA_QN, I_GQA_KN, I_GQA_WO, I_GLA_WIN, I_GLA_WG1, I_GLA_WG2, I_GLA_BG, I_GLA_ON, I_GLA_WO,
       I_MLA_WDOWN, I_MLA_QAN, I_MLA_KVAN, I_MLA_WUQ, I_MLA_WUKV, I_MLA_QN, I_MLA_KNN, I_MLA_KRN, I_MLA_WO, I_W1, I_W2, N_IN };

constexpr size_t MiB = 1u << 20;
constexpr size_t WS_CTL = 0, CTL_ZERO_BYTES = 1 * MiB;
constexpr size_t WS_MODP = 384 * MiB;
constexpr size_t WS_MOD = 16 * MiB;
constexpr size_t WS_BND = 20 * MiB - 4096;
constexpr size_t WS_ROPE = 20 * MiB;
constexpr size_t WS_BW1 = 20 * MiB + 256 * 1024, WS_BW2 = 21 * MiB;
constexpr size_t WS_BW1B = 26 * MiB, WS_BW2B = 26 * MiB + 768 * 1024;
constexpr size_t WS_SSQA = 22 * MiB, WS_SSQB = 24 * MiB;
constexpr size_t WS_W = 28 * MiB;
constexpr size_t WS_W1T = WS_W, WS_W2T = WS_W + 32 * MiB, WS_WMIX = WS_W + 64 * MiB;
constexpr size_t WS_WO_T = WS_WMIX + 26 * MiB;
constexpr size_t WS_H = 128 * MiB;
constexpr size_t WS_S = 384 * MiB;
constexpr size_t WS_QKV = WS_S;
constexpr size_t WS_PROJ = WS_S, WS_OB = WS_S + 800 * MiB;
constexpr size_t WS_DOWN = WS_S, WS_Q = WS_S + 128 * MiB, WS_KV = WS_S + 512 * MiB;
constexpr size_t WS_HID = WS_S;
constexpr size_t WS_WB = WS_S + 1056 * MiB;
constexpr size_t WS_END = WS_WB + 100 * MiB;
static_assert(WS_WO_T + 8 * MiB <= WS_H && WS_OB + 256 * MiB <= WS_END && WS_KV + 512 * MiB <= WS_END && WS_HID + 1024 * MiB <= WS_END, "ws map");
constexpr int CW_BAR = 4096;
constexpr int CW_PREP = 8192;

constexpr int RING_BYTES = 131072;
constexpr int LDSCTL_OFF = 144 * 1024 - 512;
constexpr int LDS_BYTES = 147456;

typedef unsigned short bf16;
typedef unsigned v4u __attribute__((ext_vector_type(4)));
typedef unsigned v2u __attribute__((ext_vector_type(2)));
typedef unsigned v3u __attribute__((ext_vector_type(3)));
typedef float f32x4 __attribute__((ext_vector_type(4)));
typedef float f32x2 __attribute__((ext_vector_type(2)));
typedef short bf16x8 __attribute__((ext_vector_type(8)));
typedef GAS unsigned gu32;
#define RLX_AGENT __ATOMIC_RELAXED, __HIP_MEMORY_SCOPE_AGENT
#define LDS_WAIT() asm volatile("s_waitcnt lgkmcnt(0)" ::: "memory")
#define VM_WAIT() asm volatile("s_waitcnt vmcnt(0)" ::: "memory")
__device__ __forceinline__ unsigned f2bf(float f) { unsigned u = __builtin_bit_cast(unsigned, f); return (u + 0x7fffu + ((u >> 16) & 1u)) >> 16; }
typedef __bf16 bf16x2_t __attribute__((ext_vector_type(2)));
__device__ __forceinline__ unsigned pk2c(float lo, float hi) { const f32x2 v = {lo, hi}; const bf16x2_t b = __builtin_convertvector(v, bf16x2_t); return __builtin_bit_cast(unsigned, b); }
__device__ __forceinline__ unsigned pk2(float lo, float hi) { unsigned r; asm volatile("v_cvt_pk_bf16_f32 %0, %1, %2" : "=v"(r) : "v"(lo), "v"(hi)); return r; }
__device__ __forceinline__ float bflo(unsigned u) { return __uint_as_float(u << 16); }
__device__ __forceinline__ float bfhi(unsigned u) { return __uint_as_float(u & 0xffff0000u); }
__device__ __forceinline__ int seq_of_row(int row) { return row < MP ? (row >> 11) : 16 + ((row - MP) >> 13); }
__device__ __forceinline__ int pos_of_row(int row) { return row < MP ? (row & 2047) : (row & 8191); }
__device__ __forceinline__ float wave_sum(float v) {
#pragma unroll
    for (int o = 1; o < 64; o <<= 1) v += __shfl_xor(v, o);
    return v;
}
namespace pg8 {
typedef unsigned short bf16_t;
typedef short bf16x8 __attribute__((ext_vector_type(8)));
typedef float f32x4 __attribute__((ext_vector_type(4)));
typedef unsigned u32x4 __attribute__((ext_vector_type(4)));
constexpr int BM = 256, BK = 64, HALF = 128, HTB = HALF * BK * 2  , STAGE_BYTES = 8 * HTB, NXCD = 8, WGM = 8;

__host__ __device__ __forceinline__ int lds_byte(int r, int c) { const int st = (r >> 4) * 2 + (c >> 5), rr = r & 15, cc = c & 31, ob = rr * 64 + cc * 2; return st * 1024 + (ob ^ (((ob >> 9) & 1) << 5)); }
__host__ __device__ __forceinline__ void stage_rc(int b, int& R, int& C) { const int st = b / 1024, sb = b % 1024, swz = sb ^ (((sb >> 9) & 1) << 5); R = (st >> 1) * 16 + swz / 64; C = (st & 1) * 32 + (swz % 64) / 2; }
__host__ __device__ __forceinline__ int perm32(int rho) { const int n = rho >> 4, i = rho & 15; return 8 * (i >> 2) + 4 * n + (i & 3); }

struct Unit { int pm, pn; };
struct Gemm { const bf16_t* A; const bf16_t* Bt; int M, N, K, lda, pairA; };

struct StaticOrder {
    int nM, nN, nwg, G, c, reps, wgm;
    __host__ __device__ void init(int M, int N, int G_, int c_, int reps_ = 1, int wgm_ = 4) { nM = M / BM; nN = N / BM; nwg = nM * nN; G = G_; c = c_; reps = reps_; wgm = wgm_; }
    __host__ __device__ bool next(int i, Unit& u) const {
        long L = (long)i * G + c; if (L >= (long)nwg * reps) return false;
        L %= nwg;
        int wgid = (int)L; { const int q = nwg / NXCD, r = nwg % NXCD, xcd = wgid % NXCD, off = wgid / NXCD; wgid = (xcd < r ? xcd * (q + 1) : r * (q + 1) + (xcd - r) * q) + off; }
        const int nig = wgm * nN, gid = wgid / nig, fm = gid * wgm, gsz = (nM - fm) < wgm ? (nM - fm) : wgm;
        u.pm = fm + ((wgid % nig) % gsz); u.pn = (wgid % nig) / gsz; return true;
    }
    __device__ __forceinline__ void a_ready(const Unit&) const {}
    __device__ __forceinline__ void done(const Unit&) const {}
};


__device__ __forceinline__ unsigned cvt_pk_bf16(float lo, float hi) { return ::pk2(lo, hi); }
template <int ACT> struct EpiBf16N {
    static constexpr bool PERM = true, AFTER_DRAIN = false, OWN_ALIGN = true;
    bf16_t* O; int ldc; const float* ssq; const float* bw; int ldbw;
    __device__ __forceinline__ void operator()(const f32x4 (&acc)[2][2][4][2], const Unit& u, int wr, int wc, int fr, int fq) const {
        const int rowt = u.pm * BM, row0 = rowt + wr * 64 + fr, col0 = u.pn * BM + wc * 32 + 8 * fq;
        const int seq = rowt < 32768 ? (rowt >> 11) : 16 + ((rowt - 32768) >> 13);
        typedef float f32x2v __attribute__((ext_vector_type(2)));
        f32x2v pv[8]; f32x4 bv[2][2];
#pragma unroll
        for (int i = 0; i < 8; ++i) pv[i] = *(const f32x2v*)(ssq + (size_t)(row0 + (i >> 2) * HALF + (i & 3) * 16) * 8 + 2 * fq);
#pragma unroll
        for (int bj = 0; bj < 2; ++bj)
#pragma unroll
            for (int n = 0; n < 2; ++n) bv[bj][n] = *(const f32x4*)(bw + (size_t)seq * ldbw + col0 + bj * HALF + 4 * n);
        asm volatile("" ::: "memory"); if (wr == 0) __builtin_amdgcn_s_barrier(); asm volatile("" ::: "memory");
        float rs[8];
#pragma unroll
        for (int i = 0; i < 8; ++i) { float s = pv[i].x + pv[i].y; s += __shfl_xor(s, 16); s += __shfl_xor(s, 32); rs[i] = __builtin_amdgcn_rsqf(s * (1.f / 2048.f) + 1e-6f); }
#pragma unroll
        for (int ai = 0; ai < 2; ++ai)
#pragma unroll
            for (int m = 0; m < 4; ++m) { const int r = row0 + ai * HALF + m * 16; const float rsr = rs[ai * 4 + m];
                bf16_t* rowp = O + (size_t)r * ldc + col0;
#pragma unroll
                for (int bj = 0; bj < 2; ++bj) { f32x4 v0 = acc[ai][bj][m][0] * rsr + bv[bj][0], v1 = acc[ai][bj][m][1] * rsr + bv[bj][1];
                    if (ACT == 1) {
#pragma unroll
                        for (int j = 0; j < 4; ++j) { const float a = fmaxf(v0[j], 0.f), b = fmaxf(v1[j], 0.f); v0[j] = a * a; v1[j] = b * b; } }
                    u32x4 w; w.x = cvt_pk_bf16(v0[0], v0[1]); w.y = cvt_pk_bf16(v0[2], v0[3]); w.z = cvt_pk_bf16(v1[0], v1[1]); w.w = cvt_pk_bf16(v1[2], v1[3]);
                    *(u32x4*)(rowp + bj * HALF) = w; } }
    }
};
struct EpiResGateNorm {
    static constexpr bool PERM = false, AFTER_DRAIN = false, OWN_ALIGN = false;
    const float* in0; const float* in1; float* out; const float* gate;
    bf16_t* xa; const float* gn; const float* sc; float* ssq; PG8_LAS float* xl;
    __device__ __forceinline__ void operator()(const f32x4 (&acc)[2][2][4][2], const Unit& u, int wr, int wc, int fr, int fq) const {
        const int rowt = u.pm * BM, row0 = rowt + wr * 64 + fr, col0 = u.pn * BM + wc * 32 + 4 * fq;
        const int seq = rowt < 32768 ? (rowt >> 11) : 16 + ((rowt - 32768) >> 13);
        const float* gp = gate + (size_t)seq * 12288 + col0;
        typedef unsigned u32x2 __attribute__((ext_vector_type(2)));
        u32x2 dp[2][2][4][2];
        {
            f32x4 gv[2][2];
#pragma unroll
            for (int bj = 0; bj < 2; ++bj)
#pragma unroll
                for (int n = 0; n < 2; ++n) gv[bj][n] = *(const f32x4*)(gp + bj * HALF + n * 16);
#pragma unroll
            for (int ai = 0; ai < 2; ++ai)
#pragma unroll
                for (int bj = 0; bj < 2; ++bj)
#pragma unroll
                    for (int m = 0; m < 4; ++m)
#pragma unroll
                        for (int n = 0; n < 2; ++n) { const f32x4 d = gv[bj][n] * acc[ai][bj][m][n]; dp[ai][bj][m][n] = (u32x2){cvt_pk_bf16(d[0], d[1]), cvt_pk_bf16(d[2], d[3])}; }
        }
        asm volatile("" ::: "memory");
        const float* base = in0 ? (rowt < 32768 ? in0 : in1 - (size_t)32768 * 2048) : out;
        f32x4 av[2][2];
#pragma unroll
        for (int bj = 0; bj < 2; ++bj)
#pragma unroll
            for (int n = 0; n < 2; ++n) { if (xa) av[bj][n] = *(const f32x4*)(gn + col0 + bj * HALF + n * 16) * (*(const f32x4*)(sc + (size_t)seq * 12288 + col0 + bj * HALF + n * 16) + 1.0f); else av[bj][n] = (f32x4){0.f, 0.f, 0.f, 0.f}; }
#pragma unroll
        for (int ai = 0; ai < 2; ++ai) {
            f32x4 bsv[4][2][2];
#pragma unroll
            for (int m = 0; m < 4; ++m)
#pragma unroll
                for (int bj = 0; bj < 2; ++bj)
#pragma unroll
                    for (int n = 0; n < 2; ++n) bsv[m][bj][n] = *(const f32x4*)(base + (size_t)(row0 + ai * HALF + m * 16) * 2048 + col0 + bj * HALF + n * 16);
            asm volatile("" ::: "memory");
#pragma unroll
            for (int m = 0; m < 4; ++m) { const size_t off = (size_t)(row0 + ai * HALF + m * 16) * 2048 + col0; float ss = 0.f;
#pragma unroll
                for (int bj = 0; bj < 2; ++bj)
#pragma unroll
                    for (int n = 0; n < 2; ++n) { const u32x2 dq = dp[ai][bj][m][n];
                        const f32x4 d = {__uint_as_float(dq.x << 16), __uint_as_float(dq.x & 0xffff0000u), __uint_as_float(dq.y << 16), __uint_as_float(dq.y & 0xffff0000u)};
                        const f32x4 o = bsv[m][bj][n] + d;
                        *(f32x4*)(out + off + bj * HALF + n * 16) = o;
                        if (xa) { const f32x4 y = o * av[bj][n]; ss += (o[0] * o[0] + o[1] * o[1]) + (o[2] * o[2] + o[3] * o[3]);
                            *(u32x2*)(xa + off + bj * HALF + n * 16) = (u32x2){cvt_pk_bf16(y[0], y[1]), cvt_pk_bf16(y[2], y[3])}; } }
                if (xa) { ss += __shfl_xor(ss, 16); ss += __shfl_xor(ss, 32);
                    if (fq == 0) xl[(ai * HALF + wr * 64 + m * 16 + fr) * 4 + wc] = ss; } }
            asm volatile("" ::: "memory");
        }
        if (xa) {
            asm volatile("s_waitcnt lgkmcnt(0)" ::: "memory"); __builtin_amdgcn_s_barrier(); asm volatile("" ::: "memory");
            const int t = threadIdx.x;
            if (t < 256) { const f32x4 p = *(const PG8_LAS f32x4*)(xl + t * 4); ssq[(size_t)(rowt + t) * 8 + u.pn] = (p[0] + p[1]) + (p[2] + p[3]); }
        }
    }
};
template <int MODE>
struct EpiResGateNormB {
    static constexpr bool PERM = true, AFTER_DRAIN = false, OWN_ALIGN = true;
    const float* in0; const float* in1; float* out; const float* gate;
    bf16_t* xa; const float* gn; const float* sc; float* ssq; PG8_LAS float* xl;
    static __device__ __forceinline__ void unpack(u32x4 w, f32x4& lo, f32x4& hi) {
        lo = (f32x4){__uint_as_float(w.x << 16), __uint_as_float(w.x & 0xffff0000u), __uint_as_float(w.y << 16), __uint_as_float(w.y & 0xffff0000u)};
        hi = (f32x4){__uint_as_float(w.z << 16), __uint_as_float(w.z & 0xffff0000u), __uint_as_float(w.w << 16), __uint_as_float(w.w & 0xffff0000u)};
    }
    static __device__ __forceinline__ u32x4 pack(f32x4 lo, f32x4 hi) { u32x4 w; w.x = cvt_pk_bf16(lo[0], lo[1]); w.y = cvt_pk_bf16(lo[2], lo[3]); w.z = cvt_pk_bf16(hi[0], hi[1]); w.w = cvt_pk_bf16(hi[2], hi[3]); return w; }
    __device__ __forceinline__ void operator()(const f32x4 (&acc)[2][2][4][2], const Unit& u, int wr, int wc, int fr, int fq) const {
        const int rowt = u.pm * BM, row0 = rowt + wr * 64 + fr, col0 = u.pn * BM + wc * 32 + 8 * fq;
        const int seq = rowt < 32768 ? (rowt >> 11) : 16 + ((rowt - 32768) >> 13);
        const float* gp = gate + (size_t)seq * 12288 + col0;
        bf16_t* const xb = (bf16_t*)out + (size_t)row0 * 4096 + u.pn * 512 + wc * 32 + 8 * fq;
        f32x4 gv[2][2], av[2][2];
        if constexpr (MODE == 0) {
            typedef unsigned u32x2 __attribute__((ext_vector_type(2)));
            u32x2 dp[2][2][4][2];
#pragma unroll
            for (int bj = 0; bj < 2; ++bj)
#pragma unroll
                for (int n = 0; n < 2; ++n) gv[bj][n] = *(const f32x4*)(gp + bj * HALF + 4 * n);
            asm volatile("" ::: "memory"); if (wr == 0) __builtin_amdgcn_s_barrier(); asm volatile("" ::: "memory");
#pragma unroll
            for (int ai = 0; ai < 2; ++ai)
#pragma unroll
                for (int bj = 0; bj < 2; ++bj)
#pragma unroll
                    for (int m = 0; m < 4; ++m)
#pragma unroll
                        for (int n = 0; n < 2; ++n) { const f32x4 d = gv[bj][n] * acc[ai][bj][m][n]; dp[ai][bj][m][n] = (u32x2){cvt_pk_bf16(d[0], d[1]), cvt_pk_bf16(d[2], d[3])}; }
            asm volatile("" ::: "memory");
#pragma unroll
            for (int bj = 0; bj < 2; ++bj)
#pragma unroll
                for (int n = 0; n < 2; ++n) av[bj][n] = *(const f32x4*)(sc + (size_t)seq * 12288 + col0 + bj * HALF + 4 * n);
            const float* base = rowt < 32768 ? in0 : in1 - (size_t)32768 * 2048;
#pragma unroll
            for (int ai = 0; ai < 2; ++ai) {
                f32x4 bsv[4][2][2];
#pragma unroll
                for (int m = 0; m < 4; ++m)
#pragma unroll
                    for (int bj = 0; bj < 2; ++bj)
#pragma unroll
                        for (int n = 0; n < 2; ++n) bsv[m][bj][n] = *(const f32x4*)(base + (size_t)(row0 + ai * HALF + m * 16) * 2048 + col0 + bj * HALF + 4 * n);
                asm volatile("" ::: "memory");
#pragma unroll
                for (int m = 0; m < 4; ++m) { const size_t off = (size_t)(row0 + ai * HALF + m * 16) * 2048 + col0; float ss = 0.f;
#pragma unroll
                    for (int bj = 0; bj < 2; ++bj) { f32x4 o[2];
#pragma unroll
                        for (int n = 0; n < 2; ++n) { const u32x2 dq = dp[ai][bj][m][n];
                            const f32x4 d = {__uint_as_float(dq.x << 16), __uint_as_float(dq.x & 0xffff0000u), __uint_as_float(dq.y << 16), __uint_as_float(dq.y & 0xffff0000u)};
                            o[n] = bsv[m][bj][n] + d; ss += (o[n][0] * o[n][0] + o[n][1] * o[n][1]) + (o[n][2] * o[n][2] + o[n][3] * o[n][3]); }
                        *(u32x4*)(xb + (size_t)(ai * HALF + m * 16) * 4096 + bj * HALF) = pack(o[0], o[1]);
                        *(u32x4*)(xa + off + bj * HALF) = pack(o[0] * av[bj][0], o[1] * av[bj][1]); }
                    ss += __shfl_xor(ss, 16); ss += __shfl_xor(ss, 32);
                    if (fq == 0) xl[(ai * HALF + wr * 64 + m * 16 + fr) * 4 + wc] = ss; }
                asm volatile("" ::: "memory");
            }
        } else {
            u32x4 xv[2][4][2], dpk[2][4][2];
#pragma unroll
            for (int bj = 0; bj < 2; ++bj)
#pragma unroll
                for (int n = 0; n < 2; ++n) gv[bj][n] = *(const f32x4*)(gp + bj * HALF + 4 * n);
#pragma unroll
            for (int m = 0; m < 4; ++m)
#pragma unroll
                for (int bj = 0; bj < 2; ++bj) xv[0][m][bj] = *(const u32x4*)(xb + (size_t)(m * 16) * 4096 + bj * HALF);
            asm volatile("" ::: "memory"); if (wr == 0) __builtin_amdgcn_s_barrier(); asm volatile("" ::: "memory");
#pragma unroll
            for (int ai = 0; ai < 2; ++ai)
#pragma unroll
                for (int m = 0; m < 4; ++m)
#pragma unroll
                    for (int bj = 0; bj < 2; ++bj) dpk[ai][m][bj] = pack(gv[bj][0] * acc[ai][bj][m][0], gv[bj][1] * acc[ai][bj][m][1]);
            asm volatile("" ::: "memory");
#pragma unroll
            for (int bj = 0; bj < 2; ++bj)
#pragma unroll
                for (int n = 0; n < 2; ++n) { if constexpr (MODE == 1) av[bj][n] = *(const f32x4*)(sc + (size_t)seq * 12288 + col0 + bj * HALF + 4 * n); else av[bj][n] = (f32x4){0.f, 0.f, 0.f, 0.f}; }
#pragma unroll
            for (int m = 0; m < 4; ++m)
#pragma unroll
                for (int bj = 0; bj < 2; ++bj) xv[1][m][bj] = *(const u32x4*)(xb + (size_t)(HALF + m * 16) * 4096 + bj * HALF);
            if constexpr (MODE == 2) { asm volatile("s_waitcnt vmcnt(0)" ::: "memory"); __builtin_amdgcn_s_barrier(); }
            asm volatile("" ::: "memory");
#pragma unroll
            for (int ai = 0; ai < 2; ++ai) {
#pragma unroll
                for (int m = 0; m < 4; ++m) { const size_t off = (size_t)(row0 + ai * HALF + m * 16) * 2048 + col0; float ss = 0.f;
#pragma unroll
                    for (int bj = 0; bj < 2; ++bj) { f32x4 o[2], d[2]; unpack(xv[ai][m][bj], o[0], o[1]); unpack(dpk[ai][m][bj], d[0], d[1]); o[0] += d[0]; o[1] += d[1];
                        if constexpr (MODE == 2) { *(f32x4*)(out + off + bj * HALF) = o[0]; *(f32x4*)(out + off + bj * HALF + 4) = o[1]; }
                        else {
#pragma unroll
                            for (int n = 0; n < 2; ++n) ss += (o[n][0] * o[n][0] + o[n][1] * o[n][1]) + (o[n][2] * o[n][2] + o[n][3] * o[n][3]);
                            *(u32x4*)(xb + (size_t)(ai * HALF + m * 16) * 4096 + bj * HALF) = pack(o[0], o[1]);
                            *(u32x4*)(xa + off + bj * HALF) = pack(o[0] * av[bj][0], o[1] * av[bj][1]); } }
                    if constexpr (MODE != 2) { ss += __shfl_xor(ss, 16); ss += __shfl_xor(ss, 32);
                        if (fq == 0) xl[(ai * HALF + wr * 64 + m * 16 + fr) * 4 + wc] = ss; } }
                asm volatile("" ::: "memory");
            }
        }
        if constexpr (MODE != 2) {
            asm volatile("s_waitcnt lgkmcnt(0)" ::: "memory"); __builtin_amdgcn_s_barrier(); asm volatile("" ::: "memory");
            const int t = threadIdx.x;
            if (t < 256) { const f32x4 p = *(const PG8_LAS f32x4*)(xl + t * 4); ssq[(size_t)(rowt + t) * 8 + u.pn] = (p[0] + p[1]) + (p[2] + p[3]); }
        }
    }
};
constexpr float QSCALE = 0.088388347648318440f * 1.4426950408889634f;
struct EpiBf16NRope {
    static constexpr bool PERM = true, AFTER_DRAIN = false, OWN_ALIGN = true;
    bf16_t* O; int ldc; const float* ssq; const float* bw; int ldbw;
    const float* qg; const float* kg; const float* rope; PG8_LAS float* hs;
    __device__ __forceinline__ void operator()(f32x4 (&acc)[2][2][4][2], const Unit& u, int wr, int wc, int fr, int fq) const {
        const int rowt = u.pm * BM, row0 = rowt + wr * 64 + fr, col0 = u.pn * BM + wc * 32 + 8 * fq;
        const int seq = rowt < 32768 ? (rowt >> 11) : 16 + ((rowt - 32768) >> 13);
        const bool roped = u.pn < 10;
        typedef float f32x2v __attribute__((ext_vector_type(2)));
        f32x2v pv[8]; f32x4 bv[2][2], gv[2];
#pragma unroll
        for (int i = 0; i < 8; ++i) pv[i] = *(const f32x2v*)(ssq + (size_t)(row0 + (i >> 2) * HALF + (i & 3) * 16) * 8 + 2 * fq);
#pragma unroll
        for (int bj = 0; bj < 2; ++bj)
#pragma unroll
            for (int n = 0; n < 2; ++n) bv[bj][n] = *(const f32x4*)(bw + (size_t)seq * ldbw + col0 + bj * HALF + 4 * n);
        { const float* g = (u.pn < 8 ? qg : kg) + wc * 32 + 8 * fq; gv[0] = *(const f32x4*)g; gv[1] = *(const f32x4*)(g + 4);
          if (u.pn < 8) { gv[0] *= QSCALE; gv[1] *= QSCALE; } }
        asm volatile("" ::: "memory"); if (wr == 0) __builtin_amdgcn_s_barrier(); asm volatile("" ::: "memory");
        float rs[8];
#pragma unroll
        for (int i = 0; i < 8; ++i) { float s = pv[i].x + pv[i].y; s += __shfl_xor(s, 16); s += __shfl_xor(s, 32); rs[i] = __builtin_amdgcn_rsqf(s * (1.f / 2048.f) + 1e-6f); }
#pragma unroll
        for (int ai = 0; ai < 2; ++ai)
#pragma unroll
            for (int m = 0; m < 4; ++m)
#pragma unroll
                for (int bj = 0; bj < 2; ++bj) { const float rsr = rs[ai * 4 + m];
                    acc[ai][bj][m][0] = acc[ai][bj][m][0] * rsr + bv[bj][0]; acc[ai][bj][m][1] = acc[ai][bj][m][1] * rsr + bv[bj][1];
                    if (roped) { const f32x4 a = acc[ai][bj][m][0], b = acc[ai][bj][m][1];
                        float s = ((a[0] * a[0] + a[1] * a[1]) + (a[2] * a[2] + a[3] * a[3])) + ((b[0] * b[0] + b[1] * b[1]) + (b[2] * b[2] + b[3] * b[3]));
                        s += __shfl_xor(s, 16); s += __shfl_xor(s, 32);
                        if (fq == 0) hs[((ai * HALF + wr * 64 + m * 16 + fr) * 2 + bj) * 4 + wc] = s; } }
        if (roped) { asm volatile("s_waitcnt lgkmcnt(0)" ::: "memory"); __builtin_amdgcn_s_barrier(); asm volatile("" ::: "memory"); }
#pragma unroll
        for (int ai = 0; ai < 2; ++ai) {
            f32x4 cs[4][2];
            if (roped) {
#pragma unroll
                for (int m = 0; m < 4; ++m) { const int r = row0 + ai * HALF + m * 16, t = r < 32768 ? (r & 2047) : (r & 8191);
                    const float* rp = rope + (size_t)((wc < 2 ? (t >> 6) : 128 + (t & 63)) * 32 + (wc & 1) * 16 + 4 * fq) * 2;
                    cs[m][0] = *(const f32x4*)rp; cs[m][1] = *(const f32x4*)(rp + 4); }
            }
#pragma unroll
            for (int m = 0; m < 4; ++m) { const int r = row0 + ai * HALF + m * 16; bf16_t* rowp = O + (size_t)r * ldc + col0;
#pragma unroll
                for (int bj = 0; bj < 2; ++bj) { f32x4 v0 = acc[ai][bj][m][0], v1 = acc[ai][bj][m][1];
                    if (roped) { const f32x4 hp = *(const PG8_LAS f32x4*)(hs + ((ai * HALF + wr * 64 + m * 16 + fr) * 2 + bj) * 4);
                        const float hr = __builtin_amdgcn_rsqf(((hp[0] + hp[1]) + (hp[2] + hp[3])) * (1.f / 128.f) + 1e-6f);
                        v0 = v0 * hr * gv[0]; v1 = v1 * hr * gv[1];
                        const f32x4 c0 = cs[m][0], c1 = cs[m][1];
                        const float a0 = v0[0] * c0[0] - v0[1] * c0[1], a1 = v0[0] * c0[1] + v0[1] * c0[0], a2 = v0[2] * c0[2] - v0[3] * c0[3], a3 = v0[2] * c0[3] + v0[3] * c0[2];
                        const float b0 = v1[0] * c1[0] - v1[1] * c1[1], b1 = v1[0] * c1[1] + v1[1] * c1[0], b2 = v1[2] * c1[2] - v1[3] * c1[3], b3 = v1[2] * c1[3] + v1[3] * c1[2];
                        v0 = (f32x4){a0, a1, a2, a3}; v1 = (f32x4){b0, b1, b2, b3}; }
                    u32x4 w; w.x = cvt_pk_bf16(v0[0], v0[1]); w.y = cvt_pk_bf16(v0[2], v0[3]); w.z = cvt_pk_bf16(v1[0], v1[1]); w.w = cvt_pk_bf16(v1[2], v1[3]);
                    *(u32x4*)(rowp + bj * HALF) = w; } }
        }
    }
};
struct EpiBf16KV {
    static constexpr bool PERM = true, AFTER_DRAIN = false, OWN_ALIGN = false;
    bf16_t* O; int ldc; const float* kg; PG8_LAS float* hs;
    __device__ __forceinline__ void operator()(const f32x4 (&acc)[2][2][4][2], const Unit& u, int wr, int wc, int fr, int fq) const {
        const int row0 = u.pm * BM + wr * 64 + fr, col0 = u.pn * BM + wc * 32 + 8 * fq;
        const f32x4 g0 = *(const f32x4*)(kg + wc * 32 + 8 * fq), g1 = *(const f32x4*)(kg + wc * 32 + 8 * fq + 4);
#pragma unroll
        for (int ai = 0; ai < 2; ++ai)
#pragma unroll
            for (int m = 0; m < 4; ++m) { const f32x4 a = acc[ai][0][m][0], b = acc[ai][0][m][1];
                float s = ((a[0] * a[0] + a[1] * a[1]) + (a[2] * a[2] + a[3] * a[3])) + ((b[0] * b[0] + b[1] * b[1]) + (b[2] * b[2] + b[3] * b[3]));
                s += __shfl_xor(s, 16); s += __shfl_xor(s, 32);
                if (fq == 0) hs[(ai * HALF + wr * 64 + m * 16 + fr) * 4 + wc] = s; }
#pragma unroll
        for (int ai = 0; ai < 2; ++ai)
#pragma unroll
            for (int m = 0; m < 4; ++m) { bf16_t* rowp = O + (size_t)(row0 + ai * HALF + m * 16) * ldc + col0 + HALF;
                const f32x4 v0 = acc[ai][1][m][0], v1 = acc[ai][1][m][1];
                u32x4 w; w.x = cvt_pk_bf16(v0[0], v0[1]); w.y = cvt_pk_bf16(v0[2], v0[3]); w.z = cvt_pk_bf16(v1[0], v1[1]); w.w = cvt_pk_bf16(v1[2], v1[3]); *(u32x4*)rowp = w; }
        asm volatile("s_waitcnt lgkmcnt(0)" ::: "memory"); __builtin_amdgcn_s_barrier(); asm volatile("" ::: "memory");
#pragma unroll
        for (int ai = 0; ai < 2; ++ai)
#pragma unroll
            for (int m = 0; m < 4; ++m) { bf16_t* rowp = O + (size_t)(row0 + ai * HALF + m * 16) * ldc + col0;
                const f32x4 hp = *(const PG8_LAS f32x4*)(hs + (ai * HALF + wr * 64 + m * 16 + fr) * 4);
                const float hr = __builtin_amdgcn_rsqf(((hp[0] + hp[1]) + (hp[2] + hp[3])) * (1.f / 128.f) + 1e-6f);
                const f32x4 v0 = acc[ai][0][m][0] * hr * g0, v1 = acc[ai][0][m][1] * hr * g1;
                u32x4 w; w.x = cvt_pk_bf16(v0[0], v0[1]); w.y = cvt_pk_bf16(v0[2], v0[3]); w.z = cvt_pk_bf16(v1[0], v1[1]); w.w = cvt_pk_bf16(v1[2], v1[3]); *(u32x4*)rowp = w; }
    }
};
struct EpiBf16P {
    static constexpr bool PERM = true, AFTER_DRAIN = false, OWN_ALIGN = false;
    bf16_t* O; int ldc;
    __device__ __forceinline__ void operator()(const f32x4 (&acc)[2][2][4][2], const Unit& u, int wr, int wc, int fr, int fq) const {
        const int row0 = u.pm * BM + wr * 64 + fr, col0 = u.pn * BM + wc * 32 + 8 * fq;
#pragma unroll
        for (int ai = 0; ai < 2; ++ai)
#pragma unroll
            for (int m = 0; m < 4; ++m) { bf16_t* rowp = O + (size_t)(row0 + ai * HALF + m * 16) * ldc + col0;
#pragma unroll
                for (int bj = 0; bj < 2; ++bj) { const f32x4 v0 = acc[ai][bj][m][0], v1 = acc[ai][bj][m][1];
                    u32x4 w; w.x = cvt_pk_bf16(v0[0], v0[1]); w.y = cvt_pk_bf16(v0[2], v0[3]); w.z = cvt_pk_bf16(v1[0], v1[1]); w.w = cvt_pk_bf16(v1[2], v1[3]);
                    *(u32x4*)(rowp + bj * HALF) = w; } }
    }
};
template <class Epi, class Sched, bool ALIGN_EPI = false, bool SP2 = false>
__device__ __forceinline__ void gemm_phase(PG8_LAS unsigned char* lds, const Gemm g, const Sched& S, const Epi& E) {
    const int tid = threadIdx.x, wid = __builtin_amdgcn_readfirstlane(tid >> 6), lane = tid & 63, wr = wid >> 2, wc = wid & 3, fr = lane & 15, fq = lane >> 4;
    const int K = g.K, nt = K / BK;
    unsigned voffA[2], voffB[2];
#pragma unroll
    for (int i = 0; i < 2; ++i) { int R, C; stage_rc(tid * 16 + i * 8192, R, C); const int Rb = Epi::PERM ? ((R & ~31) + perm32(R & 31)) : R;
        voffA[i] = (unsigned)(R * g.lda + C) * 2u; voffB[i] = (unsigned)(Rb * K + C) * 2u; }
    const size_t kstep = (size_t)(BK * 2);
    const size_t hstepB = (size_t)HALF * K * 2, hstepA = (size_t)HALF * g.lda * 2;
    const size_t tstepA = 2 * hstepA, tstepB = 2 * hstepB;
    const unsigned ldsw = (unsigned)wid * 1024u;
    const int aoff = lds_byte(wr * 64 + fr, fq * 8), boff = lds_byte(wc * 32 + fr, fq * 8);
#define PG8_SA(b, h) (((b) * 2 + (h)) * HTB)
#define PG8_SB(b, h) ((4 + (b) * 2 + (h)) * HTB)
#define PG8_STAGE(bufoff, gbase, voff) do { _Pragma("unroll") for (int _i = 0; _i < 2; ++_i) \
        __builtin_amdgcn_global_load_lds((const unsigned*)((const char*)(gbase) + (voff)[_i]), (PG8_LAS unsigned*)(lds + (bufoff) + ldsw + _i * 8192), 16, 0, 0); } while (0)
#define PG8_LDA(dst, b, h) do { _Pragma("unroll") for (int m = 0; m < 4; ++m) _Pragma("unroll") for (int k = 0; k < 2; ++k) dst[m][k] = *(const PG8_LAS bf16x8*)(lds + PG8_SA(b, h) + aoff + m * 2048 + k * 1024); } while (0)
#define PG8_LDB(dst, b, h) do { _Pragma("unroll") for (int n = 0; n < 2; ++n) _Pragma("unroll") for (int k = 0; k < 2; ++k) dst[n][k] = *(const PG8_LAS bf16x8*)(lds + PG8_SB(b, h) + boff + n * 2048 + k * 1024); } while (0)
#define PG8_MMA(ai, bj, At, Bt) do { __builtin_amdgcn_s_setprio(1); _Pragma("unroll") for (int m = 0; m < 4; ++m) _Pragma("unroll") for (int n = 0; n < 2; ++n) _Pragma("unroll") for (int k = 0; k < 2; ++k) \
        acc[ai][bj][m][n] = __builtin_amdgcn_mfma_f32_16x16x32_bf16(Bt[n][k], At[m][k], acc[ai][bj][m][n], 0, 0, 0); __builtin_amdgcn_s_setprio(0); } while (0)
#define PG8_WAIT_V(n) asm volatile("s_waitcnt vmcnt(" #n ")" ::: "memory")
#define PG8_WAIT_L(n) asm volatile("s_waitcnt lgkmcnt(" #n ")" ::: "memory")
#define PG8_BAR __builtin_amdgcn_s_barrier()
#define PG8_SCHED __builtin_amdgcn_sched_barrier(0)
    Unit cur, nxt; int ui = 0;
    if (!S.next(0, cur)) return;
    f32x4 acc[2][2][4][2];
#pragma unroll
    for (int a = 0; a < 2; ++a)
#pragma unroll
        for (int b = 0; b < 2; ++b)
#pragma unroll
            for (int m = 0; m < 4; ++m)
#pragma unroll
                for (int n = 0; n < 2; ++n) acc[a][b][m][n] = (f32x4){0.f, 0.f, 0.f, 0.f};
    bf16x8 At[4][2], B0[2][2], B1[2][2];
    const char* cA = (const char*)g.A + (size_t)cur.pm * tstepA; const char* cB = (const char*)g.Bt + (size_t)cur.pn * tstepB;
    S.a_ready(cur);
    if constexpr (SP2) {
        PG8_STAGE(PG8_SB(0, 0), cB, voffB); PG8_STAGE(PG8_SB(0, 1), cB + hstepB, voffB); PG8_STAGE(PG8_SA(0, 0), cA, voffA); PG8_STAGE(PG8_SA(0, 1), cA + hstepA, voffA);
        if (wr == 1) PG8_BAR;
        PG8_WAIT_V(2); PG8_BAR;
        PG8_STAGE(PG8_SB(1, 0), cB + kstep, voffB); PG8_STAGE(PG8_SA(1, 0), cA + kstep, voffA); PG8_STAGE(PG8_SB(1, 1), cB + hstepB + kstep, voffB);
        PG8_WAIT_V(6); PG8_BAR;
    } else {
        PG8_STAGE(PG8_SB(0, 0), cB, voffB); PG8_STAGE(PG8_SA(0, 0), cA, voffA); PG8_STAGE(PG8_SB(0, 1), cB + hstepB, voffB); PG8_STAGE(PG8_SA(0, 1), cA + hstepA, voffA);
        if (wr == 1) PG8_BAR;
        PG8_WAIT_V(4); PG8_BAR;
        PG8_STAGE(PG8_SB(1, 0), cB + kstep, voffB); PG8_STAGE(PG8_SA(1, 0), cA + kstep, voffA); PG8_STAGE(PG8_SB(1, 1), cB + hstepB + kstep, voffB);
        PG8_WAIT_V(6); PG8_BAR;
    }
    for (;;) {
        const bool has_next = S.next(ui + 1, nxt);
        const char* nA = has_next ? (const char*)g.A + (size_t)nxt.pm * tstepA : cA; const char* nB = has_next ? (const char*)g.Bt + (size_t)nxt.pn * tstepB : cB;
        for (int t = 0; t < nt; t += 2) {
            const bool last = (t == nt - 2);
            const char* a1 = cA + (size_t)(t >> 1) * g.pairA + kstep;
            const char* a2 = last ? nA : cA + (size_t)((t >> 1) + 1) * g.pairA; const char* b2 = last ? nB : cB + (size_t)(t + 2) * kstep;
            const char* a3 = a2 + kstep; const char* b3 = b2 + kstep;
            if (last && has_next) S.a_ready(nxt);
            if constexpr (SP2) {
            PG8_LDB(B0, 0, 0); PG8_LDB(B1, 0, 1); PG8_SCHED; PG8_LDA(At, 0, 0); PG8_STAGE(PG8_SA(1, 1), a1 + hstepA, voffA);
            PG8_WAIT_V(8); PG8_WAIT_L(0); PG8_BAR; PG8_MMA(0, 0, At, B0); PG8_MMA(0, 1, At, B1); PG8_BAR; PG8_SCHED;
            PG8_LDA(At, 0, 1); PG8_STAGE(PG8_SB(0, 0), b2, voffB); PG8_STAGE(PG8_SB(0, 1), b2 + hstepB, voffB); PG8_STAGE(PG8_SA(0, 0), a2, voffA);
            PG8_WAIT_V(8); PG8_WAIT_L(0); PG8_BAR; PG8_MMA(1, 0, At, B0); PG8_MMA(1, 1, At, B1); PG8_BAR; PG8_SCHED;
            PG8_LDB(B0, 1, 0); PG8_LDB(B1, 1, 1); PG8_SCHED; PG8_LDA(At, 1, 0); PG8_STAGE(PG8_SA(0, 1), a2 + hstepA, voffA);
            PG8_WAIT_V(8); PG8_WAIT_L(0); PG8_BAR; PG8_MMA(0, 0, At, B0); PG8_MMA(0, 1, At, B1); PG8_BAR; PG8_SCHED;
            PG8_LDA(At, 1, 1); PG8_STAGE(PG8_SB(1, 0), b3, voffB); PG8_STAGE(PG8_SB(1, 1), b3 + hstepB, voffB); PG8_STAGE(PG8_SA(1, 0), a3, voffA);
            PG8_WAIT_V(8); PG8_WAIT_L(0); PG8_BAR; PG8_MMA(1, 0, At, B0); PG8_MMA(1, 1, At, B1); PG8_BAR; PG8_SCHED;
            } else {
            PG8_LDB(B0, 0, 0); PG8_SCHED; PG8_LDA(At, 0, 0); PG8_STAGE(PG8_SA(1, 1), a1 + hstepA, voffA);
            PG8_WAIT_L(8); PG8_BAR; PG8_WAIT_L(0); PG8_MMA(0, 0, At, B0); PG8_BAR; PG8_SCHED;
            PG8_LDB(B1, 0, 1); PG8_STAGE(PG8_SB(0, 0), b2, voffB);
            PG8_BAR; PG8_WAIT_L(0); PG8_MMA(0, 1, At, B1); PG8_BAR;
            PG8_LDA(At, 0, 1); PG8_STAGE(PG8_SA(0, 0), a2, voffA);
            PG8_BAR; PG8_WAIT_L(0); PG8_MMA(1, 0, At, B0); PG8_BAR; PG8_SCHED;
            PG8_STAGE(PG8_SB(0, 1), b2 + hstepB, voffB);
            PG8_WAIT_V(6); PG8_BAR; PG8_MMA(1, 1, At, B1); PG8_BAR;
            PG8_LDB(B0, 1, 0); PG8_SCHED; PG8_LDA(At, 1, 0); PG8_STAGE(PG8_SA(0, 1), a2 + hstepA, voffA);
            PG8_WAIT_L(8); PG8_BAR; PG8_WAIT_L(0); PG8_MMA(0, 0, At, B0); PG8_BAR; PG8_SCHED;
            PG8_LDB(B1, 1, 1); PG8_STAGE(PG8_SB(1, 0), b3, voffB);
            PG8_BAR; PG8_WAIT_L(0); PG8_MMA(0, 1, At, B1); PG8_BAR;
            PG8_LDA(At, 1, 1); PG8_STAGE(PG8_SA(1, 0), a3, voffA);
            PG8_BAR; PG8_WAIT_L(0); PG8_MMA(1, 0, At, B0); PG8_BAR; PG8_SCHED;
            PG8_STAGE(PG8_SB(1, 1), b3 + hstepB, voffB);
            PG8_WAIT_V(6); PG8_BAR; PG8_MMA(1, 1, At, B1); PG8_BAR;
            }
        }
        if constexpr (ALIGN_EPI && !Epi::OWN_ALIGN) { if (wr == 0) PG8_BAR; }
        if constexpr (!Epi::AFTER_DRAIN) { E(acc, cur, wr, wc, fr, fq); S.done(cur); }
        if (!has_next) break;
#pragma unroll
        for (int a = 0; a < 2; ++a)
#pragma unroll
            for (int b = 0; b < 2; ++b)
#pragma unroll
                for (int m = 0; m < 4; ++m)
#pragma unroll
                    for (int n = 0; n < 2; ++n) acc[a][b][m][n] = (f32x4){0.f, 0.f, 0.f, 0.f};
        cur = nxt; cA = nA; cB = nB; ++ui;
        if constexpr (ALIGN_EPI) { if (wr == 1) PG8_BAR; }
    }
    PG8_WAIT_V(0);
    if constexpr (!ALIGN_EPI) { if (wr == 0) PG8_BAR; }
    PG8_BAR;
    if constexpr (Epi::AFTER_DRAIN) { E.fused(acc, cur, wr, wc, fr, fq, lds, wid, lane); S.done(cur); }
#undef PG8_SA
#undef PG8_SB
#undef PG8_STAGE
#undef PG8_LDA
#undef PG8_LDB
#undef PG8_MMA
#undef PG8_WAIT_V
#undef PG8_WAIT_L
#undef PG8_BAR
#undef PG8_SCHED
}
}

namespace attn {
using bf16x8 = __attribute__((ext_vector_type(8))) short;
using s16x4  = __attribute__((ext_vector_type(4))) short;
using f32x16 = __attribute__((ext_vector_type(16))) float;
using u32x4  = __attribute__((ext_vector_type(4))) unsigned;
using f32x4  = __attribute__((ext_vector_type(4))) float;
constexpr int NW = 8, QBLK = 32, KVBLK = 64;
constexpr float THR = 8.f;
#define SBAR() __builtin_amdgcn_sched_barrier(0)
__device__ __forceinline__ int crow(int r, int hi) { return (r & 3) + 8 * (r >> 2) + 4 * hi; }
__device__ __forceinline__ unsigned cvtpk(float lo, float hi) { unsigned r; asm volatile("v_cvt_pk_bf16_f32 %0, %1, %2\n\ts_nop 1" : "=v"(r) : "v"(lo), "v"(hi)); return r; }
template <bool VIS> __device__ __forceinline__ unsigned cvtpk_t(float lo, float hi) { if constexpr (VIS) return ::pk2c(lo, hi); else return cvtpk(lo, hi); }

template <int DQK> struct Cfg {
    static constexpr int KROW = DQK * 2;
    static constexpr int SHM_K = KVBLK * KROW, SHM_V = KVBLK * 128 * 2;
    static constexpr int NQR = DQK == 128 ? 8 : 6;
    static constexpr int QX_WAVE = (DQK / 16 - NQR) * 1024;
    static constexpr int SHM = 2 * SHM_V + 2 * SHM_K + NW * 64 * 4 + NW * QX_WAVE;
    static constexpr float SCALE = DQK == 128 ? 0.088388347648318440f : 0.072168783648703220f;
    static constexpr float C = SCALE * 1.4426950408889634f;
};
template <int DQK> __device__ __forceinline__ int kswz(int row, int colB) { return row * (DQK * 2) + (colB ^ ((row & (DQK == 128 ? 15 : 7)) << 4)); }

template <int DQK, bool NOMAX = false> __device__ __forceinline__ void partialSM(f32x16& p0, f32x16& p1, float& m_reg, float& mn, float& alpha, float shiftC = 0.f) {
  constexpr float THRS = THR * 1.4426950408889634f;
  if constexpr (NOMAX) {
    alpha = 1.f; mn = 0.f;
#pragma unroll
    for (int r = 0; r < 16; ++r) p0[r] = __builtin_amdgcn_exp2f(p0[r]);
    return;
  }
  float pmax = p0[0];
#pragma unroll
  for (int r = 1; r < 16; ++r) pmax = fmaxf(pmax, p0[r]);
#pragma unroll
  for (int r = 0; r < 16; ++r) pmax = fmaxf(pmax, p1[r]);
  { auto rr = __builtin_amdgcn_permlane32_swap(__float_as_uint(pmax), __float_as_uint(pmax), false, false);
    pmax = fmaxf(__uint_as_float(rr[0]), __uint_as_float(rr[1])); }
  if (__builtin_expect(__all(pmax - m_reg <= THRS), 1)) { mn = m_reg; alpha = 1.f; }
  else { mn = fmaxf(m_reg, pmax); alpha = __builtin_amdgcn_exp2f(m_reg - mn); m_reg = mn; }
#pragma unroll
  for (int r = 0; r < 16; ++r) p0[r] = p0[r] - mn;
#pragma unroll
  for (int r = 0; r < 16; ++r) p1[r] = p1[r] - mn;
#pragma unroll
  for (int r = 0; r < 16; ++r) p0[r] = __builtin_amdgcn_exp2f(p0[r]);
}
template <bool VIS> __device__ __forceinline__ void finishSM(f32x16& p0, f32x16& p1, float alpha, float& l_reg, bf16x8& pa0, bf16x8& pa1, bf16x8& pa2, bf16x8& pa3) {
#pragma unroll
  for (int r = 0; r < 16; ++r) p1[r] = __builtin_amdgcn_exp2f(p1[r]);
  float ps = 0;
#pragma unroll
  for (int r = 0; r < 16; ++r) ps += p0[r];
#pragma unroll
  for (int r = 0; r < 16; ++r) ps += p1[r];
  { auto rr = __builtin_amdgcn_permlane32_swap(__float_as_uint(ps), __float_as_uint(ps), false, false);
    ps = __uint_as_float(rr[0]) + __uint_as_float(rr[1]); }
  l_reg = l_reg * alpha + ps;
#define PK4(P, BASE, OUT) do { unsigned a0 = cvtpk_t<VIS>(P[BASE + 0], P[BASE + 1]), a1 = cvtpk_t<VIS>(P[BASE + 2], P[BASE + 3]);   \
    unsigned b0 = cvtpk_t<VIS>(P[BASE + 4], P[BASE + 5]), b1 = cvtpk_t<VIS>(P[BASE + 6], P[BASE + 7]);                              \
    auto r0 = __builtin_amdgcn_permlane32_swap(a0, b0, false, false); auto r1 = __builtin_amdgcn_permlane32_swap(a1, b1, false, false); \
    u32x4 w = {r0[0], r1[0], r0[1], r1[1]}; OUT = *reinterpret_cast<bf16x8*>(&w); } while (0)
  PK4(p0, 0, pa0); PK4(p0, 8, pa1); PK4(p1, 0, pa2); PK4(p1, 8, pa3);
#undef PK4
}
template <int DQK, int NQR> __device__ __forceinline__ void qkt(f32x16& p0, f32x16& p1, const char* Ks, const bf16x8* qr, const char* qx, int r32, int hi) {
  p0 = f32x16{}; p1 = f32x16{};
#pragma unroll
  for (int d0 = 0; d0 < DQK / 16; ++d0) { const int cb = (d0 * 16 + hi * 8) * 2;
    bf16x8 b0 = *reinterpret_cast<const bf16x8*>(Ks + kswz<DQK>(r32, cb));
    bf16x8 b1 = *reinterpret_cast<const bf16x8*>(Ks + kswz<DQK>(32 + r32, cb));
    bf16x8 q; if (d0 < NQR) q = qr[d0]; else q = *reinterpret_cast<const bf16x8*>(qx + (d0 - NQR) * 1024);
    p0 = __builtin_amdgcn_mfma_f32_32x32x16_bf16(b0, q, p0, 0, 0, 0);
    p1 = __builtin_amdgcn_mfma_f32_32x32x16_bf16(b1, q, p1, 0, 0, 0);
    if (DQK > 128 && (d0 & 3) == 3 && d0 + 1 < DQK / 16) SBAR(); }
}
__device__ __forceinline__ int v_st(int k, int c) { const int kk = (k & ~0xC) | ((k & 4) << 1) | ((k & 8) >> 1); return ((kk >> 3) * 4 + (c >> 5)) * 512 + ((kk & 7) * 32 + (c & 31)) * 2; }
__device__ __forceinline__ int v_rd_base(int lane) { return ((lane & 3) << 3) | (((lane >> 2) & 3) << 6) | (((lane >> 4) & 1) << 5) | (((lane >> 5) & 1) << 8); }
constexpr int v_rd_off(int d0, int ks, int half) { return d0 * 512 + ks * 4096 + half * 2048; }
template <int OFF> __device__ __forceinline__ s16x4 tr_read(int vb) {
  s16x4 r; asm volatile("ds_read_b64_tr_b16 %0, %1 offset:%2" : "=&v"(r) : "v"(vb), "i"(OFF) : "memory"); return r;
}
template <int D0> __device__ __forceinline__ void pv_one(f32x16& od, int vb, bf16x8 pa0, bf16x8 pa1, bf16x8 pa2, bf16x8 pa3) {
  const s16x4 l0 = tr_read<v_rd_off(D0, 0, 0)>(vb), h0 = tr_read<v_rd_off(D0, 0, 1)>(vb), l1 = tr_read<v_rd_off(D0, 1, 0)>(vb), h1 = tr_read<v_rd_off(D0, 1, 1)>(vb);
  const s16x4 l2 = tr_read<v_rd_off(D0, 2, 0)>(vb), h2 = tr_read<v_rd_off(D0, 2, 1)>(vb), l3 = tr_read<v_rd_off(D0, 3, 0)>(vb), h3 = tr_read<v_rd_off(D0, 3, 1)>(vb);
  asm volatile("s_waitcnt lgkmcnt(0)" ::: "memory"); SBAR();
#define PK(L, H) (bf16x8){L[0], L[1], L[2], L[3], H[0], H[1], H[2], H[3]}
  od = __builtin_amdgcn_mfma_f32_32x32x16_bf16(pa0, PK(l0, h0), od, 0, 0, 0);
  od = __builtin_amdgcn_mfma_f32_32x32x16_bf16(pa1, PK(l1, h1), od, 0, 0, 0);
  od = __builtin_amdgcn_mfma_f32_32x32x16_bf16(pa2, PK(l2, h2), od, 0, 0, 0);
  od = __builtin_amdgcn_mfma_f32_32x32x16_bf16(pa3, PK(l3, h3), od, 0, 0, 0);
#undef PK
}
__device__ __forceinline__ void pv_d0(f32x16* o, int vb, bf16x8 pa0, bf16x8 pa1, bf16x8 pa2, bf16x8 pa3) {
  pv_one<0>(o[0], vb, pa0, pa1, pa2, pa3); pv_one<1>(o[1], vb, pa0, pa1, pa2, pa3); pv_one<2>(o[2], vb, pa0, pa1, pa2, pa3); pv_one<3>(o[3], vb, pa0, pa1, pa2, pa3);
}

template <int DQK, int LDQ, int LDK, int LDKR, int LDV, int LDO, int SDEPTH, bool QNORM = false, bool NOMAX = false>
__device__ __forceinline__ void attn_dense_body(const bf16* __restrict__ Qb, const bf16* __restrict__ Kh, const bf16* __restrict__ KRh, const bf16* __restrict__ Vh,
                                                bf16* __restrict__ Ob, int seq, char* lds, const float* qgain = nullptr, const float* ropetab = nullptr, int tq0 = 0, float shiftC = 0.f) {
  constexpr int SHM_V = Cfg<DQK>::SHM_V, SHM_K = Cfg<DQK>::SHM_K; constexpr float SCALE = Cfg<DQK>::SCALE;
  constexpr bool ROPE = (DQK == 192);
  const int tid = threadIdx.x, wid = tid >> 6, lane = tid & 63, r32 = lane & 31, hi = lane >> 5;
  char* V_lds = lds; char* K_lds = lds + 2 * SHM_V;
  float* ws = (float*)(lds + 2 * SHM_V + 2 * SHM_K) + wid * 64; float* li_l = ws; float* al_l = ws + 32;
  constexpr int NQR = Cfg<DQK>::NQR;
  float m_reg = -1e30f, l_reg = 0; f32x16 o[4] = {}; bf16x8 qr[NQR];
  const bf16* Qw = Qb + (long)(wid * QBLK + r32) * LDQ + hi * 8;
  char* qx = lds + 2 * SHM_V + 2 * SHM_K + NW * 64 * 4 + wid * Cfg<DQK>::QX_WAVE + lane * 16;
  if constexpr (!QNORM) {
#pragma unroll
    for (int d0 = 0; d0 < NQR; ++d0) qr[d0] = *reinterpret_cast<const bf16x8*>(Qw + d0 * 16);
#pragma unroll
    for (int d0 = NQR; d0 < DQK / 16; ++d0) *reinterpret_cast<bf16x8*>(qx + (d0 - NQR) * 1024) = *reinterpret_cast<const bf16x8*>(Qw + d0 * 16);
  } else {
    float ss = 0.f;
#pragma unroll
    for (int d0 = 0; d0 < DQK / 16; ++d0) { const u32x4 rw = *reinterpret_cast<const u32x4*>(Qw + d0 * 16);
#pragma unroll
      for (int w = 0; w < 4; ++w) { const float a = __uint_as_float(rw[w] << 16), b = __uint_as_float(rw[w] & 0xffff0000u); ss += a * a + b * b; } }
    asm volatile("" ::: "memory");
    { auto rr = __builtin_amdgcn_permlane32_swap(__float_as_uint(ss), __float_as_uint(ss), false, false); ss = __uint_as_float(rr[0]) + __uint_as_float(rr[1]); }
    const float rsn = __builtin_amdgcn_rsqf(ss * (1.f / DQK) + 1e-6f) * Cfg<DQK>::C;
    const int tpos = tq0 + wid * QBLK + r32, eri = tpos >> 6, eci = 128 + (tpos & 63);
#pragma unroll
    for (int d0 = 0; d0 < DQK / 16; ++d0) {
      const f32x4 g0 = *reinterpret_cast<const f32x4*>(qgain + d0 * 16 + hi * 8), g1 = *reinterpret_cast<const f32x4*>(qgain + d0 * 16 + hi * 8 + 4);
      const u32x4 rw = *reinterpret_cast<const u32x4*>(Qw + d0 * 16);
      float x[8];
#pragma unroll
      for (int w = 0; w < 4; ++w) { x[2 * w] = __uint_as_float(rw[w] << 16) * rsn; x[2 * w + 1] = __uint_as_float(rw[w] & 0xffff0000u) * rsn; }
      x[0] *= g0[0]; x[1] *= g0[1]; x[2] *= g0[2]; x[3] *= g0[3]; x[4] *= g1[0]; x[5] *= g1[1]; x[6] *= g1[2]; x[7] *= g1[3];
      if (d0 >= 8) {
        const float* rp = ropetab + (size_t)((d0 < 10 ? eri : eci) * 16 + ((d0 - 8) & 1) * 8 + hi * 4) * 2;
        const f32x4 c0 = *reinterpret_cast<const f32x4*>(rp), c1 = *reinterpret_cast<const f32x4*>(rp + 4);
        const float a0 = x[0] * c0[0] - x[1] * c0[1], a1 = x[0] * c0[1] + x[1] * c0[0], a2 = x[2] * c0[2] - x[3] * c0[3], a3 = x[2] * c0[3] + x[3] * c0[2];
        const float a4 = x[4] * c1[0] - x[5] * c1[1], a5 = x[4] * c1[1] + x[5] * c1[0], a6 = x[6] * c1[2] - x[7] * c1[3], a7 = x[6] * c1[3] + x[7] * c1[2];
        x[0] = a0; x[1] = a1; x[2] = a2; x[3] = a3; x[4] = a4; x[5] = a5; x[6] = a6; x[7] = a7;
      }
      u32x4 w4 = {cvtpk(x[0], x[1]), cvtpk(x[2], x[3]), cvtpk(x[4], x[5]), cvtpk(x[6], x[7])};
      if (d0 < NQR) qr[d0 < NQR ? d0 : 0] = *reinterpret_cast<bf16x8*>(&w4); else *reinterpret_cast<bf16x8*>(qx + (d0 - NQR) * 1024) = *reinterpret_cast<bf16x8*>(&w4);
    }
  }
  const int sr = tid >> 4, sc = (tid & 15) * 8, vst0 = v_st(sr, sc), vst1 = v_st(32 + sr, sc);
  const int rr = tid >> 3, rc = (tid & 7) * 8;
  const int vb0 = (int)(uintptr_t)V_lds + v_rd_base(lane);
  struct { bf16x8 vs0, vs1, ks0, ks1, kr; } sr_[SDEPTH];
  const unsigned offV = (unsigned)(sr * LDV + sc) * 2u, offK = (unsigned)(sr * LDK + sc) * 2u, offR = (unsigned)(rr * LDKR + rc) * 2u;
#define SLOAD(i, k0) do { const char* vb_ = (const char*)Vh + (size_t)(k0) * (LDV * 2); const char* kb_ = (const char*)Kh + (size_t)(k0) * (LDK * 2); \
    sr_[i].vs0 = *reinterpret_cast<const bf16x8*>(vb_ + offV); sr_[i].vs1 = *reinterpret_cast<const bf16x8*>(vb_ + (size_t)32 * LDV * 2 + offV); \
    sr_[i].ks0 = *reinterpret_cast<const bf16x8*>(kb_ + offK); sr_[i].ks1 = *reinterpret_cast<const bf16x8*>(kb_ + (size_t)32 * LDK * 2 + offK); \
    if constexpr (ROPE) sr_[i].kr = *reinterpret_cast<const bf16x8*>((const char*)KRh + (size_t)(k0) * (LDKR * 2) + offR); } while (0)
#define SWRITE(b, i) do { *(bf16x8*)(V_lds + (b) * SHM_V + vst0) = sr_[i].vs0;          \
    *(bf16x8*)(V_lds + (b) * SHM_V + vst1) = sr_[i].vs1; const int kc = sc * 2;               \
    *(bf16x8*)(K_lds + (b) * SHM_K + kswz<DQK>(sr, kc)) = sr_[i].ks0;                       \
    *(bf16x8*)(K_lds + (b) * SHM_K + kswz<DQK>(32 + sr, kc)) = sr_[i].ks1;                   \
    if constexpr (ROPE) *(bf16x8*)(K_lds + (b) * SHM_K + kswz<DQK>(rr, 256 + rc * 2)) = sr_[i].kr; } while (0)
#define SWAIT() do { if constexpr (SDEPTH == 2) { if constexpr (ROPE) asm volatile("s_waitcnt vmcnt(5)" ::: "memory"); else asm volatile("s_waitcnt vmcnt(4)" ::: "memory"); } else asm volatile("s_waitcnt vmcnt(0)" ::: "memory"); } while (0)
#define RESC(a) do { if constexpr (!NOMAX) if (__any((a) < 1.f)) { if (hi == 0) al_l[r32] = (a); asm volatile("s_waitcnt lgkmcnt(0)" ::: "memory"); \
    _Pragma("unroll") for (int d = 0; d < 4; ++d) _Pragma("unroll") for (int r = 0; r < 16; ++r) o[d][r] *= al_l[crow(r, hi)]; } } while (0)
  f32x16 pA0, pA1, pB0, pB1; float mnA, mnB, alA, alB; bf16x8 pa0, pa1, pa2, pa3; const int NT = seq / KVBLK;
  constexpr int SE = 0, SO = SDEPTH - 1;
  SLOAD(SE, 0); asm volatile("s_waitcnt vmcnt(0)" ::: "memory"); SWRITE(0, SE); __syncthreads();
  qkt<DQK, NQR>(pA0, pA1, K_lds, qr, qx, r32, hi); partialSM<DQK, NOMAX>(pA0, pA1, m_reg, mnA, alA, shiftC);
  SLOAD(SO, KVBLK); if constexpr (SDEPTH == 2) { if (2 < NT) SLOAD(SE, 2 * KVBLK); }
  SWAIT(); SWRITE(1, SO); __syncthreads();
  for (int j = 1; j + 1 < NT; j += 2) {
    SBAR(); qkt<DQK, NQR>(pB0, pB1, K_lds + SHM_K, qr, qx, r32, hi);
    finishSM<true>(pA0, pA1, alA, l_reg, pa0, pa1, pa2, pa3); SBAR();
    SLOAD(SO, (j + SDEPTH) * KVBLK); SBAR();
    pv_d0(o, vb0, pa0, pa1, pa2, pa3); partialSM<DQK, NOMAX>(pB0, pB1, m_reg, mnB, alB, shiftC);
    __syncthreads(); SWAIT(); SWRITE(0, SE);
    RESC(alB); __syncthreads();
    SBAR(); qkt<DQK, NQR>(pA0, pA1, K_lds, qr, qx, r32, hi);
    finishSM<true>(pB0, pB1, alB, l_reg, pa0, pa1, pa2, pa3); SBAR();
    if (SDEPTH == 1 || j + 3 < NT) SLOAD(SE, (j + 1 + SDEPTH) * KVBLK); SBAR();
    pv_d0(o, vb0 + SHM_V, pa0, pa1, pa2, pa3); partialSM<DQK, NOMAX>(pA0, pA1, m_reg, mnA, alA, shiftC);
    __syncthreads(); SWAIT(); SWRITE(1, SO);
    RESC(alA); __syncthreads();
  }
  SBAR(); qkt<DQK, NQR>(pB0, pB1, K_lds + SHM_K, qr, qx, r32, hi);
  finishSM<true>(pA0, pA1, alA, l_reg, pa0, pa1, pa2, pa3); SBAR();
  pv_d0(o, vb0, pa0, pa1, pa2, pa3); partialSM<DQK, NOMAX>(pB0, pB1, m_reg, mnB, alB, shiftC);
  __syncthreads(); RESC(alB);
  finishSM<true>(pB0, pB1, alB, l_reg, pa0, pa1, pa2, pa3); SBAR();
  pv_d0(o, vb0 + SHM_V, pa0, pa1, pa2, pa3);
  { int w2 = tid; asm volatile("" : "+v"(w2)); li_l = (float*)(lds + 2 * SHM_V + 2 * SHM_K) + (w2 >> 6) * 64; }
  if (hi == 0) li_l[r32] = l_reg; asm volatile("s_waitcnt lgkmcnt(0)" ::: "memory");
  float rli[16];
#pragma unroll
  for (int r = 0; r < 16; ++r) rli[r] = __builtin_amdgcn_rcpf(li_l[crow(r, hi)]);
  bf16* Ow = Ob + (long)(wid * QBLK) * LDO;
#pragma unroll
  for (int r = 0; r < 16; ++r) { const int orow = crow(r, hi);
#pragma unroll
    for (int d0 = 0; d0 < 4; ++d0) Ow[(long)orow * LDO + d0 * 32 + r32] = (bf16)(cvtpk(o[d0][r] * rli[r], 0.f) & 0xffffu); }
  __syncthreads();
#undef SLOAD
#undef SWRITE
#undef SWAIT
#undef RESC
}
}
#define XB_TMO      128
#define XB_XCNT(j)  (256  + 64 * (j))
#define XB_XSUB(j)  (1280 + 64 * (j))
#define XB_XGEN(j)  (2304 + 64 * (j))
#define XB_TOP      3328
#define XB_TOPGEN   3392
#define XCD_BAR_WORDS 3456
#define XB_SPIN_CAP (1u << 18)

__device__ __forceinline__ unsigned xb_ld(unsigned* p)              { return __hip_atomic_load(p, __ATOMIC_RELAXED, __HIP_MEMORY_SCOPE_AGENT); }
__device__ __forceinline__ unsigned xb_add(unsigned* p, unsigned v) { return __hip_atomic_fetch_add(p, v, __ATOMIC_RELAXED, __HIP_MEMORY_SCOPE_AGENT); }
__device__ __forceinline__ unsigned xb_xcc_id() { return (unsigned)__builtin_amdgcn_s_getreg((3 << 11) | 20) & 0xFu; }
#define XB_SPIN(cond, bar) do { unsigned _sp = 0; while (cond) { __builtin_amdgcn_s_sleep(1); \
    if ((++_sp & 255u) == 0u) { if (xb_ld(&(bar)[XB_TMO])) break; if (_sp > XB_SPIN_CAP) { atomicAdd(&(bar)[XB_TMO], 1u); break; } } } } while (0)

struct XcdBarrier {
    unsigned* bar; unsigned x;
    volatile LAS unsigned* st;
};

__device__ __forceinline__ XcdBarrier xcd_barrier_post(unsigned* bar, volatile LAS unsigned* st) {
    XcdBarrier b; b.bar = bar; b.x = xb_xcc_id(); b.st = st;
    if (threadIdx.x == 0) (void)xb_add(&bar[XB_XCNT(b.x)], 1u);
    return b;
}
__device__ __forceinline__ void xcd_barrier_complete(unsigned* bar, unsigned x, unsigned& nloc, unsigned& nx) {
    const unsigned G = gridDim.x * gridDim.y * gridDim.z;
    unsigned sum, cnt, mine, sp = 0u;
    for (;;) {
        sum = 0u; cnt = 0u; mine = 0u;
#pragma unroll
        for (unsigned j = 0; j < 16; ++j) { const unsigned c = xb_ld(&bar[XB_XCNT(j)]); sum += c; cnt += (c > 0u) ? 1u : 0u; mine = (j == x) ? c : mine; }
        if (sum == G) break;
        __builtin_amdgcn_s_sleep(1);
        if ((++sp & 255u) == 0u) { if (xb_ld(&bar[XB_TMO])) break; if (sp > XB_SPIN_CAP) { atomicAdd(&bar[XB_TMO], 1u); break; } }
    }
    nloc = mine > 0u ? mine : 1u; nx = cnt > 0u ? cnt : 1u;
}

__device__ __forceinline__ void xcd_barrier(const XcdBarrier& b) {
    asm volatile("s_waitcnt vmcnt(0)" ::: "memory");
    __syncthreads();
    if (threadIdx.x == 0) {
        unsigned* bar = b.bar; asm volatile("" : "+s"(bar));
        __builtin_amdgcn_s_waitcnt(0);
        unsigned nloc = b.st[0], nx = b.st[1];
        if (nloc == 0u) { xcd_barrier_complete(bar, b.x, nloc, nx); b.st[0] = nloc; b.st[1] = nx; }
        const unsigned old = xb_add(&bar[XB_XSUB(b.x)], 1u);
        const unsigned gen = old / nloc;
        if (old + 1u == (gen + 1u) * nloc) {
            __builtin_amdgcn_fence(__ATOMIC_RELEASE, "agent");
            asm volatile("s_waitcnt vmcnt(0)" ::: "memory");
            const unsigned og = xb_add(&bar[XB_TOP], 1u);
            const unsigned tg = og / nx;
            if (og + 1u == (tg + 1u) * nx) xb_add(&bar[XB_TOPGEN], 1u);
            else XB_SPIN(xb_ld(&bar[XB_TOPGEN]) == tg, bar);
            __builtin_amdgcn_fence(__ATOMIC_ACQUIRE, "agent");
            xb_add(&bar[XB_XGEN(b.x)], 1u);
            asm volatile("s_waitcnt vmcnt(0)" ::: "memory");
        } else {
            XB_SPIN(xb_ld(&bar[XB_XGEN(b.x)]) == gen, bar);
            __builtin_amdgcn_fence(__ATOMIC_ACQUIRE, "agent");
            asm volatile("s_waitcnt vmcnt(0)" ::: "memory");
        }
    }
    __syncthreads();
}

struct Args { const float* in[N_IN]; float* out; unsigned char* ws; int ph_lo, ph_hi, one_launch, pad; };
struct Frame {
    LAS unsigned char* lds;
    int tid, lane, wave, vcu, G;
    const float* const* in;
    float* out; unsigned char* ws;
    float* mod; const f32x2* ropeA; const f32x2* ropeC;
    bf16* H;
};
constexpr int NWAVES = 8;
__device__ __forceinline__ int fresh_lane() { int l; asm volatile("v_mbcnt_lo_u32_b32 %0, -1, 0\n\tv_mbcnt_hi_u32_b32 %0, -1, %0" : "=v"(l)); return l; }

__device__ __forceinline__ void transpose_item(const float* W, int ldw, int K, int N, bf16* WT, int row_off, float scale, LAS float* scr, int item, int lane) {
    const int nblk = N / 32, kb = item / nblk, nb = item % nblk, k0 = 64 * kb, n0 = 32 * nb;
#pragma unroll 8
    for (int i = 0; i < 32; ++i) { const int kk = 2 * i + (lane >> 5); scr[kk * 33 + (lane & 31)] = W[(size_t)(k0 + kk) * ldw + n0 + (lane & 31)] * scale; }
    LDS_WAIT(); asm volatile("" ::: "memory");
    const int c = lane & 7;
#pragma unroll
    for (int j = 0; j < 4; ++j) { const int n = (lane >> 3) + 8 * j; const LAS float* s = scr + (8 * c) * 33 + n;
        v4u o; o.x = pk2(s[0 * 33], s[1 * 33]); o.y = pk2(s[2 * 33], s[3 * 33]); o.z = pk2(s[4 * 33], s[5 * 33]); o.w = pk2(s[6 * 33], s[7 * 33]);
        *(GAS v4u*)(WT + (size_t)(row_off + n0 + n) * K + k0 + 8 * c) = o; }
    LDS_WAIT(); asm volatile("" ::: "memory");
}
struct ItemSrc { unsigned* head; int cur, step; };
__device__ __forceinline__ void item_next(ItemSrc& S) {
    if (S.head) { unsigned v = 0; if ((threadIdx.x & 63) == 0) v = __hip_atomic_fetch_add(S.head, 1u, __ATOMIC_RELAXED, __HIP_MEMORY_SCOPE_AGENT); S.cur = (int)__builtin_amdgcn_readfirstlane(v); }
    else S.cur += S.step;
}
__device__ __forceinline__ int transpose_matrix(Frame& F, ItemSrc& S, int base, const float* W, int ldw, int K, int N, bf16* WT, int row_off, float scale) {
    LAS float* scr = (LAS float*)(F.lds + F.wave * 16384);
    const int nit = (K / 64) * (N / 32), nb = (nit + 7) / 8;
    while (S.cur < base + nb) { const int i0 = (S.cur - base) * 8, i1 = i0 + 8 < nit ? i0 + 8 : nit;
        for (int it = i0; it < i1; ++it) transpose_item(W, ldw, K, N, WT, row_off, scale, scr, it, F.lane);
        item_next(S); }
    return base + nb;
}
__device__ __forceinline__ void zero_rows(Frame& F, bf16* WT, int row0, int nrows, int K) {
    const size_t n16 = (size_t)nrows * K / 8; GAS v4u* p = (GAS v4u*)(WT + (size_t)row0 * K);
    for (size_t i = (size_t)(F.vcu * NWAVES + F.wave) * 64 + F.lane; i < n16; i += (size_t)F.G * NWAVES * 64) p[i] = (v4u){0u, 0u, 0u, 0u};
}
__device__ __forceinline__ void prep_weights(Frame& F, int layer, unsigned* head) {
    F.lane = fresh_lane();
    const int kind = layer % 3, j = layer / 3;
    unsigned char* wr = F.ws + ((layer & 1) ? WS_WB : WS_W);
    bf16* w1t = (bf16*)wr; bf16* w2t = (bf16*)(wr + 32 * MiB); bf16* wmix = (bf16*)(wr + 64 * MiB); bf16* wot = (bf16*)(wr + 90 * MiB);
    if (kind == 1) {
        const float* g1 = F.in[I_GLA_WG1];
        for (int i = (F.vcu * NWAVES + F.wave) * 64 + F.lane; i < 2 * 16 * D; i += F.G * NWAVES * 64) { const int k = i % D, nr = i / D, n = nr >> 4, r = nr & 15;
            wmix[(size_t)(6144 + nr) * D + k] = (bf16)f2bf(g1[((size_t)n * D + k) * 16 + r]); }
        zero_rows(F, wmix, 6176, 224, D);
    } else if (kind == 2) zero_rows(F, wmix, 832, 192, D);
    ItemSrc S; S.head = head; S.step = F.G * NWAVES; S.cur = F.vcu * NWAVES + F.wave;
    if (head) item_next(S);
    int b = 0;
    b = transpose_matrix(F, S, b, F.in[I_W1] + (size_t)layer * D * FF, FF, D, FF, w1t, 0, 1.f);
    b = transpose_matrix(F, S, b, F.in[I_W2] + (size_t)layer * FF * D, D, FF, D, w2t, 0, 1.f);
    if (kind == 0) {
        b = transpose_matrix(F, S, b, F.in[I_GQA_WQKV] + (size_t)j * D * 3072, 3072, D, 3072, wmix, 0, 1.f);
        b = transpose_matrix(F, S, b, F.in[I_GQA_WO] + (size_t)j * D * D, D, D, D, wot, 0, 1.f);
    } else if (kind == 1) {
        const float* win = F.in[I_GLA_WIN];
        b = transpose_matrix(F, S, b, win, 6144, D, 1024, wmix, 0, 0.0625f);
        b = transpose_matrix(F, S, b, win + 1024, 6144, D, 5120, wmix, 1024, 1.f);
        b = transpose_matrix(F, S, b, F.in[I_GLA_WO], D, D, D, wot, 0, 1.f);
    } else {
        b = transpose_matrix(F, S, b, F.in[I_MLA_WDOWN], 832, D, 832, wmix, 0, 1.f);
        b = transpose_matrix(F, S, b, F.in[I_MLA_WUQ], 3072, 512, 3072, wmix + (size_t)4 * MiB / 2, 0, 1.f);
        b = transpose_matrix(F, S, b, F.in[I_MLA_WUKV], 4096, 256, 4096, wmix + (size_t)8 * MiB / 2, 0, 1.f);
        b = transpose_matrix(F, S, b, F.in[I_MLA_WO], D, D, D, wot, 0, 1.f);
    }
    (void)b;
}
__device__ __forceinline__ void ada_phase(Frame& F) {
    F.lane = fresh_lane();
    LAS float* cond = (LAS float*)(F.lds);
    float* modp = (float*)(F.ws + WS_MODP);
    const float* cp = F.in[I_CP]; const float* cs = F.in[I_CS]; const float* aw = F.in[I_ADAW];
    for (int item = F.vcu; item < 4 * 24 * 4; item += F.G) {
        const int kq = item & 3, cg = (item >> 2) % 24, l = item / 96;
        __syncthreads();
        for (int i = F.tid; i < 512 * NSEQ; i += 512) { const int k = i / NSEQ, s = i % NSEQ; const float c = s < 16 ? cp[s * D + kq * 512 + k] : cs[(s - 16) * D + kq * 512 + k];
            cond[i] = c / (1.f + __expf(-c)); }
        __syncthreads();
        const int col = cg * 512 + F.wave * 64 + F.lane;
        const float* wp = aw + ((size_t)l * D + kq * 512) * 12288 + col;
        float acc[NSEQ];
#pragma unroll
        for (int s = 0; s < NSEQ; ++s) acc[s] = 0.f;
        for (int k0 = 0; k0 < 512; k0 += 8) {
            float wv[8];
#pragma unroll
            for (int u = 0; u < 8; ++u) wv[u] = wp[(size_t)(k0 + u) * 12288];
#pragma unroll
            for (int u = 0; u < 8; ++u) { const LAS f32x4* cr = (const LAS f32x4*)(cond + (k0 + u) * NSEQ);
#pragma unroll
                for (int q = 0; q < 5; ++q) { const f32x4 cv = cr[q]; acc[4 * q] += cv.x * wv[u]; acc[4 * q + 1] += cv.y * wv[u]; acc[4 * q + 2] += cv.z * wv[u]; acc[4 * q + 3] += cv.w * wv[u]; } }
        }
#pragma unroll
        for (int s = 0; s < NSEQ; ++s) modp[(((size_t)kq * DEPTH + l) * NSEQ + s) * 12288 + col] = acc[s];
    }
    __syncthreads();
}
__device__ __forceinline__ void rope_tables(Frame& F) {
    F.lane = fresh_lane();
    f32x2* ra = (f32x2*)(F.ws + WS_ROPE); f32x2* rc = ra + 192 * 32;
    for (int i = (F.vcu * NWAVES + F.wave) * 64 + F.lane; i < 192 * 48; i += F.G * NWAVES * 64) {
        const int e = i / 48, f = i % 48; const double idx = (double)(e < 128 ? e : e - 128);
        const double inv = f < 32 ? pow(10000.0, -(double)f / 32.0) : pow(10000.0, -(double)(f - 32) / 16.0);
        const double a = idx * inv; const f32x2 v = {(float)cos(a), (float)sin(a)};
        if (f < 32) ra[e * 32 + f] = v; else rc[e * 16 + (f - 32)] = v;
    }
}
__device__ __forceinline__ void score_bounds(Frame& F) {
    if (F.vcu != 0 || F.wave != 0) return;
    const int l = F.tid & 63; float* bnd = (float*)(F.ws + WS_BND);
    auto wmax = [](float v) { for (int o = 1; o < 64; o <<= 1) v = fmaxf(v, __shfl_xor(v, o)); return v; };
    for (int j = 0; j < 2; ++j) {
        const float gq = wmax(fmaxf(fabsf(F.in[I_GQA_QN][j * 128 + l]), fabsf(F.in[I_GQA_QN][j * 128 + 64 + l]))), gk = wmax(fmaxf(fabsf(F.in[I_GQA_KN][j * 128 + l]), fabsf(F.in[I_GQA_KN][j * 128 + 64 + l])));
        if (l == 0) bnd[j] = 11.313708499f * gq * gk * (1.02f * 1.4426950408889634f); }
    const float gq = wmax(fmaxf(fmaxf(fabsf(F.in[I_MLA_QN][l]), fabsf(F.in[I_MLA_QN][64 + l])), fabsf(F.in[I_MLA_QN][128 + l])));
    const float gkn = wmax(fmaxf(fabsf(F.in[I_MLA_KNN][l]), fabsf(F.in[I_MLA_KNN][64 + l]))), gkr = wmax(fabsf(F.in[I_MLA_KRN][l]));
    if (l == 0) bnd[2] = gq * sqrtf(128.f * gkn * gkn + 64.f * gkr * gkr) * (1.02f * 1.4426950408889634f);
}
__device__ __forceinline__ void mod_finalize(Frame& F) {
    F.lane = fresh_lane();
    const float* modp = (const float*)(F.ws + WS_MODP); const float* ab = F.in[I_ADAB];
    constexpr int NTOT = DEPTH * NSEQ * 12288, Q = NTOT;
    for (int i = (F.vcu * NWAVES + F.wave) * 64 + F.lane; i < NTOT; i += F.G * NWAVES * 64) { const int l = i / (NSEQ * 12288), n = i % 12288;
        float v = ab[l * 12288 + n] + ((modp[i] + modp[i + Q]) + (modp[i + 2 * Q] + modp[i + 3 * Q]));
        const int slot = n >> 11; if (slot == 1) v = F.in[I_N1G][l * D + (n & 2047)] * (1.0f + v); else if (slot == 4) v = F.in[I_N2G][l * D + (n & 2047)] * (1.0f + v);
        F.mod[i] = v; }
}
__device__ __forceinline__ void norm0_phase(Frame& F) {
    F.lane = fresh_lane();
    const int gw = F.vcu * NWAVES + F.wave, NGW = F.G * NWAVES;
    float* ssq = (float*)(F.ws + WS_SSQB);
    for (int item = gw; item < M / 32; item += NGW) {
        const int row0 = item * 32, seq = seq_of_row(row0);
        const float* mp = F.mod + (size_t)seq * 12288;
        f32x4 A[8];
#pragma unroll
        for (int j = 0; j < 8; ++j) { const int c = j * 256 + F.lane * 4; A[j] = *(const f32x4*)(mp + D + c); }
        const float* xb = row0 < MP ? F.in[I_XP] + (size_t)row0 * D : F.in[I_XS] + (size_t)(row0 - MP) * D;
        bf16* hb = F.H + (size_t)row0 * D;
        for (int r = 0; r < 32; r += 2) {
            f32x4 v0[8], v1[8]; float s0 = 0.f, s1 = 0.f;
#pragma unroll
            for (int j = 0; j < 8; ++j) { v0[j] = *(const GAS f32x4*)(xb + (size_t)r * D + j * 256 + F.lane * 4); v1[j] = *(const GAS f32x4*)(xb + (size_t)(r + 1) * D + j * 256 + F.lane * 4); }
#pragma unroll
            for (int j = 0; j < 8; ++j) { s0 += (v0[j].x * v0[j].x + v0[j].y * v0[j].y) + (v0[j].z * v0[j].z + v0[j].w * v0[j].w); s1 += (v1[j].x * v1[j].x + v1[j].y * v1[j].y) + (v1[j].z * v1[j].z + v1[j].w * v1[j].w); }
            s0 = wave_sum(s0); s1 = wave_sum(s1);
            if (F.lane < 16) { const int rr = row0 + r + (F.lane >> 3), sl = F.lane & 7; ssq[(size_t)rr * 8 + sl] = sl == 0 ? ((F.lane >> 3) ? s1 : s0) : 0.f; }
#pragma unroll
            for (int j = 0; j < 8; ++j) { const f32x4 a = v0[j] * A[j], b = v1[j] * A[j];
                *(GAS v2u*)(hb + (size_t)r * D + j * 256 + F.lane * 4) = (v2u){pk2(a.x, a.y), pk2(a.z, a.w)};
                *(GAS v2u*)(hb + (size_t)(r + 1) * D + j * 256 + F.lane * 4) = (v2u){pk2(b.x, b.y), pk2(b.z, b.w)}; }
        }
    }
}
__device__ __forceinline__ void gemv20_item(Frame& F, const float* shift  , const float* W, int ldw, int ncols, float scale, float* out, int ldo, int c0) {
    LAS float* cond = (LAS float*)(F.lds);
    LAS float* red = (LAS float*)(F.lds + 98304);
    const int c = c0 + F.lane; const bool ok = c < ncols;
    for (int pass = 0; pass < 2; ++pass) {
        __syncthreads();
        for (int i = F.tid; i < 2048 * 10; i += 512) { const int k = i / 10, s = i % 10; cond[k * 12 + s] = shift[(size_t)(pass * 10 + s) * 12288 + k]; }
        __syncthreads();
        float acc[10];
#pragma unroll
        for (int s = 0; s < 10; ++s) acc[s] = 0.f;
        const float* wp = W + (size_t)(F.wave * 256) * ldw + (ok ? c : 0);
        const LAS float* cb = cond + F.wave * 256 * 12;
        for (int k0 = 0; k0 < 256; k0 += 16) {
            float wv[16];
#pragma unroll
            for (int u = 0; u < 16; ++u) { wv[u] = *wp; wp += ldw; }
#pragma unroll
            for (int u = 0; u < 16; ++u) { const LAS f32x4* cr = (const LAS f32x4*)(cb + (k0 + u) * 12); const f32x4 c0v = cr[0], c1v = cr[1], c2v = cr[2];
                acc[0] += c0v.x * wv[u]; acc[1] += c0v.y * wv[u]; acc[2] += c0v.z * wv[u]; acc[3] += c0v.w * wv[u]; acc[4] += c1v.x * wv[u]; acc[5] += c1v.y * wv[u];
                acc[6] += c1v.z * wv[u]; acc[7] += c1v.w * wv[u]; acc[8] += c2v.x * wv[u]; acc[9] += c2v.y * wv[u]; }
        }
#pragma unroll
        for (int s = 0; s < 10; ++s) red[(F.wave * 10 + s) * 64 + F.lane] = acc[s];
        __syncthreads();
        for (int i = F.tid; i < 640; i += 512) { const int s = i >> 6, l = i & 63; float t = 0.f;
#pragma unroll
            for (int w = 0; w < 8; ++w) t += red[(w * 10 + s) * 64 + l];
            if (c0 + l < ncols) out[(size_t)(pass * 10 + s) * ldo + c0 + l] = t * scale; }
    }
    __syncthreads();
}
__device__ __forceinline__ void bw_phase(Frame& F, int layer) {
    F.lane = fresh_lane();
    const int kind = layer % 3, j = layer / 3;
    const float* sh1 = F.mod + (size_t)layer * NSEQ * 12288; const float* sh2 = sh1 + 3 * D;
    float* bw1 = (float*)(F.ws + ((layer & 1) ? WS_BW1B : WS_BW1)); float* bw2 = (float*)(F.ws + ((layer & 1) ? WS_BW2B : WS_BW2));
    const int n1 = kind == 0 ? 48 : (kind == 1 ? 98 : 13);
    for (int it = F.G - 1 - F.vcu; it < n1 + 128; it += F.G) {
        if (it >= n1) { gemv20_item(F, sh2, F.in[I_W1] + (size_t)layer * D * FF, FF, FF, 1.f, bw2, FF, (it - n1) * 64); continue; }
        if (kind == 0) gemv20_item(F, sh1, F.in[I_GQA_WQKV] + (size_t)j * D * 3072, 3072, 3072, 1.f, bw1, 6400, it * 64);
        else if (kind == 1) {
            if (it < 16) gemv20_item(F, sh1, F.in[I_GLA_WIN], 6144, 1024, 0.0625f, bw1, 6400, it * 64);
            else if (it < 96) gemv20_item(F, sh1, F.in[I_GLA_WIN], 6144, 6144, 1.f, bw1, 6400, it * 64);
            else gemv20_item(F, sh1, F.in[I_GLA_WG1] + (size_t)(it - 96) * D * 16, 16, 16, 1.f, bw1 + 6144 + (it - 96) * 16, 6400, 0);
        } else gemv20_item(F, sh1, F.in[I_MLA_WDOWN], 832, 832, 1.f, bw1, 6400, it * 64);
    }
}
__device__ __forceinline__ void rot(float& y0, float& y1, f32x2 cs) { const float a = y0 * cs.x - y1 * cs.y, b = y0 * cs.y + y1 * cs.x; y0 = a; y1 = b; }
__device__ __forceinline__ void unpack8(v4u w, float* x) { x[0] = bflo(w.x); x[1] = bfhi(w.x); x[2] = bflo(w.y); x[3] = bfhi(w.y); x[4] = bflo(w.z); x[5] = bfhi(w.z); x[6] = bflo(w.w); x[7] = bfhi(w.w); }
__device__ __forceinline__ void mla_down_norm_phase(Frame& F) {
    F.lane = fresh_lane();
    bf16* DN = (bf16*)(F.ws + WS_DOWN); const float* qa = F.in[I_MLA_QAN]; const float* kva = F.in[I_MLA_KVAN]; const float* krn = F.in[I_MLA_KRN];
    const int gw = F.vcu * NWAVES + F.wave, NGW = F.G * NWAVES, lane = F.lane;
    float g0[8], g1[8], g2[8];
#pragma unroll
    for (int e = 0; e < 8; ++e) { g0[e] = qa[lane * 8 + e]; g1[e] = kva[(lane & 31) * 8 + e]; g2[e] = krn[(lane & 7) * 8 + e]; }
    for (int row = gw; row < M; row += NGW) {
        const int t = pos_of_row(row), ri = t >> 6, ci = 128 + (t & 63);
        bf16* rp = DN + (size_t)row * 1024;
        const v4u w0 = *(const GAS v4u*)(rp + lane * 8), w1 = *(const GAS v4u*)(rp + 512 + (lane & 31) * 8), w2 = *(const GAS v4u*)(rp + 768 + (lane & 7) * 8);
        float x[8], ss;
        unpack8(w0, x); ss = 0.f;
#pragma unroll
        for (int e = 0; e < 8; ++e) ss += x[e] * x[e];
        ss = wave_sum(ss); { const float rs = 1.0f / sqrtf(ss * (1.f / 512.f) + NORM_EPS);
#pragma unroll
            for (int e = 0; e < 8; ++e) x[e] = x[e] * rs * g0[e]; }
        *(GAS v4u*)(rp + lane * 8) = (v4u){pk2(x[0], x[1]), pk2(x[2], x[3]), pk2(x[4], x[5]), pk2(x[6], x[7])};
        unpack8(w1, x); ss = 0.f;
#pragma unroll
        for (int e = 0; e < 8; ++e) ss += x[e] * x[e];
        ss += __shfl_xor(ss, 1); ss += __shfl_xor(ss, 2); ss += __shfl_xor(ss, 4); ss += __shfl_xor(ss, 8); ss += __shfl_xor(ss, 16);
        { const float rs = 1.0f / sqrtf(ss * (1.f / 256.f) + NORM_EPS);
#pragma unroll
            for (int e = 0; e < 8; ++e) x[e] = x[e] * rs * g1[e]; }
        if (lane < 32) *(GAS v4u*)(rp + 512 + lane * 8) = (v4u){pk2(x[0], x[1]), pk2(x[2], x[3]), pk2(x[4], x[5]), pk2(x[6], x[7])};
        unpack8(w2, x); ss = 0.f;
#pragma unroll
        for (int e = 0; e < 8; ++e) ss += x[e] * x[e];
        ss += __shfl_xor(ss, 1); ss += __shfl_xor(ss, 2); ss += __shfl_xor(ss, 4);
        { const float rs = 1.0f / sqrtf(ss * (1.f / 64.f) + NORM_EPS);
#pragma unroll
            for (int e = 0; e < 8; ++e) x[e] = x[e] * rs * g2[e]; }
#pragma unroll
        for (int p = 0; p < 4; ++p) { const int i = (lane & 7) * 4 + p; rot(x[2 * p], x[2 * p + 1], F.ropeC[(i < 16 ? ri : ci) * 16 + (i & 15)]); }
        if (lane < 8) *(GAS v4u*)(rp + 768 + lane * 8) = (v4u){pk2(x[0], x[1]), pk2(x[2], x[3]), pk2(x[4], x[5]), pk2(x[6], x[7])};
    }
}
__device__ __forceinline__ void mla_knope_norm_phase(Frame& F) {
    F.lane = fresh_lane();
    bf16* KV = (bf16*)(F.ws + WS_KV); const float* knn = F.in[I_MLA_KNN];
    const int gw = F.vcu * NWAVES + F.wave, NGW = F.G * NWAVES, lane = F.lane, sub = lane & 15, hh = lane >> 4;
    float gk[8];
#pragma unroll
    for (int e = 0; e < 8; ++e) gk[e] = knn[sub * 8 + e];
    for (int row = gw; row < M; row += NGW) {
        v4u w[4];
#pragma unroll
        for (int ps = 0; ps < 4; ++ps) w[ps] = *(const GAS v4u*)(KV + (size_t)row * 4096 + (ps * 4 + hh) * 256 + sub * 8);
#pragma unroll
        for (int ps = 0; ps < 4; ++ps) {
            float x[8]; unpack8(w[ps], x); float ss = 0.f;
#pragma unroll
            for (int e = 0; e < 8; ++e) ss += x[e] * x[e];
            ss += __shfl_xor(ss, 1); ss += __shfl_xor(ss, 2); ss += __shfl_xor(ss, 4); ss += __shfl_xor(ss, 8);
            const float rs = 1.0f / sqrtf(ss * (1.f / 128.f) + NORM_EPS);
#pragma unroll
            for (int e = 0; e < 8; ++e) x[e] = x[e] * rs * gk[e];
            *(GAS v4u*)(KV + (size_t)row * 4096 + (ps * 4 + hh) * 256 + sub * 8) = (v4u){pk2(x[0], x[1]), pk2(x[2], x[3]), pk2(x[4], x[5]), pk2(x[6], x[7])};
        }
    }
}
__device__ __forceinline__ void gla_post_phase(Frame& F) {
    F.lane = fresh_lane();
    bf16* OB = (bf16*)(F.ws + WS_OB); const bf16* PROJ = (const bf16*)(F.ws + WS_PROJ); const float* on = F.in[I_GLA_ON];
    const int gw = F.vcu * NWAVES + F.wave, NGW = F.G * NWAVES, lane = F.lane;
    float g[8];
#pragma unroll
    for (int e = 0; e < 8; ++e) g[e] = on[lane * 8 + e];
    for (int row = gw; row < M; row += NGW) {
        v4u wf[4], wb[4], wr[4];
#pragma unroll
        for (int h = 0; h < 4; ++h) { wf[h] = *(const GAS v4u*)(F.H + (size_t)row * D + h * 512 + lane * 8); wb[h] = *(const GAS v4u*)(OB + (size_t)row * D + h * 512 + lane * 8);
            wr[h] = *(const GAS v4u*)(PROJ + (size_t)row * 6400 + 4096 + h * 512 + lane * 8); }
#pragma unroll
        for (int h = 0; h < 4; ++h) {
            float a[8], b[8], r[8]; unpack8(wf[h], a); unpack8(wb[h], b); unpack8(wr[h], r); float ss = 0.f;
#pragma unroll
            for (int e = 0; e < 8; ++e) { a[e] += b[e]; ss += a[e] * a[e]; }
            ss = wave_sum(ss); const float rs = 1.0f / sqrtf(ss * (1.f / 512.f) + NORM_EPS);
#pragma unroll
            for (int e = 0; e < 8; ++e) a[e] = a[e] * rs * g[e] * (r[e] / (1.f + __expf(-r[e])));
            *(GAS v4u*)(OB + (size_t)row * D + h * 512 + lane * 8) = (v4u){pk2(a[0], a[1]), pk2(a[2], a[3]), pk2(a[4], a[5]), pk2(a[6], a[7])};
        }
    }
}

namespace gla {
typedef float f32x4 __attribute__((ext_vector_type(4)));
typedef short bf16x8 __attribute__((ext_vector_type(8)));
constexpr int CL = 32;
constexpr int QD_ROW = 528, KET_ROW = 80, V_ROW = 272, P_ROW = 80;
constexpr int OFF_QD = 0, OFF_KD = OFF_QD + CL * QD_ROW, OFF_KET = OFF_KD + CL * QD_ROW, OFF_V = OFF_KET + 256 * KET_ROW, OFF_DE = OFF_V + CL * V_ROW, BUF_BYTES = OFF_DE + 1024;
constexpr int OFF_LOW = 2 * BUF_BYTES, OFF_PW = OFF_LOW + 2 * CL * 64, OFF_END = OFF_PW + 4 * CL * P_ROW;
static_assert(OFF_END <= LDSCTL_OFF, "gla LDS map");
__device__ __forceinline__ float log_sigmoid(float z) { return fminf(z, 0.f) - __logf(1.f + __expf(-fabsf(z))); }
__device__ __forceinline__ void rd_p(bf16x8 (&fa)[2][2], bf16x8 (&fb)[2][2], int aq, int ak) {
#pragma unroll
    for (int mi = 0; mi < 2; ++mi)
#pragma unroll
        for (int kk = 0; kk < 2; ++kk) { fa[mi][kk] = *(const LAS bf16x8*)(uintptr_t)(unsigned)(aq + mi * 8448 + kk * 64); fb[mi][kk] = *(const LAS bf16x8*)(uintptr_t)(unsigned)(ak + mi * 8448 + kk * 64); }
}
__device__ __forceinline__ void rd_v(unsigned (&vu)[8], int av) {
#pragma unroll
    for (int q = 0; q < 8; ++q) vu[q] = *(const LAS unsigned short*)(uintptr_t)(unsigned)(av + q * 272);
}
__device__ __forceinline__ void rd_pw(bf16x8 (&fp)[2], int ap) { fp[0] = *(const LAS bf16x8*)(uintptr_t)(unsigned)ap; fp[1] = *(const LAS bf16x8*)(uintptr_t)(unsigned)(ap + 1280); }
__device__ __forceinline__ void rd_q(v2u (&q0)[2][2], v2u (&q1)[2][2], int aq) {
#pragma unroll
    for (int mi = 0; mi < 2; ++mi)
#pragma unroll
        for (int kk = 0; kk < 2; ++kk) { q0[mi][kk] = *(const LAS v2u*)(uintptr_t)(unsigned)(aq + mi * 8448 + kk * 64); q1[mi][kk] = *(const LAS v2u*)(uintptr_t)(unsigned)(aq + mi * 8448 + kk * 64 + 32); }
}
__device__ __forceinline__ void rd_s(bf16x8 (&fk)[4], f32x4 (&fd)[4], int ak, int ad) {
#pragma unroll
    for (int t = 0; t < 4; ++t) { fk[t] = *(const LAS bf16x8*)(uintptr_t)(unsigned)(ak + t * 1280); fd[t] = *(const LAS f32x4*)(uintptr_t)(unsigned)(ad + t * 64); }
}
static_assert(16 * QD_ROW == 8448 && V_ROW == 272 && 16 * P_ROW == 1280 && 16 * KET_ROW == 1280, "asm offsets");
#define GLA_BAR() do { asm volatile("s_waitcnt lgkmcnt(0)" ::: "memory"); __builtin_amdgcn_s_barrier(); asm volatile("" ::: "memory"); } while (0)

__device__ __forceinline__ void chain(LAS unsigned char* lds, const bf16* PROJ, bf16* OF, bf16* OB, const float* wg2, const float* bgv, int c) {
    const int tid = threadIdx.x, wave = __builtin_amdgcn_readfirstlane(tid >> 6), lane = tid & 63;
    const int sl = c & 3, dir = (c >> 2) & 1, h = (c >> 3) & 3, s = c >> 5;
    int T, rowbase;
    if (c < 128) { T = 8192; rowbase = MP + s * 8192; } else { T = 2048; rowbase = (s - 4) * 2048; }
    const int nch = T / CL;
    GLA_BAR();
    if (wave < 4) {
        const int ptid = tid, l16 = lane & 15, g = lane >> 4, dbase = 64 * wave + 2 * l16;
        bf16x8 wB[4]; float bias[4];
#pragma unroll
        for (int nj = 0; nj < 4; ++nj) { const int d = dbase + 32 * (nj >> 1) + (nj & 1); float w[8];
#pragma unroll
            for (int jx = 0; jx < 8; ++jx) w[jx] = g < 2 ? wg2[((size_t)dir * 16 + 8 * g + jx) * 1024 + h * 256 + d] : 0.f;
            wB[nj] = __builtin_bit_cast(bf16x8, (v4u){pk2c(w[0], w[1]), pk2c(w[2], w[3]), pk2c(w[4], w[5]), pk2c(w[6], w[7])});
            bias[nj] = bgv[dir * 1024 + h * 256 + d]; }
        unsigned qv[2][2][4], kv[2][2][4]; v4u vv[2]; unsigned lw;
#define GLA_ROW0(J) ((size_t)rowbase + (size_t)(dir ? nch - 1 - (J) : (J)) * CL)
#define GLA_LOAD_QKV(J) do { const size_t r0_ = GLA_ROW0(J); const char* qp_ = (const char*)PROJ + (r0_ * 6400 + h * 256 + 64 * wave) * 2; const unsigned voff_ = (unsigned)(4 * g * 6400 + 2 * l16) * 2u;     \
        _Pragma("unroll") for (int pp = 0; pp < 2; ++pp) _Pragma("unroll") for (int mi = 0; mi < 2; ++mi) _Pragma("unroll") for (int r = 0; r < 4; ++r) { \
            qv[pp][mi][r] = *(const GAS unsigned*)(qp_ + (size_t)(16 * mi + r) * 12800 + pp * 64 + voff_); kv[pp][mi][r] = *(const GAS unsigned*)(qp_ + (size_t)(16 * mi + r) * 12800 + pp * 64 + 2048 + voff_); } \
        _Pragma("unroll") for (int jj = 0; jj < 2; ++jj) { const int idx = ptid + 256 * jj, pos = idx >> 4, e8 = (idx & 15) * 8; vv[jj] = *(const GAS v4u*)(PROJ + (r0_ + pos) * 6400 + 2048 + h * 512 + sl * 128 + e8); } } while (0)
#define GLA_LOAD_LOW(J) do { lw = *(const GAS unsigned*)(PROJ + (GLA_ROW0(J) + (ptid >> 3)) * 6400 + 6144 + dir * 16 + (ptid & 7) * 2); } while (0)
#define GLA_PUT_LOW(J) do { *(LAS unsigned*)(lds + OFF_LOW + ((J) & 1) * (CL * 64) + (ptid >> 3) * 64 + (ptid & 7) * 4) = lw; } while (0)
        { const int b_ = ptid >> 7, pos_ = (ptid >> 2) & 31, part_ = ptid & 3; *(LAS v2u*)(lds + OFF_LOW + b_ * (CL * 64) + pos_ * 64 + 32 + part_ * 8) = (v2u){0u, 0u}; }
        GLA_LOAD_LOW(0); GLA_PUT_LOW(0);
        if (nch > 1) GLA_LOAD_LOW(1);
        GLA_LOAD_QKV(0);
        GLA_BAR();
        for (int j = 0; j < nch; ++j) {
            LAS unsigned char* B = lds + (j & 1) * BUF_BYTES;
            if (j + 1 < nch) GLA_PUT_LOW(j + 1);
            f32x4 z[2][4];
            { bf16x8 fA[2];
#pragma unroll
              for (int mi = 0; mi < 2; ++mi) fA[mi] = *(const LAS bf16x8*)(lds + OFF_LOW + (j & 1) * (CL * 64) + (16 * mi + l16) * 64 + g * 16);
#pragma unroll
              for (int mi = 0; mi < 2; ++mi)
#pragma unroll
                  for (int nj = 0; nj < 4; ++nj) z[mi][nj] = __builtin_amdgcn_mfma_f32_16x16x32_bf16(fA[mi], wB[nj], (f32x4){bias[nj], bias[nj], bias[nj], bias[nj]}, 0, 0, 0); }
            float tot[4];
#pragma unroll
            for (int nj = 0; nj < 4; ++nj) {
                float s[2];
#pragma unroll
                for (int mi = 0; mi < 2; ++mi) {
#pragma unroll
                    for (int r = 0; r < 4; ++r) { const float zz = z[mi][nj][r]; const float t = __builtin_amdgcn_exp2f(-1.4426950408889634f * __builtin_fabsf(zz));
                        z[mi][nj][r] = __builtin_fmaf(__builtin_amdgcn_logf(1.0f + t), -0.0625f, __builtin_fminf(zz * 0.09016844005556021f, 0.f)); }
                    if (dir == 0) { z[mi][nj][1] += z[mi][nj][0]; z[mi][nj][2] += z[mi][nj][1]; z[mi][nj][3] += z[mi][nj][2]; s[mi] = z[mi][nj][3]; }
                    else          { z[mi][nj][2] += z[mi][nj][3]; z[mi][nj][1] += z[mi][nj][2]; z[mi][nj][0] += z[mi][nj][1]; s[mi] = z[mi][nj][0]; }
                }
                float e[2], t2[2];
#pragma unroll
                for (int mi = 0; mi < 2; ++mi) { const float s1 = __shfl_xor(s[mi], 16), ps = s[mi] + s1, p2 = __shfl_xor(ps, 32); t2[mi] = ps + p2;
                    e[mi] = dir == 0 ? (((g & 1) ? s1 : 0.f) + ((g & 2) ? p2 : 0.f)) : (((g & 1) ? 0.f : s1) + ((g & 2) ? 0.f : p2)); }
                const float o0 = e[0] + (dir == 0 ? 0.f : t2[1]), o1 = e[1] + (dir == 0 ? t2[0] : 0.f);
#pragma unroll
                for (int r = 0; r < 4; ++r) { z[0][nj][r] += o0; z[1][nj][r] += o1; }
                tot[nj] = t2[0] + t2[1];
            }
#pragma unroll
            for (int jj = 0; jj < 2; ++jj) { const int idx = ptid + 256 * jj, pos = idx >> 4, e8 = (idx & 15) * 8; *(LAS v4u*)(B + OFF_V + pos * V_ROW + e8 * 2) = vv[jj]; }
#pragma unroll
            for (int pp = 0; pp < 2; ++pp) { const int da = dbase + 32 * pp;
                const float dea = __builtin_amdgcn_exp2f(tot[2 * pp]), deb = __builtin_amdgcn_exp2f(tot[2 * pp + 1]);
                if (g == 0) *(LAS f32x2*)(B + OFF_DE + da * 4) = (f32x2){dea, deb};
#pragma unroll
                for (int mi = 0; mi < 2; ++mi) { float ea[4], eb[4];
#pragma unroll
                    for (int r = 0; r < 4; ++r) { const float b_a = z[mi][2 * pp][r], b_b = z[mi][2 * pp + 1][r];
                        const float xa = __builtin_amdgcn_exp2f(b_a), xb = __builtin_amdgcn_exp2f(b_b), ia = __builtin_amdgcn_exp2f(-b_a), ib = __builtin_amdgcn_exp2f(-b_b);
                        const unsigned qw = qv[pp][mi][r], kw = kv[pp][mi][r];
                        const float ka = bflo(kw) * ia, kb = bfhi(kw) * ib; ea[r] = ka * dea; eb[r] = kb * deb;
                        const int pos = 16 * mi + 4 * g + r;
                        *(LAS unsigned*)(B + OFF_QD + pos * QD_ROW + da * 2) = pk2c(bflo(qw) * xa, bfhi(qw) * xb);
                        *(LAS unsigned*)(B + OFF_KD + pos * QD_ROW + da * 2) = pk2c(ka, kb); }
                    *(LAS v2u*)(B + OFF_KET + da * KET_ROW + (16 * mi + 4 * g) * 2) = (v2u){pk2c(ea[0], ea[1]), pk2c(ea[2], ea[3])};
                    *(LAS v2u*)(B + OFF_KET + (da + 1) * KET_ROW + (16 * mi + 4 * g) * 2) = (v2u){pk2c(eb[0], eb[1]), pk2c(eb[2], eb[3])};
                }
            }
            if (j + 1 < nch) GLA_LOAD_QKV(j + 1);
            if (j + 2 < nch) GLA_LOAD_LOW(j + 2);
            GLA_BAR();
        }
        GLA_BAR();
#undef GLA_ROW0
#undef GLA_LOAD_QKV
#undef GLA_LOAD_LOW
#undef GLA_PUT_LOW
    } else {
        const int cw = wave - 4, l16 = lane & 15, g = lane >> 4;
        bf16* OD = dir ? OB : OF;
        LAS unsigned char* PW = lds + OFF_PW + cw * (CL * P_ROW);
        f32x4 S[2][16];
#pragma unroll
        for (int cb = 0; cb < 2; ++cb)
#pragma unroll
            for (int t = 0; t < 16; ++t) S[cb][t] = (f32x4){0.f, 0.f, 0.f, 0.f};
        GLA_BAR();
        GLA_BAR();
#define GLA_WAIT() do { asm volatile("s_waitcnt lgkmcnt(0)" ::: "memory"); __builtin_amdgcn_sched_barrier(0); } while (0)
        const int lbase = (int)(uintptr_t)lds;
        const int a_qd = lbase + OFF_QD + l16 * QD_ROW + g * 16;
        const int a_kd = lbase + OFF_KD + l16 * QD_ROW + g * 16;
        const int a_qp = lbase + OFF_QD + l16 * QD_ROW + g * 8;
        const int a_ke = lbase + OFF_KET + l16 * KET_ROW + g * 16;
        const int a_de = lbase + OFF_DE + g * 16;
        const int a_v = lbase + OFF_V + (8 * g) * V_ROW + (32 * cw + l16) * 2;
        const int a_pw = (int)(uintptr_t)PW + l16 * P_ROW + g * 16;
        for (int j = 0; j < nch; ++j) {
            const int bo = (j & 1) * BUF_BYTES;
            const size_t r0 = (size_t)rowbase + (size_t)(dir ? nch - 1 - j : j) * CL;
            f32x4 pacc[2][2];
#pragma unroll
            for (int mi = 0; mi < 2; ++mi)
#pragma unroll
                for (int ni = 0; ni < 2; ++ni) pacc[mi][ni] = (f32x4){0.f, 0.f, 0.f, 0.f};
#pragma unroll
            for (int hb = 0; hb < 4; ++hb) {
                bf16x8 fa[2][2], fb[2][2];
                rd_p(fa, fb, a_qd + bo + hb * 128, a_kd + bo + hb * 128);
#pragma unroll
                for (int kk = 0; kk < 2; ++kk)
#pragma unroll
                    for (int mi = 0; mi < 2; ++mi)
#pragma unroll
                        for (int ni = 0; ni < 2; ++ni) pacc[mi][ni] = __builtin_amdgcn_mfma_f32_16x16x32_bf16(fa[mi][kk], fb[ni][kk], pacc[mi][ni], 0, 0, 0);
            }
#pragma unroll
            for (int mi = 0; mi < 2; ++mi)
#pragma unroll
                for (int ni = 0; ni < 2; ++ni)
#pragma unroll
                    for (int r = 0; r < 4; ++r) { const int pos = 16 * mi + 4 * g + r, pk = 16 * ni + l16; const bool keep = dir ? (pk >= pos) : (pk <= pos);
                        *(LAS unsigned short*)(PW + pos * P_ROW + pk * 2) = (unsigned short)(pk2c(keep ? pacc[mi][ni][r] : 0.f, 0.f) & 0xffffu); }
            unsigned vu[2][8]; bf16x8 fp[2];
            asm volatile("s_waitcnt lgkmcnt(0)" ::: "memory");
            rd_v(vu[0], a_v + bo); rd_v(vu[1], a_v + bo + 32);
            rd_pw(fp, a_pw);
            bf16x8 Bv[2];
#pragma unroll
            for (int cb = 0; cb < 2; ++cb) Bv[cb] = __builtin_bit_cast(bf16x8, (v4u){vu[cb][0] | (vu[cb][1] << 16), vu[cb][2] | (vu[cb][3] << 16), vu[cb][4] | (vu[cb][5] << 16), vu[cb][6] | (vu[cb][7] << 16)});
            f32x4 oacc[2][2];
#pragma unroll
            for (int mi = 0; mi < 2; ++mi)
#pragma unroll
                for (int cb = 0; cb < 2; ++cb) oacc[mi][cb] = __builtin_amdgcn_mfma_f32_16x16x32_bf16(fp[mi], Bv[cb], (f32x4){0.f, 0.f, 0.f, 0.f}, 0, 0, 0);
#pragma unroll
            for (int hb = 0; hb < 4; ++hb) {
                v2u q0[2][2], q1[2][2];
                rd_q(q0, q1, a_qp + bo + hb * 128);
#pragma unroll
                for (int kk = 0; kk < 2; ++kk) { const int k2 = 2 * (hb * 2 + kk);
                    bf16x8 Bs[2];
#pragma unroll
                    for (int cb = 0; cb < 2; ++cb) Bs[cb] = __builtin_bit_cast(bf16x8, (v4u){pk2c(S[cb][k2][0], S[cb][k2][1]), pk2c(S[cb][k2][2], S[cb][k2][3]), pk2c(S[cb][k2 + 1][0], S[cb][k2 + 1][1]), pk2c(S[cb][k2 + 1][2], S[cb][k2 + 1][3])});
#pragma unroll
                    for (int mi = 0; mi < 2; ++mi) { const bf16x8 a = __builtin_bit_cast(bf16x8, (v4u){q0[mi][kk].x, q0[mi][kk].y, q1[mi][kk].x, q1[mi][kk].y});
#pragma unroll
                        for (int cb = 0; cb < 2; ++cb) oacc[mi][cb] = __builtin_amdgcn_mfma_f32_16x16x32_bf16(a, Bs[cb], oacc[mi][cb], 0, 0, 0); }
                }
            }
            { bf16* op = OD + r0 * 2048 + h * 512 + sl * 128 + 32 * cw + l16;
#pragma unroll
              for (int mi = 0; mi < 2; ++mi)
#pragma unroll
                  for (int cb = 0; cb < 2; ++cb)
#pragma unroll
                      for (int r = 0; r < 4; ++r) op[(size_t)(16 * mi + 4 * g + r) * 2048 + 16 * cb] = (bf16)(pk2c(oacc[mi][cb][r], 0.f) & 0xffffu); }
#pragma unroll
            for (int hb = 0; hb < 4; ++hb) {
                bf16x8 fk[4]; f32x4 fd[4];
                rd_s(fk, fd, a_ke + bo + hb * 5120, a_de + bo + hb * 256);
#pragma unroll
                for (int t = 0; t < 4; ++t)
#pragma unroll
                    for (int cb = 0; cb < 2; ++cb) S[cb][hb * 4 + t] = __builtin_amdgcn_mfma_f32_16x16x32_bf16(fk[t], Bv[cb], S[cb][hb * 4 + t] * fd[t], 0, 0, 0);
            }
            GLA_BAR();
        }
#undef GLA_WAIT
    }
}
}

constexpr int N_PHASE_IDS = 2 + 10 * DEPTH;
__host__ __device__ constexpr bool phase_exists(int ph) {
    if (ph < 2) return true;
    const int l = (ph - 2) / 10, s = (ph - 2) % 10, kind = l % 3;
    if (s == 5) return kind == 2;
    if (s == 7) return false;
    if (s == 4) return false;
    if (s == 0 && l > 0) return false;
    if (s == 2 && kind == 0) return false;
    return true;
}
#define IN(k) (lo <= (k) && (k) < hi)
#ifndef SITE_MASK
#define SITE_MASK 0xffffu
#endif
#ifndef WGM_RES
#define WGM_RES 4
#endif
#ifndef REPS_G1
#define REPS_G1 1
#endif
#ifndef REPS_G3
#define REPS_G3 1
#endif
#ifndef REPS_SCAN
#define REPS_SCAN 1
#endif
#ifndef REPS_ATT
#define REPS_ATT 1
#endif
#define SITE(n) ((((unsigned)(SITE_MASK)) >> (n)) & 1u)
#define SEAM(k) do { if ((k) + 1 < hi) xcd_barrier(bar); } while (0)
template <int layer> __device__ __forceinline__ void layer_body(Frame& F, const XcdBarrier& bar, const int lo, const int hi, unsigned char* lds_raw) {
    constexpr size_t wreg = (layer & 1) ? WS_WB : WS_W, bw1o = (layer & 1) ? WS_BW1B : WS_BW1, bw2o = (layer & 1) ? WS_BW2B : WS_BW2;
    bf16* const w1t = (bf16*)(F.ws + wreg); bf16* const w2t = (bf16*)(F.ws + wreg + 32 * MiB); bf16* const wmix = (bf16*)(F.ws + wreg + 64 * MiB); bf16* const wot = (bf16*)(F.ws + wreg + 90 * MiB);
#define PREP_NEXT() do { if constexpr (layer + 1 < DEPTH) { __syncthreads(); bw_phase(F, layer + 1); prep_weights(F, layer + 1, (unsigned*)(F.ws + WS_CTL) + CW_PREP + 64 * (layer + 1)); } } while (0)

        constexpr int pb = 2 + 10 * layer, kind = layer % 3, jj = layer / 3;
        const float* modl = F.mod + (size_t)layer * NSEQ * 12288;
        if (SITE(2) && layer == 0 && IN(pb + 0)) { norm0_phase(F); bw_phase(F, 0); SEAM(pb + 0); }
        if (SITE(3) && IN(pb + 1)) {
            const int N1 = kind == 0 ? 3072 : (kind == 1 ? 6400 : 1024);
            pg8::Gemm g{F.H, wmix, M, N1, D, D, 256}; pg8::StaticOrder S; S.init(M, N1, F.G, (int)blockIdx.x, REPS_G1);
            if constexpr (kind == 0) {
                pg8::EpiBf16NRope E{(bf16*)(F.ws + WS_S), N1, (const float*)(F.ws + WS_SSQB), (const float*)(F.ws + bw1o), 6400,
                                    F.in[I_GQA_QN] + jj * 128, F.in[I_GQA_KN] + jj * 128, (const float*)F.ropeA, (PG8_LAS float*)(F.lds + RING_BYTES + 4096)};
                pg8::gemm_phase<pg8::EpiBf16NRope, pg8::StaticOrder, true, true>(F.lds, g, S, E);
            } else {
                pg8::EpiBf16N<0> E{(bf16*)(F.ws + WS_S), N1, (const float*)(F.ws + WS_SSQB), (const float*)(F.ws + bw1o), 6400};
                pg8::gemm_phase<pg8::EpiBf16N<0>, pg8::StaticOrder, true, true>(F.lds, g, S, E);
            }
            SEAM(pb + 1);
        }
        if (kind == 0) {
            if (SITE(5) && IN(pb + 3)) {
                const bf16* QKV = (const bf16*)(F.ws + WS_QKV);
                const float shiftC = __int_as_float(__builtin_amdgcn_readfirstlane(__float_as_int(((const float*)(F.ws + WS_BND))[jj])));
                if (shiftC < 60.f) {
                for (int u_ = F.vcu; u_ < 4096 * REPS_ATT; u_ += F.G) { const int u = u_ & 4095;
                    int rowq, rowk, T, head;
                    if (u < 2048) { const int sq = u >> 9, r = u & 511; head = r >> 5; T = 8192; rowk = MP + sq * 8192; rowq = rowk + (r & 31) * 256; }
                    else { const int v = u - 2048, sq = v >> 7, r = v & 127; head = r >> 3; T = 2048; rowk = sq * 2048; rowq = rowk + (r & 7) * 256; }
                    const int kvh = head >> 2;
                    attn::attn_dense_body<128, 3072, 3072, 3072, 3072, 3072, 2, false, true>(QKV + (size_t)rowq * 3072 + head * 128, QKV + (size_t)rowk * 3072 + 2048 + kvh * 128, nullptr,
                        QKV + (size_t)rowk * 3072 + 2560 + kvh * 128, (bf16*)QKV + (size_t)rowq * 3072 + head * 128, T, (char*)lds_raw, nullptr, nullptr, 0, shiftC);
                }
                } else {
                for (int u_ = F.vcu; u_ < 4096 * REPS_ATT; u_ += F.G) { const int u = u_ & 4095;
                    int rowq, rowk, T, head;
                    if (u < 2048) { const int sq = u >> 9, r = u & 511; head = r >> 5; T = 8192; rowk = MP + sq * 8192; rowq = rowk + (r & 31) * 256; }
                    else { const int v = u - 2048, sq = v >> 7, r = v & 127; head = r >> 3; T = 2048; rowk = sq * 2048; rowq = rowk + (r & 7) * 256; }
                    const int kvh = head >> 2;
                    attn::attn_dense_body<128, 3072, 3072, 3072, 3072, 3072, 2>(QKV + (size_t)rowq * 3072 + head * 128, QKV + (size_t)rowk * 3072 + 2048 + kvh * 128, nullptr,
                        QKV + (size_t)rowk * 3072 + 2560 + kvh * 128, (bf16*)QKV + (size_t)rowq * 3072 + head * 128, T, (char*)lds_raw);
                }
                }
                PREP_NEXT();
                SEAM(pb + 3);
            }
        } else if (kind == 1) {
            if (SITE(6) && IN(pb + 2)) {
                const bf16* PROJ = (const bf16*)(F.ws + WS_PROJ); bf16* OB = (bf16*)(F.ws + WS_OB);
                const int nrep = REPS_SCAN + (F.G >> 24);
                for (int rp = 0; rp < nrep; ++rp) {
                    const int nmine = F.G == 256 ? (F.vcu < 128 ? 1 : 4) : (640 - F.vcu + F.G - 1) / F.G;
                    for (int q = 0; q < nmine; ++q) { const int c = F.G == 256 ? (F.vcu < 128 ? F.vcu : 128 + (F.vcu - 128) * 4 + q) : F.vcu + q * F.G;
                        gla::chain(F.lds, PROJ, F.H, OB, F.in[I_GLA_WG2], F.in[I_GLA_BG], c); } }
                PREP_NEXT();
                SEAM(pb + 2);
            }
            if (SITE(7) && IN(pb + 3)) { gla_post_phase(F); SEAM(pb + 3); }
        } else {
            if (SITE(8) && IN(pb + 2)) { mla_down_norm_phase(F); SEAM(pb + 2); }
            if (SITE(9) && IN(pb + 3)) {
                const bf16* DN = (const bf16*)(F.ws + WS_DOWN);
                { pg8::Gemm g{DN, wmix + (size_t)4 * MiB / 2, M, 3072, 512, 1024, 256}; pg8::StaticOrder S; S.init(M, 3072, F.G, (int)blockIdx.x);
                  pg8::EpiBf16P E{(bf16*)(F.ws + WS_Q), 3072};
                  pg8::gemm_phase<pg8::EpiBf16P, pg8::StaticOrder, true, true>(F.lds, g, S, E); }
                __syncthreads();
                { int K2 = 256, lda2 = 1024; asm volatile("" : "+s"(K2), "+s"(lda2));
                  pg8::Gemm g{DN + 512, wmix + (size_t)8 * MiB / 2, M, 4096, K2, lda2, 256}; pg8::StaticOrder S; S.init(M, 4096, F.G, (int)blockIdx.x);
                  pg8::EpiBf16KV E{(bf16*)(F.ws + WS_KV), 4096, F.in[I_MLA_KNN], (PG8_LAS float*)(F.lds + RING_BYTES + 4096)};
                  pg8::gemm_phase<pg8::EpiBf16KV, pg8::StaticOrder, true, true>(F.lds, g, S, E); }
                SEAM(pb + 3);
            }
            if (SITE(11) && IN(pb + 5)) {
                const bf16* Q = (const bf16*)(F.ws + WS_Q); const bf16* KV = (const bf16*)(F.ws + WS_KV); const bf16* DN = (const bf16*)(F.ws + WS_DOWN);
                const float shiftC = __int_as_float(__builtin_amdgcn_readfirstlane(__float_as_int(((const float*)(F.ws + WS_BND))[2])));
                if (shiftC < 60.f) {
                for (int u_ = F.vcu; u_ < 4096 * REPS_ATT; u_ += F.G) { const int u = u_ & 4095;
                    int rowq, rowk, T, head;
                    if (u < 2048) { const int sq = u >> 9, r = u & 511; head = r >> 5; T = 8192; rowk = MP + sq * 8192; rowq = rowk + (r & 31) * 256; }
                    else { const int v = u - 2048, sq = v >> 7, r = v & 127; head = r >> 3; T = 2048; rowk = sq * 2048; rowq = rowk + (r & 7) * 256; }
                    attn::attn_dense_body<192, 3072, 4096, 1024, 4096, 3072, 1, true, true>(Q + (size_t)rowq * 3072 + head * 192, KV + (size_t)rowk * 4096 + head * 256, DN + (size_t)rowk * 1024 + 768,
                        KV + (size_t)rowk * 4096 + head * 256 + 128, (bf16*)Q + (size_t)rowq * 3072 + head * 192, T, (char*)lds_raw, F.in[I_MLA_QN], (const float*)F.ropeC, rowq - rowk, shiftC);
                }
                } else {
                for (int u_ = F.vcu; u_ < 4096 * REPS_ATT; u_ += F.G) { const int u = u_ & 4095;
                    int rowq, rowk, T, head;
                    if (u < 2048) { const int sq = u >> 9, r = u & 511; head = r >> 5; T = 8192; rowk = MP + sq * 8192; rowq = rowk + (r & 31) * 256; }
                    else { const int v = u - 2048, sq = v >> 7, r = v & 127; head = r >> 3; T = 2048; rowk = sq * 2048; rowq = rowk + (r & 7) * 256; }
                    attn::attn_dense_body<192, 3072, 4096, 1024, 4096, 3072, 1, true>(Q + (size_t)rowq * 3072 + head * 192, KV + (size_t)rowk * 4096 + head * 256, DN + (size_t)rowk * 1024 + 768,
                        KV + (size_t)rowk * 4096 + head * 256 + 128, (bf16*)Q + (size_t)rowq * 3072 + head * 192, T, (char*)lds_raw, F.in[I_MLA_QN], (const float*)F.ropeC, rowq - rowk);
                }
                }
                PREP_NEXT();
                SEAM(pb + 5);
            }
        }
        if (SITE(12) && IN(pb + 6)) {
            const bf16* A2 = kind == 0 ? (const bf16*)(F.ws + WS_QKV) : (kind == 1 ? (const bf16*)(F.ws + WS_OB) : (const bf16*)(F.ws + WS_Q));
            pg8::Gemm g{A2, wot, M, D, D, kind == 1 ? D : 3072, kind == 2 ? 384 : 256}; pg8::StaticOrder S; S.init(M, D, F.G, (int)blockIdx.x, 1, WGM_RES);
            typedef pg8::EpiResGateNormB<layer == 0 ? 0 : 1> EpiT;
            EpiT E{F.in[I_XP], F.in[I_XS], F.out, modl + 2 * D, F.H, F.in[I_N2G] + layer * D, modl + 4 * D, (float*)(F.ws + WS_SSQA), (PG8_LAS float*)(F.lds + RING_BYTES)};
            pg8::gemm_phase<EpiT, pg8::StaticOrder, true, true>(F.lds, g, S, E);
            SEAM(pb + 6);
        }
        if (SITE(14) && IN(pb + 8)) {
            pg8::Gemm g{F.H, w1t, M, FF, D, D, 256}; pg8::StaticOrder S; S.init(M, FF, F.G, (int)blockIdx.x, REPS_G3);
            pg8::EpiBf16N<1> E{(bf16*)(F.ws + WS_HID), FF, (const float*)(F.ws + WS_SSQA), (const float*)(F.ws + bw2o), FF};
            pg8::gemm_phase<pg8::EpiBf16N<1>, pg8::StaticOrder, true, true>(F.lds, g, S, E);
            SEAM(pb + 8);
        }
        if (SITE(15) && IN(pb + 9)) {
            pg8::Gemm g{(const bf16*)(F.ws + WS_HID), w2t, M, D, FF, FF, 256}; pg8::StaticOrder S; S.init(M, D, F.G, (int)blockIdx.x, 1, WGM_RES);
            typedef pg8::EpiResGateNormB<layer + 1 < DEPTH ? 1 : 2> EpiT;
            EpiT E{nullptr, F.in[I_XS], F.out, modl + 5 * D, layer + 1 < DEPTH ? F.H : nullptr, F.in[I_N1G] + (layer + 1 < DEPTH ? layer + 1 : 0) * D,
                   modl + (layer + 1 < DEPTH ? NSEQ * 12288 + D : 0), (float*)(F.ws + WS_SSQB), (PG8_LAS float*)(F.lds + RING_BYTES)};
            pg8::gemm_phase<EpiT, pg8::StaticOrder, true, true>(F.lds, g, S, E);
            SEAM(pb + 9);
        }
    }
#undef PREP_NEXT
__global__ void __launch_bounds__(NWAVES * 64, 2) trunk_fwd(Args args) {
    extern __shared__ __attribute__((aligned(16))) unsigned char lds_raw[];
    Frame F;
    F.lds = (LAS unsigned char*)lds_raw;
    F.tid = threadIdx.x; F.lane = F.tid & 63; F.wave = __builtin_amdgcn_readfirstlane(F.tid >> 6);
    F.G = gridDim.x; { const int bx = blockIdx.x; F.vcu = (F.G % 8 == 0) ? (bx % 8) * (F.G / 8) + bx / 8 : bx; }
    F.in = args.in; F.out = args.out; F.ws = args.ws;
    F.mod = (float*)(args.ws + WS_MOD); F.ropeA = (const f32x2*)(args.ws + WS_ROPE); F.ropeC = F.ropeA + 192 * 32;
    F.H = (bf16*)(args.ws + WS_H);
    for (int u = F.tid; u < (LDS_BYTES - LDSCTL_OFF) / 4; u += NWAVES * 64) ((LAS unsigned*)(F.lds + LDSCTL_OFF))[u] = 0u;
    __syncthreads();
    XcdBarrier bar; bar.bar = (unsigned*)(args.ws + WS_CTL) + CW_BAR; bar.x = 0; bar.st = nullptr;
    if (args.one_launch) bar = xcd_barrier_post((unsigned*)(args.ws + WS_CTL) + CW_BAR, (volatile LAS unsigned*)(F.lds + LDSCTL_OFF));
    const int lo = args.ph_lo, hi = args.ph_hi;

    if (SITE(0) && IN(0)) { ada_phase(F); rope_tables(F); prep_weights(F, 0, (unsigned*)(F.ws + WS_CTL) + CW_PREP); SEAM(0); }
    if (SITE(1) && IN(1)) { mod_finalize(F); score_bounds(F); SEAM(1); }

    layer_body<0>(F, bar, lo, hi, lds_raw); layer_body<1>(F, bar, lo, hi, lds_raw); layer_body<2>(F, bar, lo, hi, lds_raw); layer_body<3>(F, bar, lo, hi, lds_raw);
#undef IN
#undef SEAM
}

extern "C" void kernel_launch(void* const* d_in, const int* in_sizes, int n_in, void* d_out, int out_size, void* d_ws, size_t ws_size, hipStream_t stream) {
    static int grid = 0;
    if (grid == 0) {
        if (n_in != N_IN || out_size != M * D || ws_size < WS_END) { fprintf(stderr, "kernel_launch: unexpected shapes (n_in %d out %d ws %zu, need %zu)\n", n_in, out_size, ws_size, (size_t)WS_END); grid = -1; return; }
        int dev = 0, cus = 0, per_cu = 0;
        if (hipGetDevice(&dev) != hipSuccess || hipDeviceGetAttribute(&cus, hipDeviceAttributeMultiprocessorCount, dev) != hipSuccess) { grid = -1; return; }
        if (hipFuncSetAttribute((const void*)trunk_fwd, hipFuncAttributeMaxDynamicSharedMemorySize, LDS_BYTES) != hipSuccess) { fprintf(stderr, "kernel_launch: hipFuncSetAttribute failed\n"); grid = -1; return; }
        if (hipOccupancyMaxActiveBlocksPerMultiprocessor(&per_cu, (const void*)trunk_fwd, NWAVES * 64, LDS_BYTES) != hipSuccess || per_cu < 1) { fprintf(stderr, "kernel_launch: occupancy query says %d blocks per CU\n", per_cu); }
        (void)hipGetLastError();
        grid = cus;
    }
    if (grid < 0) return;
    (void)hipMemsetAsync((char*)d_ws + WS_CTL, 0, CTL_ZERO_BYTES, stream);
    Args a{};
    for (int i = 0; i < N_IN; ++i) a.in[i] = (const float*)d_in[i];
    a.out = (float*)d_out; a.ws = (unsigned char*)d_ws; a.pad = 0;
#if MK_ONE_LAUNCH
    a.ph_lo = 0; a.ph_hi = N_PHASE_IDS; a.one_launch = 1;
    hipLaunchKernelGGL(trunk_fwd, dim3(grid), dim3(NWAVES * 64), LDS_BYTES, stream, a);
#else
    for (int ph = 0; ph < N_PHASE_IDS; ++ph) { if (!phase_exists(ph)) continue;
        a.ph_lo = ph; a.ph_hi = ph + 1; a.one_launch = 0;
        hipLaunchKernelGGL(trunk_fwd, dim3(grid), dim3(NWAVES * 64), LDS_BYTES, stream, a); }
#endif
    const hipError_t le = hipPeekAtLastError();
    if (le != hipSuccess) fprintf(stderr, "kernel_launch: launch failed: %s\n", hipGetErrorName(le));
}
```
